# Optimizing an MI355X kernel written in HIP

```python
import jax, jax.numpy as jnp
from jax import lax
import numpy as np

D_MODEL = 1024
BATCH = 16
SEQ = 256
DEPTH = 1
DEC_BATCH = 2
DEC_SEQ = 1024
PAST_LEN = 512

GRID_W = 64
GLA_HEADS = 4
GLA_DK = 64
GLA_DV = 128
GLA_QK = GLA_HEADS * GLA_DK
GLA_V = GLA_HEADS * GLA_DV
GLA_LOWRANK = 16
GLA_GATE_NORM = 16.0
GLA_CHUNK = 64
NA_HEADS = 8
NA_HD = 64
NA_W = NA_HEADS * NA_HD
NA_WIN_ROWS = 8
NA_WIN_COLS = 16
D_FF = 2816
CONV_W = 3
EPS = 1e-6
Q_BLOCK = 128
IN_SIZES = (GLA_QK, GLA_QK, GLA_V, GLA_V, GLA_LOWRANK, GLA_LOWRANK, NA_W, NA_W, NA_W, D_MODEL, D_MODEL)
D_IN = sum(IN_SIZES)

kernel_name = 'hybrid_gla_natten_prefix_dit_step'


def rmsnorm(x, g):
    xf = x.astype(jnp.float32)
    y = xf * lax.rsqrt(jnp.mean(xf * xf, axis=-1, keepdims=True) + EPS)
    return (y * g.astype(jnp.float32)).astype(x.dtype)


def ada_mod(cond, w, b):
    m = (jax.nn.silu(cond) @ w + b)[:, None, :]
    return jnp.split(m, 6, axis=-1)


def split_in(u):
    idx = np.cumsum(IN_SIZES)[:-1].tolist()
    return jnp.split(u, idx, axis=-1)


def gla_scan(q, k, v, log_a, s0):
    B, T, H, DK = q.shape
    DV = v.shape[-1]
    C = GLA_CHUNK
    N = T // C
    f32 = jnp.float32
    qc = q.astype(f32).reshape(B, N, C, H, DK)
    kc = k.astype(f32).reshape(B, N, C, H, DK)
    vc = v.astype(f32).reshape(B, N, C, H, DV)
    bc = jnp.cumsum(log_a.astype(f32).reshape(B, N, C, H, DK), axis=2)
    b_last = bc[:, :, -1]
    causal = jnp.tril(jnp.ones((C, C), dtype=bool))[None, None, :, :, None, None]
    diff = bc[:, :, :, None] - bc[:, :, None, :]
    decay = jnp.exp(jnp.where(causal, diff, -jnp.inf))
    scores = jnp.einsum('bnthd,bnshd,bntshd->bnhts', qc, kc, decay)
    o_intra = jnp.einsum('bnhts,bnshv->bnthv', scores, vc)
    kv_chunk = jnp.einsum('bnshd,bnshv->bnhdv', kc * jnp.exp(b_last[:, :, None] - bc), vc)

    def step(s, inp):
        a_last, kv = inp
        return jnp.exp(a_last)[..., None] * s + kv, s

    s_final, s_start = lax.scan(step, s0.astype(f32),
                                (jnp.moveaxis(b_last, 1, 0), jnp.moveaxis(kv_chunk, 1, 0)))
    o_inter = jnp.einsum('bnthd,nbhdv->bnthv', qc * jnp.exp(bc), s_start)
    o = (o_intra + o_inter).reshape(B, T, H, DV)
    return o.astype(v.dtype), s_final.astype(s0.dtype)


def gla_bidir(q, k, v, la_f, la_b, s0_f, s0_b):
    o_f, s_f = gla_scan(q, k, v, la_f, s0_f)
    flip = lambda a: jnp.flip(a, axis=1)
    o_b, s_b = gla_scan(flip(q), flip(k), flip(v), flip(la_b), s0_b)
    return o_f + flip(o_b), s_f, s_b


def ctx_attention(q, k, v):
    B, L, H, HD = q.shape
    nb = L // Q_BLOCK
    qb = jnp.moveaxis(q.reshape(B, nb, Q_BLOCK, H, HD), 1, 0)

    def one(qblk):
        s = jnp.einsum('bqhd,bkhd->bhqk', qblk, k).astype(jnp.float32) * (HD ** -0.5)
        p = jax.nn.softmax(s, axis=-1)
        return jnp.einsum('bhqk,bkhd->bqhd', p.astype(v.dtype), v)

    o = lax.map(one, qb)
    return jnp.moveaxis(o, 0, 1).reshape(B, L, H, HD)


def na_latent_attention(q, k, v, k_ctx, v_ctx, rpb):
    B, T, H, HD = q.shape
    rows = T // GRID_W
    wr = min(NA_WIN_ROWS, rows)
    wc = NA_WIN_COLS
    scale = HD ** -0.5
    qg = q.reshape(B, rows, GRID_W, H, HD)
    kg = k.reshape(B, rows, GRID_W, H, HD)
    vg = v.reshape(B, rows, GRID_W, H, HD)
    r = jnp.arange(rows)
    row_start = jnp.clip(r - wr // 2, 0, rows - wr)
    key_rows = row_start[:, None] + jnp.arange(wr)[None, :]
    k_rows = kg[:, key_rows]
    v_rows = vg[:, key_rows]
    s_loc = jnp.einsum('brqhd,brikhd->bhrqik', qg, k_rows).astype(jnp.float32) * scale
    cidx = jnp.arange(GRID_W)
    col_start = jnp.clip(cidx - wc // 2, 0, GRID_W - wc)
    in_win = (cidx[None, :] >= col_start[:, None]) & (cidx[None, :] < col_start[:, None] + wc)
    dr_idx = key_rows - r[:, None] + NA_WIN_ROWS - 1
    dc_idx = jnp.clip(cidx[None, :] - cidx[:, None], -(wc - 1), wc - 1) + NA_WIN_COLS - 1
    bias = rpb.astype(jnp.float32)[:, dr_idx[:, None, :, None], dc_idx[None, :, None, :]]
    s_loc = jnp.where(in_win[None, None, None, :, None, :], s_loc + bias[None], -jnp.inf)
    n_loc = wr * GRID_W
    s_ctx = jnp.einsum('brqhd,blhd->bhrql', qg, k_ctx).astype(jnp.float32) * scale
    s = jnp.concatenate([s_loc.reshape(B, H, rows, GRID_W, n_loc), s_ctx], axis=-1)
    p = jax.nn.softmax(s, axis=-1).astype(v.dtype)
    p_loc = p[..., :n_loc].reshape(B, H, rows, GRID_W, wr, GRID_W)
    p_ctx = p[..., n_loc:]
    o = (jnp.einsum('bhrqik,brikhd->brqhd', p_loc, v_rows)
         + jnp.einsum('bhrql,blhd->brqhd', p_ctx, v_ctx))
    return o.reshape(B, T, H, HD)


def conv_ffn(h, w_up, w_conv, b_conv, w_down):
    u = h @ w_up
    ch = u.shape[-1]
    u = lax.conv_general_dilated(u, w_conv[:, None, :], window_strides=(1,),
                                 padding=((CONV_W // 2, CONV_W // 2),),
                                 dimension_numbers=('NWC', 'WIO', 'NWC'),
                                 feature_group_count=ch) + b_conv
    a, g = jnp.split(u, 2, axis=-1)
    return (a * jax.nn.silu(g)) @ w_down


def block(x, cond, lp, ctx=None):
    (w_ada, b_ada, g_mix, w_in, w_af, b_af, w_ab, b_ab, g_gla, g_qn, g_kn, rpb,
     w_gla_o, w_na_o, w_out, g_ffn, w_up, w_conv, b_conv, w_down) = lp
    B, T, _ = x.shape
    sh1, sc1, gt1, sh2, sc2, gt2 = ada_mod(cond, w_ada, b_ada)
    h = rmsnorm(x, g_mix) * (1 + sc1) + sh1
    gq, gk, gv, gr, zf, zb, nq, nk, nv, m_gla, m_na = split_in(h @ w_in)
    q = gq.reshape(B, T, GLA_HEADS, GLA_DK) * (GLA_DK ** -0.5)
    k = gk.reshape(B, T, GLA_HEADS, GLA_DK)
    v = gv.reshape(B, T, GLA_HEADS, GLA_DV)
    la_f = (jax.nn.log_sigmoid((zf @ w_af + b_af).astype(jnp.float32)) / GLA_GATE_NORM).reshape(B, T, GLA_HEADS, GLA_DK)
    la_b = (jax.nn.log_sigmoid((zb @ w_ab + b_ab).astype(jnp.float32)) / GLA_GATE_NORM).reshape(B, T, GLA_HEADS, GLA_DK)
    if ctx is None:
        s0_f = jnp.zeros((B, GLA_HEADS, GLA_DK, GLA_DV), x.dtype)
        s0_b = s0_f
    else:
        k_ctx, v_ctx, s0_f, s0_b = ctx
    o_gla, s_f, s_b = gla_bidir(q, k, v, la_f, la_b, s0_f, s0_b)
    b_gla = (rmsnorm(o_gla, g_gla).reshape(B, T, GLA_V) * jax.nn.silu(gr)) @ w_gla_o
    qn = rmsnorm(nq.reshape(B, T, NA_HEADS, NA_HD), g_qn)
    kn = rmsnorm(nk.reshape(B, T, NA_HEADS, NA_HD), g_kn)
    vn = nv.reshape(B, T, NA_HEADS, NA_HD)
    if ctx is None:
        o_na = ctx_attention(qn, kn, vn)
    else:
        o_na = na_latent_attention(qn, kn, vn, k_ctx, v_ctx, rpb)
    b_na = o_na.reshape(B, T, NA_W) @ w_na_o
    mix = (jax.nn.sigmoid(m_gla) * b_gla + jax.nn.sigmoid(m_na) * b_na) @ w_out
    x = x + gt1 * mix
    h2 = rmsnorm(x, g_ffn) * (1 + sc2) + sh2
    x = x + gt2 * conv_ffn(h2, w_up, w_conv, b_conv, w_down)
    return x, (kn, vn, s_f, s_b)


def setup_inputs(seed: int = 0) -> dict:
    key = jax.random.key(seed)
    ks = jax.random.split(key, 28)
    nrm = lambda kk, shape, s=1.0: jax.random.normal(kk, shape, jnp.float32) * s
    gain = lambda kk, shape: 1.0 + 0.02 * jax.random.normal(kk, shape, jnp.float32)
    L = DEPTH
    return {
        'x_prompt': nrm(ks[0], (BATCH, SEQ, D_MODEL)),
        'x_sample': nrm(ks[1], (DEC_BATCH, DEC_SEQ, D_MODEL)),
        'c': nrm(ks[2], (DEC_BATCH, D_MODEL)),
        'cache_na_k': nrm(ks[3], (DEC_BATCH, L, PAST_LEN, NA_HEADS, NA_HD)),
        'cache_na_v': nrm(ks[4], (DEC_BATCH, L, PAST_LEN, NA_HEADS, NA_HD)),
        'state_gla_fwd': nrm(ks[5], (DEC_BATCH, L, GLA_HEADS, GLA_DK, GLA_DV), 2.0),
        'state_gla_bwd': nrm(ks[6], (DEC_BATCH, L, GLA_HEADS, GLA_DK, GLA_DV), 2.0),
        'c_ctx': nrm(ks[7], (D_MODEL,)),
        'w_ada': nrm(ks[8], (L, D_MODEL, 6 * D_MODEL), 0.3 * D_MODEL ** -0.5),
        'b_ada': nrm(ks[9], (L, 6 * D_MODEL), 0.02),
        'g_norm_mix': gain(ks[10], (L, D_MODEL)),
        'w_in': nrm(ks[11], (L, D_MODEL, D_IN), D_MODEL ** -0.5),
        'w_alpha_fwd': nrm(ks[12], (L, GLA_LOWRANK, GLA_QK), GLA_LOWRANK ** -0.5),
        'b_alpha_fwd': nrm(ks[13], (L, GLA_QK), 0.1),
        'w_alpha_bwd': nrm(ks[14], (L, GLA_LOWRANK, GLA_QK), GLA_LOWRANK ** -0.5),
        'b_alpha_bwd': nrm(ks[15], (L, GLA_QK), 0.1),
        'g_gla_norm': gain(ks[16], (L, GLA_DV)),
        'g_q_norm': gain(ks[17], (L, NA_HD)),
        'g_k_norm': gain(ks[18], (L, NA_HD)),
        'rpb': nrm(ks[19], (L, NA_HEADS, 2 * NA_WIN_ROWS - 1, 2 * NA_WIN_COLS - 1), 0.1),
        'w_gla_o': nrm(ks[20], (L, GLA_V, D_MODEL), GLA_V ** -0.5),
        'w_na_o': nrm(ks[21], (L, NA_W, D_MODEL), NA_W ** -0.5),
        'w_out': nrm(ks[22], (L, D_MODEL, D_MODEL), D_MODEL ** -0.5),
        'g_norm_ffn': gain(ks[23], (L, D_MODEL)),
        'w_up': nrm(ks[24], (L, D_MODEL, 2 * D_FF), D_MODEL ** -0.5),
        'w_conv': nrm(ks[25], (L, CONV_W, 2 * D_FF), CONV_W ** -0.5),
        'b_conv': nrm(ks[26], (L, 2 * D_FF), 0.02),
        'w_down': nrm(ks[27], (L, D_FF, D_MODEL), D_FF ** -0.5),
    }


def reference(x_prompt, x_sample, c, cache_na_k, cache_na_v, state_gla_fwd, state_gla_bwd,
              c_ctx, w_ada, b_ada, g_norm_mix, w_in, w_alpha_fwd, b_alpha_fwd, w_alpha_bwd,
              b_alpha_bwd, g_gla_norm, g_q_norm, g_k_norm, rpb, w_gla_o, w_na_o, w_out,
              g_norm_ffn, w_up, w_conv, b_conv, w_down):
    xp = x_prompt
    xs = x_sample
    cond_ctx = c_ctx[None, :]
    new_k, new_v, new_sf, new_sb = [], [], [], []
    for l in range(DEPTH):
        lp = (w_ada[l], b_ada[l], g_norm_mix[l], w_in[l], w_alpha_fwd[l], b_alpha_fwd[l],
              w_alpha_bwd[l], b_alpha_bwd[l], g_gla_norm[l], g_q_norm[l], g_k_norm[l], rpb[l],
              w_gla_o[l], w_na_o[l], w_out[l], g_norm_ffn[l], w_up[l], w_conv[l], b_conv[l], w_down[l])
        xp, (kc, vc, sf, sb) = block(xp, cond_ctx, lp)
        new_k.append(kc)
        new_v.append(vc)
        new_sf.append(sf)
        new_sb.append(sb)
        xs, _ = block(xs, c, lp, (cache_na_k[:, l], cache_na_v[:, l], state_gla_fwd[:, l], state_gla_bwd[:, l]))
    new_cache_na_k = jnp.stack(new_k, axis=1)
    new_cache_na_v = jnp.stack(new_v, axis=1)
    new_state_gla_fwd = jnp.stack(new_sf, axis=1)
    new_state_gla_bwd = jnp.stack(new_sb, axis=1)
    return (xp, xs, new_cache_na_k, new_cache_na_v, new_state_gla_fwd, new_state_gla_bwd)
```

```cpp
#include <hip/hip_runtime.h>
#include <cstdio>
#include <cstdint>

#ifndef ONE_LAUNCH
#define ONE_LAUNCH 0
#endif

#define LAS __attribute__((address_space(3)))
#define GAS __attribute__((address_space(1)))
typedef unsigned short bf16_t;
typedef short bf16x8 __attribute__((ext_vector_type(8)));
typedef short s16x4 __attribute__((ext_vector_type(4)));
typedef float f32x2 __attribute__((ext_vector_type(2)));
typedef float f32x4 __attribute__((ext_vector_type(4)));
typedef float f32x16 __attribute__((ext_vector_type(16)));
typedef unsigned u32x2 __attribute__((ext_vector_type(2)));
typedef unsigned u32x4 __attribute__((ext_vector_type(4)));
typedef __bf16 bf16x2_t __attribute__((ext_vector_type(2)));

constexpr int DM = 1024, NCTX = 4096, NLAT = 2048, MTOK = 6144, DIN = 5152, NU = 5120, DFF = 2816, NUP = 5632;
constexpr int UQ = 0, UK = 256, UV = 512, UR = 1024, UNQ = 1536, UNK = 2048, UNV = 2560, UMG = 3072, UMN = 4096;
constexpr float EPS = 1e-6f;
constexpr float LOG2E = 1.4426950408889634f;
constexpr size_t O_YP = 0, O_YS = 4194304, O_NK = 6291456, O_NV = 8388608, O_SF = 10485760, O_SB = 11010048;
constexpr size_t MiB = 1u << 20;
constexpr size_t WS_CTL = 0, CTL_BYTES = 1 * MiB;
constexpr size_t WS_ADA = 1 * MiB;
constexpr size_t WS_WZT = 2 * MiB;
constexpr size_t WS_WIN = 3 * MiB;
constexpr size_t WS_WGO = 13 * MiB;
constexpr size_t WS_WNO = 14 * MiB;
constexpr size_t WS_WOUT = 15 * MiB;
constexpr size_t WS_WUP = 17 * MiB;
constexpr size_t WS_WDN = 28 * MiB;
constexpr size_t WS_H = 34 * MiB;
constexpr size_t WS_Z = 46 * MiB;
constexpr size_t WS_OG = 47 * MiB;
constexpr size_t WS_ON = 53 * MiB;
constexpr size_t WS_DEC = 59 * MiB;
constexpr size_t WS_QK = 60 * MiB;
constexpr size_t WS_KV = 72 * MiB;
constexpr size_t WS_MIX = 96 * MiB;
constexpr size_t WS_U = 108 * MiB;
constexpr size_t WS_U2 = 168 * MiB;
constexpr size_t WS_ACT = 108 * MiB;
constexpr size_t WS_END = 234 * MiB;

constexpr int NWAVES = 8, NTHR = 512;
constexpr int LDS_BYTES = 147456;
constexpr int RING_BYTES = 131072;
constexpr int MISC_OFF = RING_BYTES + 8192;

__device__ __forceinline__ unsigned cvtpk(float lo, float hi) { f32x2 v = {lo, hi}; bf16x2_t b = __builtin_convertvector(v, bf16x2_t); return __builtin_bit_cast(unsigned, b); }
__device__ __forceinline__ float bflo(unsigned u) { return __uint_as_float(u << 16); }
__device__ __forceinline__ float bfhi(unsigned u) { return __uint_as_float(u & 0xffff0000u); }
__device__ __forceinline__ float wave_sum(float v) {
#pragma unroll
    for (int o = 1; o < 64; o <<= 1) v += __shfl_xor(v, o);
    return v;
}
__device__ __forceinline__ float sigmoidf_(float x) { return 1.f / (1.f + __expf(-x)); }
__device__ __forceinline__ float siluf_(float x) { return x / (1.f + __expf(-x)); }
__device__ __forceinline__ int crow(int r, int hi) { return (r & 3) + 8 * (r >> 2) + 4 * hi; }
__device__ __forceinline__ s16x4 vtr(const LAS void* p) { typedef short v4i16_t __attribute__((ext_vector_type(4))); return __builtin_bit_cast(s16x4, __builtin_amdgcn_ds_read_tr16_b64_v4i16((LAS v4i16_t*)p)); }
__device__ __forceinline__ bf16x8 cat8(s16x4 lo, s16x4 hi) { return (bf16x8){lo[0], lo[1], lo[2], lo[3], hi[0], hi[1], hi[2], hi[3]}; }
__device__ __forceinline__ void unpack8(u32x4 v, float (&f)[8]) { f[0] = bflo(v.x); f[1] = bfhi(v.x); f[2] = bflo(v.y); f[3] = bfhi(v.y); f[4] = bflo(v.z); f[5] = bfhi(v.z); f[6] = bflo(v.w); f[7] = bfhi(v.w); }
__device__ __forceinline__ u32x4 pack8(const float (&f)[8]) { u32x4 v; v.x = cvtpk(f[0], f[1]); v.y = cvtpk(f[2], f[3]); v.z = cvtpk(f[4], f[5]); v.w = cvtpk(f[6], f[7]); return v; }

namespace pg8 {
constexpr int BM = 256, BK = 64, HALF = 128, HTB = HALF * BK * 2, STAGE_BYTES = 8 * HTB, NXCD = 8, WGM = 8;
__host__ __device__ __forceinline__ int lds_byte(int r, int c) { const int st = (r >> 4) * 2 + (c >> 5), rr = r & 15, cc = c & 31, ob = rr * 64 + cc * 2; return st * 1024 + (ob ^ (((ob >> 9) & 1) << 5)); }
__host__ __device__ __forceinline__ void stage_rc(int b, int& R, int& C) { const int st = b / 1024, sb = b % 1024, swz = sb ^ (((sb >> 9) & 1) << 5); R = (st >> 1) * 16 + swz / 64; C = (st & 1) * 32 + (swz % 64) / 2; }
__host__ __device__ __forceinline__ int perm32(int rho) { const int n = rho >> 4, i = rho & 15; return 8 * (i >> 2) + 4 * n + (i & 3); }

struct Unit { int pm, pn; const char* A; const char* B; int chain; };

struct StaticOrder {
    int nM, nN, nwg, G, c; const char* Ab; const char* Bb; size_t tstep;
    __device__ void init(const void* A, const void* Bt, int M, int N, int K, int G_, int c_) { nM = M / BM; nN = N / BM; nwg = nM * nN; G = G_; c = c_; Ab = (const char*)A; Bb = (const char*)Bt; tstep = (size_t)BM * K * 2; }
    __device__ bool next(int i, Unit& u) const {
        const long L = (long)i * G + c; if (L >= nwg) return false;
        int wgid = (int)L; { const int q = nwg / NXCD, r = nwg % NXCD, xcd = wgid % NXCD, off = wgid / NXCD; wgid = (xcd < r ? xcd * (q + 1) : r * (q + 1) + (xcd - r) * q) + off; }
        const int nig = WGM * nN, gid = wgid / nig, fm = gid * WGM, gsz = (nM - fm) < WGM ? (nM - fm) : WGM;
        u.pm = fm + ((wgid % nig) % gsz); u.pn = (wgid % nig) / gsz; u.A = Ab + (size_t)u.pm * tstep; u.B = Bb + (size_t)u.pn * tstep; u.chain = 0; return true;
    }
};
struct PairOrder {
    int nM, nN, nwg, G, c; const char *A0, *B0, *A1, *B1; size_t tstep;
    __device__ void init(const void* a0, const void* b0, const void* a1, const void* b1, int M, int N, int K, int G_, int c_) { nM = M / BM; nN = N / BM; nwg = nM * nN; G = G_; c = c_; A0 = (const char*)a0; B0 = (const char*)b0; A1 = (const char*)a1; B1 = (const char*)b1; tstep = (size_t)BM * K * 2; }
    __device__ bool next(int i, Unit& u) const {
        const long L = (long)(i >> 1) * G + c; if (L >= nwg) return false;
        const int t = (int)L; u.pm = t / nN; u.pn = t % nN;
        if (i & 1) { u.A = A1 + (size_t)u.pm * tstep; u.B = B1 + (size_t)u.pn * tstep; u.chain = 0; } else { u.A = A0 + (size_t)u.pm * tstep; u.B = B0 + (size_t)u.pn * tstep; u.chain = 1; }
        return true;
    }
};

struct EpiBf16 {
    static constexpr bool PERM = true, HAS_CHAIN = false;
    bf16_t* O; int ldc;
    __device__ __forceinline__ void chain(f32x4 (&)[2][2][4][2], const Unit&, int, int, int, int) const {}
    __device__ __forceinline__ void operator()(const f32x4 (&acc)[2][2][4][2], const Unit& u, int wr, int wc, int fr, int fq) const {
        const int row0 = u.pm * BM + wr * 64 + fr, col0 = u.pn * BM + wc * 32 + 8 * fq;
#pragma unroll
        for (int ai = 0; ai < 2; ++ai)
#pragma unroll
            for (int m = 0; m < 4; ++m) { bf16_t* rowp = O + (size_t)(row0 + ai * HALF + m * 16) * ldc + col0;
#pragma unroll
                for (int bj = 0; bj < 2; ++bj) { const f32x4 v0 = acc[ai][bj][m][0], v1 = acc[ai][bj][m][1];
                    u32x4 w; w.x = cvtpk(v0[0], v0[1]); w.y = cvtpk(v0[2], v0[3]); w.z = cvtpk(v1[0], v1[1]); w.w = cvtpk(v1[2], v1[3]);
                    *(u32x4*)(rowp + bj * HALF) = w; } }
    }
};
struct EpiResid {
    static constexpr bool PERM = false, HAS_CHAIN = false;
    const float* b0; const float* b1; float* out; const float* gate;
    __device__ __forceinline__ void chain(f32x4 (&)[2][2][4][2], const Unit&, int, int, int, int) const {}
    __device__ __forceinline__ void operator()(const f32x4 (&acc)[2][2][4][2], const Unit& u, int wr, int wc, int fr, int fq) const {
        const int rowt = u.pm * BM; const int cond = rowt < NCTX ? 0 : 1 + ((rowt - NCTX) >> 10);
        const float* base = rowt < NCTX ? b0 + (size_t)rowt * DM : b1 + (size_t)(rowt - NCTX) * DM;
        const int r0 = wr * 64 + fr, col0 = u.pn * BM + wc * 32 + 4 * fq;
        f32x4 gv[2][2];
#pragma unroll
        for (int bj = 0; bj < 2; ++bj)
#pragma unroll
            for (int n = 0; n < 2; ++n) gv[bj][n] = *(const f32x4*)(gate + cond * 6144 + col0 + bj * HALF + n * 16);
#pragma unroll
        for (int ai = 0; ai < 2; ++ai)
#pragma unroll
            for (int m = 0; m < 4; ++m) { const int r = r0 + ai * HALF + m * 16; const float* bp = base + (size_t)r * DM + col0; float* op = out + (size_t)(rowt + r) * DM + col0;
#pragma unroll
                for (int bj = 0; bj < 2; ++bj)
#pragma unroll
                    for (int n = 0; n < 2; ++n) { const f32x4 bs = *(const f32x4*)(bp + bj * HALF + n * 16); *(f32x4*)(op + bj * HALF + n * 16) = bs + gv[bj][n] * acc[ai][bj][m][n]; } }
    }
};
struct EpiGate {
    static constexpr bool PERM = true, HAS_CHAIN = true;
    const bf16_t* U; bf16_t* O;
    __device__ __forceinline__ void chain(f32x4 (&acc)[2][2][4][2], const Unit& u, int wr, int wc, int fr, int fq) const {
        const int row0 = u.pm * BM + wr * 64 + fr, col0 = u.pn * BM + wc * 32 + 8 * fq;
#pragma unroll
        for (int ai = 0; ai < 2; ++ai)
#pragma unroll
            for (int m = 0; m < 4; ++m) { const bf16_t* up = U + (size_t)(row0 + ai * HALF + m * 16) * NU + col0;
#pragma unroll
                for (int bj = 0; bj < 2; ++bj) { float mg[8], mn[8]; unpack8(*(const u32x4*)(up + UMG + bj * HALF), mg); unpack8(*(const u32x4*)(up + UMN + bj * HALF), mn);
#pragma unroll
                    for (int n = 0; n < 2; ++n)
#pragma unroll
                        for (int e = 0; e < 4; ++e) acc[ai][bj][m][n][e] *= (1.f + __expf(-mn[4 * n + e])) / (1.f + __expf(-mg[4 * n + e])); } }
    }
    __device__ __forceinline__ void operator()(const f32x4 (&acc)[2][2][4][2], const Unit& u, int wr, int wc, int fr, int fq) const {
        const int row0 = u.pm * BM + wr * 64 + fr, col0 = u.pn * BM + wc * 32 + 8 * fq;
#pragma unroll
        for (int ai = 0; ai < 2; ++ai)
#pragma unroll
            for (int m = 0; m < 4; ++m) { const size_t row = (size_t)(row0 + ai * HALF + m * 16); const bf16_t* up = U + row * NU + col0; bf16_t* op = O + row * DM + col0;
#pragma unroll
                for (int bj = 0; bj < 2; ++bj) { float mn[8], o[8]; unpack8(*(const u32x4*)(up + UMN + bj * HALF), mn);
#pragma unroll
                    for (int n = 0; n < 2; ++n)
#pragma unroll
                        for (int e = 0; e < 4; ++e) o[4 * n + e] = acc[ai][bj][m][n][e] * sigmoidf_(mn[4 * n + e]);
                    *(u32x4*)(op + bj * HALF) = pack8(o); } }
    }
};

template <class Epi, class Sched>
__device__ __forceinline__ void gemm_phase(LAS unsigned char* lds, const int K, const Sched& S, const Epi& E) {
    const int tid = threadIdx.x, wid = __builtin_amdgcn_readfirstlane(tid >> 6), lane = tid & 63, wr = wid >> 2, wc = wid & 3, fr = lane & 15, fq = lane >> 4;
    const int nt = K / BK;
    unsigned voffA[2], voffB[2];
#pragma unroll
    for (int i = 0; i < 2; ++i) { int R, C; stage_rc(tid * 16 + i * 8192, R, C); const int Rb = Epi::PERM ? ((R & ~31) + perm32(R & 31)) : R;
        voffA[i] = (unsigned)(R * K + C) * 2u; voffB[i] = (unsigned)(Rb * K + C) * 2u; }
    const size_t kstep = (size_t)(BK * 2);
    const size_t hstep = (size_t)HALF * K * 2;
    const unsigned ldsw = (unsigned)wid * 1024u;
    const int aoff = lds_byte(wr * 64 + fr, fq * 8), boff = lds_byte(wc * 32 + fr, fq * 8);
#define PG8_SA(b, h) (((b) * 2 + (h)) * HTB)
#define PG8_SB(b, h) ((4 + (b) * 2 + (h)) * HTB)
#define PG8_STAGE(bufoff, gbase, voff) do { _Pragma("unroll") for (int _i = 0; _i < 2; ++_i) \
        __builtin_amdgcn_global_load_lds((const unsigned*)((const char*)(gbase) + (voff)[_i]), (LAS unsigned*)(lds + (bufoff) + ldsw + _i * 8192), 16, 0, 0); } while (0)
#define PG8_LDA(dst, b, h) do { _Pragma("unroll") for (int m = 0; m < 4; ++m) _Pragma("unroll") for (int k = 0; k < 2; ++k) dst[m][k] = *(const LAS bf16x8*)(lds + PG8_SA(b, h) + aoff + m * 2048 + k * 1024); } while (0)
#define PG8_LDB(dst, b, h) do { _Pragma("unroll") for (int n = 0; n < 2; ++n) _Pragma("unroll") for (int k = 0; k < 2; ++k) dst[n][k] = *(const LAS bf16x8*)(lds + PG8_SB(b, h) + boff + n * 2048 + k * 1024); } while (0)
#define PG8_MMA(ai, bj, At, Bt) do { __builtin_amdgcn_s_setprio(1); _Pragma("unroll") for (int m = 0; m < 4; ++m) _Pragma("unroll") for (int n = 0; n < 2; ++n) _Pragma("unroll") for (int k = 0; k < 2; ++k) \
        acc[ai][bj][m][n] = __builtin_amdgcn_mfma_f32_16x16x32_bf16(Bt[n][k], At[m][k], acc[ai][bj][m][n], 0, 0, 0); __builtin_amdgcn_s_setprio(0); } while (0)
#define PG8_WAIT_V(n) asm volatile("s_waitcnt vmcnt(" #n ")" ::: "memory")
#define PG8_WAIT_L(n) asm volatile("s_waitcnt lgkmcnt(" #n ")" ::: "memory")
#define PG8_BAR __builtin_amdgcn_s_barrier()
#define PG8_SCHED __builtin_amdgcn_sched_barrier(0)
    Unit cur, nxt; int ui = 0;
    if (!S.next(0, cur)) return;
    f32x4 acc[2][2][4][2];
#pragma unroll
    for (int a = 0; a < 2; ++a)
#pragma unroll
        for (int b = 0; b < 2; ++b)
#pragma unroll
            for (int m = 0; m < 4; ++m)
#pragma unroll
                for (int n = 0; n < 2; ++n) acc[a][b][m][n] = (f32x4){0.f, 0.f, 0.f, 0.f};
    bf16x8 At[4][2], B0[2][2], B1[2][2];
    const char* cA = cur.A; const char* cB = cur.B;
    PG8_STAGE(PG8_SB(0, 0), cB, voffB); PG8_STAGE(PG8_SB(0, 1), cB + hstep, voffB); PG8_STAGE(PG8_SA(0, 0), cA, voffA); PG8_STAGE(PG8_SA(0, 1), cA + hstep, voffA);
    if (wr == 1) PG8_BAR;
    PG8_WAIT_V(2); PG8_BAR;
    PG8_STAGE(PG8_SB(1, 0), cB + kstep, voffB); PG8_STAGE(PG8_SA(1, 0), cA + kstep, voffA); PG8_STAGE(PG8_SB(1, 1), cB + hstep + kstep, voffB);
    PG8_WAIT_V(6); PG8_BAR;
    for (;;) {
        const bool has_next = S.next(ui + 1, nxt);
        const char* nA = has_next ? nxt.A : cA; const char* nB = has_next ? nxt.B : cB;
        for (int t = 0; t < nt; t += 2) {
            const bool last = (t == nt - 2);
            const char* a1 = cA + (size_t)(t + 1) * kstep;
            const char* a2 = last ? nA : cA + (size_t)(t + 2) * kstep; const char* b2 = last ? nB : cB + (size_t)(t + 2) * kstep;
            const char* a3 = a2 + kstep; const char* b3 = b2 + kstep;
            PG8_LDB(B0, 0, 0); PG8_LDB(B1, 0, 1); PG8_SCHED; PG8_LDA(At, 0, 0); PG8_STAGE(PG8_SA(1, 1), a1 + hstep, voffA);
            PG8_WAIT_V(8); PG8_WAIT_L(0); PG8_BAR; PG8_MMA(0, 0, At, B0); PG8_MMA(0, 1, At, B1); PG8_BAR; PG8_SCHED;
            PG8_LDA(At, 0, 1); PG8_STAGE(PG8_SB(0, 0), b2, voffB); PG8_STAGE(PG8_SB(0, 1), b2 + hstep, voffB); PG8_STAGE(PG8_SA(0, 0), a2, voffA);
            PG8_WAIT_V(8); PG8_WAIT_L(0); PG8_BAR; PG8_MMA(1, 0, At, B0); PG8_MMA(1, 1, At, B1); PG8_BAR; PG8_SCHED;
            PG8_LDB(B0, 1, 0); PG8_LDB(B1, 1, 1); PG8_SCHED; PG8_LDA(At, 1, 0); PG8_STAGE(PG8_SA(0, 1), a2 + hstep, voffA);
            PG8_WAIT_V(8); PG8_WAIT_L(0); PG8_BAR; PG8_MMA(0, 0, At, B0); PG8_MMA(0, 1, At, B1); PG8_BAR; PG8_SCHED;
            PG8_LDA(At, 1, 1); PG8_STAGE(PG8_SB(1, 0), b3, voffB); PG8_STAGE(PG8_SB(1, 1), b3 + hstep, voffB); PG8_STAGE(PG8_SA(1, 0), a3, voffA);
            PG8_WAIT_V(8); PG8_WAIT_L(0); PG8_BAR; PG8_MMA(1, 0, At, B0); PG8_MMA(1, 1, At, B1); PG8_BAR; PG8_SCHED;
        }
        if (wr == 0) PG8_BAR;
        if (Epi::HAS_CHAIN && cur.chain) { E.chain(acc, cur, wr, wc, fr, fq); }
        else {
            E(acc, cur, wr, wc, fr, fq);
#pragma unroll
            for (int a = 0; a < 2; ++a)
#pragma unroll
                for (int b = 0; b < 2; ++b)
#pragma unroll
                    for (int m = 0; m < 4; ++m)
#pragma unroll
                        for (int n = 0; n < 2; ++n) acc[a][b][m][n] = (f32x4){0.f, 0.f, 0.f, 0.f};
        }
        if (!has_next) break;
        cur = nxt; cA = nA; cB = nB; ++ui;
        if (wr == 1) PG8_BAR;
    }
    PG8_WAIT_V(0);
    PG8_BAR;
#undef PG8_SA
#undef PG8_SB
#undef PG8_STAGE
#undef PG8_LDA
#undef PG8_LDB
#undef PG8_MMA
#undef PG8_WAIT_V
#undef PG8_WAIT_L
#undef PG8_BAR
#undef PG8_SCHED
}
}

struct Frame {
    LAS unsigned char* lds;
    int tid, lane, wave, G, bid;
    const float* in[28];
    float* out; unsigned char* ws;
    __device__ __forceinline__ const float* xrow(int m) const { return m < NCTX ? in[0] + (size_t)m * DM : in[1] + (size_t)(m - NCTX) * DM; }
};
__device__ __forceinline__ int cond_of(int m) { return m < NCTX ? 0 : 1 + ((m - NCTX) >> 10); }

__device__ __forceinline__ void p0_transpose_item(const float* W, int N, int K, bf16_t* WT, int k0, int n0, int drow0, LAS float* scr, int lane) {
#pragma unroll 8
    for (int i = 0; i < 32; ++i) { const int kk = 2 * i + (lane >> 5); scr[kk * 33 + (lane & 31)] = W[(size_t)(k0 + kk) * N + n0 + (lane & 31)]; }
    asm volatile("s_waitcnt lgkmcnt(0)" ::: "memory");
    const int c = lane & 7;
#pragma unroll
    for (int j = 0; j < 4; ++j) { const int n = (lane >> 3) + 8 * j; const LAS float* s = scr + (8 * c) * 33 + n;
        u32x4 o; o.x = cvtpk(s[0 * 33], s[1 * 33]); o.y = cvtpk(s[2 * 33], s[3 * 33]); o.z = cvtpk(s[4 * 33], s[5 * 33]); o.w = cvtpk(s[6 * 33], s[7 * 33]);
        *(u32x4*)(WT + (size_t)(drow0 + n) * K + k0 + 8 * c) = o; }
    asm volatile("s_waitcnt lgkmcnt(0)" ::: "memory");
}
__device__ __forceinline__ void p0_prologue(Frame& F) {
    {
        LAS float* sc = (LAS float*)(F.lds);
        LAS float* red = (LAS float*)(F.lds + 12288);
        for (int i = F.tid; i < 3072; i += NTHR) { const int c = i >> 10, k = i & 1023; const float v = c == 0 ? F.in[7][k] : F.in[2][(c - 1) * 1024 + k]; sc[i] = siluf_(v); }
        __syncthreads();
        const float* wada = F.in[8]; const float* bada = F.in[9]; float* ada = (float*)(F.ws + WS_ADA);
        for (int cb = F.bid; cb < 256; cb += F.G) {
            if (F.tid < 384) {
                const int cq = F.tid % 6, kg = F.tid / 6;
                f32x4 a0 = {0.f, 0.f, 0.f, 0.f}, a1 = a0, a2 = a0;
#pragma unroll 4
                for (int kk = 0; kk < 16; ++kk) { const int k = 16 * kg + kk; const f32x4 w = *(const f32x4*)(wada + (size_t)k * 6144 + 24 * cb + 4 * cq);
                    a0 += w * sc[k]; a1 += w * sc[1024 + k]; a2 += w * sc[2048 + k]; }
#pragma unroll
                for (int e = 0; e < 4; ++e) { red[(0 * 64 + kg) * 24 + 4 * cq + e] = a0[e]; red[(1 * 64 + kg) * 24 + 4 * cq + e] = a1[e]; red[(2 * 64 + kg) * 24 + 4 * cq + e] = a2[e]; }
            }
            __syncthreads();
            if (F.tid < 72) { const int c = F.tid / 24, col = F.tid % 24; float s = 0.f;
                for (int kg = 0; kg < 64; ++kg) s += red[(c * 64 + kg) * 24 + col];
                ada[c * 6144 + 24 * cb + col] = s + bada[24 * cb + col]; }
            __syncthreads();
        }
    }
    LAS float* scr = (LAS float*)(F.lds + F.wave * 16384);
    const int gw = F.bid * NWAVES + F.wave, NGW = F.G * NWAVES;
    constexpr int I_IN = 16 * 161, I_GO = 8 * 32, I_NO = 8 * 32, I_OUT = 16 * 32, I_UP = 16 * 176, I_DN = 44 * 32;
    constexpr int NITEMS = I_IN + I_GO + I_NO + I_OUT + I_UP + I_DN;
    for (int it = gw; it < NITEMS; it += NGW) {
        int r = it;
        if (r < I_IN) { const int kb = r / 161, nb = r % 161;
            if (nb == 48) p0_transpose_item(F.in[11], DIN, 1024, (bf16_t*)(F.ws + WS_WZT), 64 * kb, 32 * nb, 0, scr, F.lane);
            else p0_transpose_item(F.in[11], DIN, 1024, (bf16_t*)(F.ws + WS_WIN), 64 * kb, 32 * nb, 32 * nb - (nb > 48 ? 32 : 0), scr, F.lane);
            continue; } r -= I_IN;
        if (r < I_GO) { p0_transpose_item(F.in[20], 1024, 512, (bf16_t*)(F.ws + WS_WGO), 64 * (r / 32), 32 * (r % 32), 32 * (r % 32), scr, F.lane); continue; } r -= I_GO;
        if (r < I_NO) { p0_transpose_item(F.in[21], 1024, 512, (bf16_t*)(F.ws + WS_WNO), 64 * (r / 32), 32 * (r % 32), 32 * (r % 32), scr, F.lane); continue; } r -= I_NO;
        if (r < I_OUT) { p0_transpose_item(F.in[22], 1024, 1024, (bf16_t*)(F.ws + WS_WOUT), 64 * (r / 32), 32 * (r % 32), 32 * (r % 32), scr, F.lane); continue; } r -= I_OUT;
        if (r < I_UP) { p0_transpose_item(F.in[24], NUP, 1024, (bf16_t*)(F.ws + WS_WUP), 64 * (r / 176), 32 * (r % 176), 32 * (r % 176), scr, F.lane); continue; } r -= I_UP;
        p0_transpose_item(F.in[27], 1024, DFF, (bf16_t*)(F.ws + WS_WDN), 64 * (r / 32), 32 * (r % 32), 32 * (r % 32), scr, F.lane);
    }
}

template <bool FROM_OUT>
__device__ __forceinline__ void norm_rows(Frame& F, const float* g, int off_sh, int off_sc) {
    const int gw = F.bid * NWAVES + F.wave, NGW = F.G * NWAVES;
    const float* ada = (const float*)(F.ws + WS_ADA);
    bf16_t* H = (bf16_t*)(F.ws + WS_H);
    for (int m = gw; m < MTOK; m += NGW) {
        const float* xr = FROM_OUT ? F.out + (size_t)m * DM : F.xrow(m);
        const float* ad = ada + cond_of(m) * 6144;
        f32x4 v[4]; float s = 0.f;
#pragma unroll
        for (int j = 0; j < 4; ++j) { v[j] = *(const f32x4*)(xr + 4 * F.lane + 256 * j); s += (v[j].x * v[j].x + v[j].y * v[j].y) + (v[j].z * v[j].z + v[j].w * v[j].w); }
        const float rinv = rsqrtf(wave_sum(s) * (1.f / DM) + EPS);
#pragma unroll
        for (int j = 0; j < 4; ++j) { const int c = 4 * F.lane + 256 * j;
            const f32x4 gg = *(const f32x4*)(g + c), sc = *(const f32x4*)(ad + off_sc + c), sh = *(const f32x4*)(ad + off_sh + c);
            const f32x4 o = v[j] * rinv * gg * (sc + 1.f) + sh;
            u32x2 w; w.x = cvtpk(o[0], o[1]); w.y = cvtpk(o[2], o[3]);
            *(u32x2*)(H + (size_t)m * DM + c) = w; }
    }
}

__device__ __forceinline__ void z_item(Frame& F, int j) {
    const bf16_t* H = (const bf16_t*)(F.ws + WS_H); const bf16_t* WzT = (const bf16_t*)(F.ws + WS_WZT); float* Z = (float*)(F.ws + WS_Z);
    const int r = F.lane & 31, hh = F.lane >> 5, row0 = 256 * j + 32 * F.wave;
    const bf16_t* ap = H + (size_t)(row0 + r) * DM + 8 * hh; const bf16_t* bp = WzT + (size_t)r * DM + 8 * hh;
    f32x16 acc = {};
#pragma unroll 8
    for (int ks = 0; ks < 64; ++ks) { const bf16x8 a = *(const bf16x8*)(ap + 16 * ks), b = *(const bf16x8*)(bp + 16 * ks); acc = __builtin_amdgcn_mfma_f32_32x32x16_bf16(a, b, acc, 0, 0, 0); }
#pragma unroll
    for (int i = 0; i < 16; ++i) Z[(size_t)(row0 + crow(i, hh)) * 32 + r] = acc[i];
}

__device__ __forceinline__ void kvout_rows(Frame& F, int m0, int nrows) {
    const bf16_t* U = (const bf16_t*)(F.ws + WS_U);
    const float* gk = F.in[18];
    for (int i = F.wave; i < nrows; i += NWAVES) {
        const int m = m0 + i;
        float k[8], v[8];
        unpack8(*(const u32x4*)(U + (size_t)m * NU + UNK + 8 * F.lane), k);
        unpack8(*(const u32x4*)(U + (size_t)m * NU + UNV + 8 * F.lane), v);
        float s = 0.f;
#pragma unroll
        for (int e = 0; e < 8; ++e) s += k[e] * k[e];
        s += __shfl_xor(s, 1); s += __shfl_xor(s, 2); s += __shfl_xor(s, 4);
        const float rinv = rsqrtf(s * (1.f / 64.f) + EPS);
        const int d0 = (8 * F.lane) & 63;
        f32x4 o0, o1;
#pragma unroll
        for (int e = 0; e < 4; ++e) { o0[e] = k[e] * rinv * gk[d0 + e]; o1[e] = k[4 + e] * rinv * gk[d0 + 4 + e]; }
        float* ok = F.out + O_NK + (size_t)m * 512 + 8 * F.lane; float* ov = F.out + O_NV + (size_t)m * 512 + 8 * F.lane;
        *(f32x4*)ok = o0; *(f32x4*)(ok + 4) = o1;
        *(f32x4*)ov = (f32x4){v[0], v[1], v[2], v[3]}; *(f32x4*)(ov + 4) = (f32x4){v[4], v[5], v[6], v[7]};
    }
}


namespace nv {
__device__ __forceinline__ float bf(const bf16_t* p) { return __uint_as_float((unsigned)(*p) << 16); }
__device__ __forceinline__ bf16_t tobf(float f) { return (bf16_t)(cvtpk(f, 0.f) & 0xffffu); }
__device__ __forceinline__ float logsig(float x) { return fminf(x, 0.f) - log1pf(expf(-fabsf(x))); }

__global__ void ada_k(const float* c_ctx, const float* c, const float* w, const float* b, float* ada) {
    const int idx = blockIdx.x * blockDim.x + threadIdx.x; if (idx >= 3 * 6144) return;
    const int cn = idx / 6144, j = idx % 6144; const float* cond = cn == 0 ? c_ctx : c + (cn - 1) * 1024;
    float s = b[j];
    for (int k = 0; k < 1024; ++k) { const float v = cond[k]; s += (v / (1.f + expf(-v))) * w[(size_t)k * 6144 + j]; }
    ada[idx] = s;
}
__global__ void norm_k(const float* x0, const float* x1, const float* g, const float* ada, int off_sh, int off_sc, bf16_t* H) {
    __shared__ float red[256];
    const int m = blockIdx.x; const float* xr = m < NCTX ? x0 + (size_t)m * DM : x1 + (size_t)(m - NCTX) * DM;
    float s = 0.f; for (int k = threadIdx.x; k < DM; k += 256) s += xr[k] * xr[k];
    red[threadIdx.x] = s; __syncthreads();
    for (int o = 128; o > 0; o >>= 1) { if (threadIdx.x < o) red[threadIdx.x] += red[threadIdx.x + o]; __syncthreads(); }
    const float rinv = rsqrtf(red[0] / DM + EPS); const float* ad = ada + cond_of(m) * 6144;
    for (int k = threadIdx.x; k < DM; k += 256) H[(size_t)m * DM + k] = tobf(xr[k] * rinv * g[k] * (1.f + ad[off_sc + k]) + ad[off_sh + k]);
}
template <class F> __global__ void gemm_k(const bf16_t* A, int K, const float* W, int ldw, int M, int N, F f) {
    const size_t idx = (size_t)blockIdx.x * blockDim.x + threadIdx.x; if (idx >= (size_t)M * N) return;
    const int m = (int)(idx / N), n = (int)(idx % N);
    float s = 0.f; const bf16_t* a = A + (size_t)m * K;
    for (int k = 0; k < K; ++k) s += bf(a + k) * W[(size_t)k * ldw + n];
    f(m, n, s);
}
struct StIn { bf16_t* U; float* Z; __device__ void operator()(int m, int n, float s) const { if (n >= 1536 && n < 1568) Z[(size_t)m * 32 + n - 1536] = s; else U[(size_t)m * NU + n - (n >= 1568 ? 32 : 0)] = tobf(s); } };
struct StBf { bf16_t* O; int ld; __device__ void operator()(int m, int n, float s) const { O[(size_t)m * ld + n] = tobf(s); } };
struct StF32 { float* O; int ld; __device__ void operator()(int m, int n, float s) const { O[(size_t)m * ld + n] = s; } };
struct StRes { const float* b0; const float* b1; float* out; const float* gate; __device__ void operator()(int m, int n, float s) const {
    const float base = m < NCTX ? b0[(size_t)m * DM + n] : b1[(size_t)(m - NCTX) * DM + n]; out[(size_t)m * DM + n] = base + gate[cond_of(m) * 6144 + n] * s; } };

__global__ void kvout_k(const bf16_t* U, const float* gk, float* out) {
    const int idx = blockIdx.x * blockDim.x + threadIdx.x; if (idx >= NCTX * 8) return;
    const int m = idx / 8, h = idx % 8; const bf16_t* k = U + (size_t)m * NU + UNK + 64 * h; const bf16_t* v = U + (size_t)m * NU + UNV + 64 * h;
    float s = 0.f; for (int d = 0; d < 64; ++d) s += bf(k + d) * bf(k + d);
    const float rinv = rsqrtf(s / 64.f + EPS);
    for (int d = 0; d < 64; ++d) { out[O_NK + (size_t)m * 512 + 64 * h + d] = bf(k + d) * rinv * gk[d]; out[O_NV + (size_t)m * 512 + 64 * h + d] = bf(v + d); }
}
__global__ void decay_k(const float* Z, const float* waf, const float* baf, const float* wab, const float* bab, float* Adec) {
    const int idx = blockIdx.x * blockDim.x + threadIdx.x; if (idx >= 2 * MTOK * 256) return;
    const int dir = idx / (MTOK * 256), m = (idx / 256) % MTOK, c = idx % 256; const float* w = dir ? wab : waf; const float* b = dir ? bab : baf;
    float s = b[c]; for (int j = 0; j < 16; ++j) s += Z[(size_t)m * 32 + 16 * dir + j] * w[j * 256 + c];
    Adec[idx] = expf(logsig(s) / 16.f);
}
__global__ void __launch_bounds__(256) gla_k(const bf16_t* U, const float* Adec, const float* s0f, const float* s0b, float* OT, float* out) {
    const int idx = blockIdx.x * blockDim.x + threadIdx.x; if (idx >= 18 * 4 * 2 * 128) return;
    const int dv = idx % 128, dir = (idx / 128) % 2, h = (idx / 256) % 4, seq = idx / 1024;
    const int T = seq < 16 ? 256 : 1024, base = seq < 16 ? seq * 256 : NCTX + (seq - 16) * 1024;
    float S[64];
    if (seq < 16) { for (int d = 0; d < 64; ++d) S[d] = 0.f; }
    else { const float* s0 = (dir ? s0b : s0f) + ((size_t)((seq - 16) * 4 + h) * 64) * 128; for (int d = 0; d < 64; ++d) S[d] = s0[d * 128 + dv]; }
    for (int st = 0; st < T; ++st) {
        const int m = base + (dir ? T - 1 - st : st);
        const bf16_t* u = U + (size_t)m * NU; const float v = bf(u + UV + 128 * h + dv); const float* a = Adec + ((size_t)dir * MTOK + m) * 256 + 64 * h;
        float o = 0.f;
#pragma unroll
        for (int d = 0; d < 64; ++d) { S[d] = a[d] * S[d] + bf(u + UK + 64 * h + d) * v; o += bf(u + UQ + 64 * h + d) * 0.125f * S[d]; }
        OT[((size_t)dir * MTOK + m) * 512 + 128 * h + dv] = o;
    }
    if (seq < 16) { float* os = out + (dir ? O_SB : O_SF) + ((size_t)(seq * 4 + h) * 64) * 128; for (int d = 0; d < 64; ++d) os[d * 128 + dv] = S[d]; }
}
__global__ void glanorm_k(const float* OT, const bf16_t* U, const float* gg, bf16_t* OG) {
    const int idx = blockIdx.x * blockDim.x + threadIdx.x; if (idx >= MTOK * 4) return;
    const int m = idx / 4, h = idx % 4; const float* a = OT + (size_t)m * 512 + 128 * h; const float* b = OT + ((size_t)MTOK + m) * 512 + 128 * h;
    float s = 0.f; for (int d = 0; d < 128; ++d) { const float o = a[d] + b[d]; s += o * o; }
    const float rinv = rsqrtf(s / 128.f + EPS);
    for (int d = 0; d < 128; ++d) { const float r = bf(U + (size_t)m * NU + UR + 128 * h + d); OG[(size_t)m * 512 + 128 * h + d] = tobf((a[d] + b[d]) * rinv * gg[d] * (r / (1.f + expf(-r)))); }
}
__global__ void __launch_bounds__(256) attn_k(const bf16_t* U, const float* gq, const float* gk, const float* ck, const float* cv, const float* rpb, bf16_t* ON) {
    const int idx = blockIdx.x * blockDim.x + threadIdx.x; if (idx >= MTOK * 16) return;
    const int m = idx / 16, h = (idx % 16) / 2, part = idx % 2;
    float q[64]; { float s = 0.f; const bf16_t* qp = U + (size_t)m * NU + UNQ + 64 * h;
#pragma unroll
        for (int d = 0; d < 64; ++d) { q[d] = bf(qp + d); s += q[d] * q[d]; }
        const float rinv = rsqrtf(s / 64.f + EPS);
#pragma unroll
        for (int d = 0; d < 64; ++d) q[d] *= rinv * gq[d] * 0.125f; }
    float mx = -INFINITY, l = 0.f, o[32];
#pragma unroll
    for (int d = 0; d < 32; ++d) o[d] = 0.f;
#define NV_STEP(sc, VEXPR) do { const float sc_ = (sc); const float mn_ = fmaxf(mx, sc_), f_ = expf(mx - mn_), p_ = expf(sc_ - mn_); l = l * f_ + p_; \
        _Pragma("unroll") for (int d = 0; d < 32; ++d) o[d] = o[d] * f_ + p_ * (VEXPR); mx = mn_; } while (0)
#define NV_UKEY(tok, bias) do { const bf16_t* kp = U + (size_t)(tok) * NU + UNK + 64 * h; const bf16_t* vp = U + (size_t)(tok) * NU + UNV + 64 * h + 32 * part; \
        float s_ = 0.f, dt_ = 0.f; _Pragma("unroll") for (int d = 0; d < 64; ++d) { const float k = bf(kp + d); s_ += k * k; dt_ += q[d] * k * gk[d]; } \
        NV_STEP(dt_ * rsqrtf(s_ / 64.f + EPS) + (bias), bf(vp + d)); } while (0)
    if (m < NCTX) { const int b0 = (m / 256) * 256; for (int j = 0; j < 256; ++j) NV_UKEY(b0 + j, 0.f); }
    else {
        const int bl = (m - NCTX) / 1024, t = (m - NCTX) % 1024, r = t / 64, c = t % 64;
        const int rs = min(max(r - 4, 0), 8), cs = min(max(c - 8, 0), 48);
        for (int i = 0; i < 8; ++i) for (int kc = cs; kc < cs + 16; ++kc) { const int kr = rs + i; const int dc = min(max(kc - c, -15), 15) + 15;
            NV_UKEY(NCTX + bl * 1024 + kr * 64 + kc, rpb[(h * 15 + (kr - r + 7)) * 31 + dc]); }
        for (int lk = 0; lk < 512; ++lk) { const float* kp = ck + ((size_t)(bl * 512 + lk) * 8 + h) * 64; const float* vp = cv + ((size_t)(bl * 512 + lk) * 8 + h) * 64 + 32 * part;
            float dt = 0.f;
#pragma unroll
            for (int d = 0; d < 64; ++d) dt += q[d] * kp[d];
            NV_STEP(dt, vp[d]); }
    }
#pragma unroll
    for (int d = 0; d < 32; ++d) ON[(size_t)m * 512 + 64 * h + 32 * part + d] = tobf(o[d] / l);
#undef NV_STEP
#undef NV_UKEY
}
__global__ void mix_k(const float* BG, const float* BN, const bf16_t* U, bf16_t* MIX) {
    const size_t idx = (size_t)blockIdx.x * blockDim.x + threadIdx.x; if (idx >= (size_t)MTOK * DM) return;
    const int m = (int)(idx / DM), n = (int)(idx % DM); const float mg = bf(U + (size_t)m * NU + UMG + n), mn = bf(U + (size_t)m * NU + UMN + n);
    MIX[idx] = tobf(BG[idx] / (1.f + expf(-mg)) + BN[idx] / (1.f + expf(-mn)));
}
__global__ void convgate_k(const bf16_t* U2, const float* wc, const float* bc, bf16_t* ACT) {
    const size_t idx = (size_t)blockIdx.x * blockDim.x + threadIdx.x; if (idx >= (size_t)MTOK * DFF) return;
    const int m = (int)(idx / DFF), c = (int)(idx % DFF);
    const int T = m < NCTX ? 256 : 1024, t = m < NCTX ? m % 256 : (m - NCTX) % 1024;
    float a = bc[c], g = bc[DFF + c];
    for (int j = 0; j < 3; ++j) { const int tt = t + j - 1; if (tt < 0 || tt >= T) continue; const bf16_t* u = U2 + (size_t)(m + j - 1) * NUP; a += wc[j * NUP + c] * bf(u + c); g += wc[j * NUP + DFF + c] * bf(u + DFF + c); }
    ACT[idx] = tobf(a * (g / (1.f + expf(-g))));
}
}

struct Args { const float* in[28]; float* out; unsigned char* ws; int ph_lo, ph_hi; };

__global__ void __launch_bounds__(NTHR, 2) fwd_kernel(Args args) {
    extern __shared__ __attribute__((aligned(16))) unsigned char lds_raw[];
    Frame F;
    F.lds = (LAS unsigned char*)lds_raw;
    F.tid = threadIdx.x; F.lane = F.tid & 63; F.wave = __builtin_amdgcn_readfirstlane(F.tid >> 6);
    F.G = gridDim.x; F.bid = blockIdx.x;
#pragma unroll
    for (int i = 0; i < 28; ++i) F.in[i] = args.in[i];
    F.out = args.out; F.ws = args.ws;
    const int lo = args.ph_lo, hi = args.ph_hi;
#define IN(k) (lo <= (k) && (k) < hi)
#define GRID_BAR() do { } while (0)

    if (IN(0)) { p0_prologue(F); GRID_BAR(); }
    if (IN(1)) { norm_rows<false>(F, F.in[10], 0, 1024); GRID_BAR(); }
    if (IN(2)) {
        pg8::StaticOrder S; S.init(F.ws + WS_H, F.ws + WS_WIN, MTOK, NU, DM, F.G, F.bid);
        pg8::EpiBf16 E{(bf16_t*)(F.ws + WS_U), NU};
        pg8::gemm_phase(F.lds, DM, S, E);
        for (int j = F.G - 1 - F.bid; j < 24; j += F.G) z_item(F, j);
        GRID_BAR();
    }
    if (IN(3)) {
        for (int c = F.bid; c < 256; c += F.G) kvout_rows(F, 16 * c, 16);
        GRID_BAR();
    }
#undef IN
}

#ifndef FUSED_MASK
#define FUSED_MASK 0x0u
#endif
constexpr unsigned FUSED = FUSED_MASK;
constexpr size_t WS_ADEC = 168 * MiB, WS_OT = 181 * MiB, WS_BG = 205 * MiB, WS_BN = 72 * MiB;

extern "C" void kernel_launch(void* const* d_in, const int* in_sizes, int n_in, void* d_out, int out_size, void* d_ws, size_t ws_size, hipStream_t stream) {
    static int grid = 0;
    if (grid == 0) {
        if (n_in != 28 || ws_size < WS_END) { fprintf(stderr, "kernel_launch: unexpected n_in %d / ws %zu\n", n_in, ws_size); grid = -1; return; }
        int dev = 0, cus = 0, per_cu = 0;
        (void)hipGetDevice(&dev);
        (void)hipDeviceGetAttribute(&cus, hipDeviceAttributeMultiprocessorCount, dev);
        (void)hipFuncSetAttribute((const void*)fwd_kernel, hipFuncAttributeMaxDynamicSharedMemorySize, LDS_BYTES);
        (void)hipOccupancyMaxActiveBlocksPerMultiprocessor(&per_cu, (const void*)fwd_kernel, NTHR, LDS_BYTES);
        (void)hipGetLastError();
        grid = cus;
        if (grid > 256) grid = 256;
    }
    if (grid < 0) return;
    (void)hipMemsetAsync((char*)d_ws + WS_CTL, 0, CTL_BYTES, stream);
    Args a{};
    for (int i = 0; i < 28; ++i) a.in[i] = (const float*)d_in[i];
    a.out = (float*)d_out; a.ws = (unsigned char*)d_ws;
    const float* const* in = (const float* const*)d_in;
    unsigned char* ws = (unsigned char*)d_ws; float* out = (float*)d_out;
    bf16_t *H = (bf16_t*)(ws + WS_H), *U = (bf16_t*)(ws + WS_U), *OG = (bf16_t*)(ws + WS_OG), *ON = (bf16_t*)(ws + WS_ON), *MIX = (bf16_t*)(ws + WS_MIX), *U2 = (bf16_t*)(ws + WS_U2), *ACT = (bf16_t*)(ws + WS_ACT);
    float *ADA = (float*)(ws + WS_ADA), *Z = (float*)(ws + WS_Z), *ADEC = (float*)(ws + WS_ADEC), *OT = (float*)(ws + WS_OT), *BG = (float*)(ws + WS_BG), *BN = (float*)(ws + WS_BN);
    auto fused = [&](int p) { a.ph_lo = p; a.ph_hi = p + 1; hipLaunchKernelGGL(fwd_kernel, dim3(grid), dim3(NTHR), LDS_BYTES, stream, a); };
    auto nb = [](size_t n) { return dim3((unsigned)((n + 255) / 256)); };
    if (FUSED & 1u) fused(0);
    else { if (FUSED) fused(0); hipLaunchKernelGGL(nv::ada_k, nb(3 * 6144), dim3(256), 0, stream, in[7], in[2], in[8], in[9], ADA); }
    if (FUSED & 2u) fused(1); else hipLaunchKernelGGL(nv::norm_k, dim3(MTOK), dim3(256), 0, stream, in[0], in[1], in[10], (const float*)ADA, 0, 1024, H);
    if (FUSED & 4u) fused(2); else hipLaunchKernelGGL(nv::gemm_k<nv::StIn>, nb((size_t)MTOK * DIN), dim3(256), 0, stream, (const bf16_t*)H, 1024, in[11], DIN, MTOK, DIN, nv::StIn{U, Z});
    if (FUSED & 8u) fused(3); else hipLaunchKernelGGL(nv::kvout_k, nb(NCTX * 8), dim3(256), 0, stream, (const bf16_t*)U, in[18], out);
    hipLaunchKernelGGL(nv::decay_k, nb((size_t)2 * MTOK * 256), dim3(256), 0, stream, (const float*)Z, in[12], in[13], in[14], in[15], ADEC);
    hipLaunchKernelGGL(nv::gla_k, nb(18 * 4 * 2 * 128), dim3(256), 0, stream, (const bf16_t*)U, (const float*)ADEC, in[5], in[6], OT, out);
    hipLaunchKernelGGL(nv::glanorm_k, nb(MTOK * 4), dim3(256), 0, stream, (const float*)OT, (const bf16_t*)U, in[16], OG);
    hipLaunchKernelGGL(nv::attn_k, nb(MTOK * 16), dim3(256), 0, stream, (const bf16_t*)U, in[17], in[18], in[3], in[4], in[19], ON);
    hipLaunchKernelGGL(nv::gemm_k<nv::StF32>, nb((size_t)MTOK * DM), dim3(256), 0, stream, (const bf16_t*)OG, 512, in[20], DM, MTOK, DM, nv::StF32{BG, DM});
    hipLaunchKernelGGL(nv::gemm_k<nv::StF32>, nb((size_t)MTOK * DM), dim3(256), 0, stream, (const bf16_t*)ON, 512, in[21], DM, MTOK, DM, nv::StF32{BN, DM});
    hipLaunchKernelGGL(nv::mix_k, nb((size_t)MTOK * DM), dim3(256), 0, stream, (const float*)BG, (const float*)BN, (const bf16_t*)U, MIX);
    hipLaunchKernelGGL(nv::gemm_k<nv::StRes>, nb((size_t)MTOK * DM), dim3(256), 0, stream, (const bf16_t*)MIX, DM, in[22], DM, MTOK, DM, nv::StRes{in[0], in[1], out, ADA + 2048});
    hipLaunchKernelGGL(nv::norm_k, dim3(MTOK), dim3(256), 0, stream, (const float*)out, (const float*)(out + (size_t)NCTX * DM), in[23], (const float*)ADA, 3072, 4096, H);
    hipLaunchKernelGGL(nv::gemm_k<nv::StBf>, nb((size_t)MTOK * NUP), dim3(256), 0, stream, (const bf16_t*)H, DM, in[24], NUP, MTOK, NUP, nv::StBf{U2, NUP});
    hipLaunchKernelGGL(nv::convgate_k, nb((size_t)MTOK * DFF), dim3(256), 0, stream, (const bf16_t*)U2, in[25], in[26], ACT);
    hipLaunchKernelGGL(nv::gemm_k<nv::StRes>, nb((size_t)MTOK * DM), dim3(256), 0, stream, (const bf16_t*)ACT, DFF, in[27], DM, MTOK, DM, nv::StRes{(const float*)out, (const float*)(out + (size_t)NCTX * DM), out, ADA + 5120});
}
```

```cpp
#include <hip/hip_runtime.h>
#include <cstdio>
#include <cstdint>

#ifndef ONE_LAUNCH
#define ONE_LAUNCH 1
#endif

#define LAS __attribute__((address_space(3)))
#define GAS __attribute__((address_space(1)))
typedef unsigned short bf16_t;
typedef short bf16x8 __attribute__((ext_vector_type(8)));
typedef short s16x4 __attribute__((ext_vector_type(4)));
typedef float f32x2 __attribute__((ext_vector_type(2)));
typedef float f32x4 __attribute__((ext_vector_type(4)));
typedef float f32x16 __attribute__((ext_vector_type(16)));
typedef unsigned u32x2 __attribute__((ext_vector_type(2)));
typedef unsigned u32x4 __attribute__((ext_vector_type(4)));
typedef __bf16 bf16x2_t __attribute__((ext_vector_type(2)));

constexpr int DM = 1024, NCTX = 4096, NLAT = 2048, MTOK = 6144, DIN = 5152, NU = 5120, DFF = 2816, NUP = 5632;
constexpr int UQ = 0, UK = 256, UV = 512, UR = 1024, UNQ = 1536, UNK = 2048, UNV = 2560, UMG = 3072, UMN = 4096;
constexpr float EPS = 1e-6f;
constexpr float LOG2E = 1.4426950408889634f;
constexpr size_t O_YP = 0, O_YS = 4194304, O_NK = 6291456, O_NV = 8388608, O_SF = 10485760, O_SB = 11010048;
constexpr size_t MiB = 1u << 20;
constexpr size_t WS_CTL = 0, CTL_BYTES = 1 * MiB;
constexpr size_t WS_ADA = 1 * MiB;
constexpr size_t WS_WZT = 2 * MiB;
constexpr size_t WS_WIN = 3 * MiB;
constexpr size_t WS_WGO = 13 * MiB;
constexpr size_t WS_WNO = 14 * MiB;
constexpr size_t WS_WOUT = 15 * MiB;
constexpr size_t WS_WUP = 17 * MiB;
constexpr size_t WS_WDN = 28 * MiB;
constexpr size_t WS_H = 34 * MiB;
constexpr size_t WS_Z = 46 * MiB;
constexpr size_t WS_OG = 47 * MiB;
constexpr size_t WS_ON = 53 * MiB;
constexpr size_t WS_DEC = 59 * MiB;
constexpr size_t WS_QK = 60 * MiB;
constexpr size_t WS_KV = 72 * MiB;
constexpr size_t WS_MIX = 96 * MiB;
constexpr size_t WS_U = 108 * MiB;
constexpr size_t WS_U2 = 168 * MiB;
constexpr size_t WS_ACT = 108 * MiB;
constexpr size_t WS_BG = 205 * MiB;
constexpr size_t WS_END = 234 * MiB;

constexpr int NWAVES = 8, NTHR = 512;
constexpr int LDS_BYTES = 147456;
constexpr int RING_BYTES = 131072;
constexpr int MISC_OFF = RING_BYTES + 8192;

__device__ __forceinline__ unsigned cvtpk(float lo, float hi) { f32x2 v = {lo, hi}; bf16x2_t b = __builtin_convertvector(v, bf16x2_t); return __builtin_bit_cast(unsigned, b); }
__device__ __forceinline__ float bflo(unsigned u) { return __uint_as_float(u << 16); }
__device__ __forceinline__ float bfhi(unsigned u) { return __uint_as_float(u & 0xffff0000u); }
__device__ __forceinline__ float wave_sum(float v) {
#pragma unroll
    for (int o = 1; o < 64; o <<= 1) v += __shfl_xor(v, o);
    return v;
}
__device__ __forceinline__ float sigmoidf_(float x) { return 1.f / (1.f + __expf(-x)); }
__device__ __forceinline__ float siluf_(float x) { return x / (1.f + __expf(-x)); }
__device__ __forceinline__ int crow(int r, int hi) { return (r & 3) + 8 * (r >> 2) + 4 * hi; }
__device__ __forceinline__ s16x4 vtr(const LAS void* p) { typedef short v4i16_t __attribute__((ext_vector_type(4))); return __builtin_bit_cast(s16x4, __builtin_amdgcn_ds_read_tr16_b64_v4i16((LAS v4i16_t*)p)); }
__device__ __forceinline__ bf16x8 cat8(s16x4 lo, s16x4 hi) { return (bf16x8){lo[0], lo[1], lo[2], lo[3], hi[0], hi[1], hi[2], hi[3]}; }
__device__ __forceinline__ void unpack8(u32x4 v, float (&f)[8]) { f[0] = bflo(v.x); f[1] = bfhi(v.x); f[2] = bflo(v.y); f[3] = bfhi(v.y); f[4] = bflo(v.z); f[5] = bfhi(v.z); f[6] = bflo(v.w); f[7] = bfhi(v.w); }
__device__ __forceinline__ u32x4 pack8(const float (&f)[8]) { u32x4 v; v.x = cvtpk(f[0], f[1]); v.y = cvtpk(f[2], f[3]); v.z = cvtpk(f[4], f[5]); v.w = cvtpk(f[6], f[7]); return v; }

namespace pg8 {
constexpr int BM = 256, BK = 64, HALF = 128, HTB = HALF * BK * 2, STAGE_BYTES = 8 * HTB, NXCD = 8, WGM = 8;
__host__ __device__ __forceinline__ int lds_byte(int r, int c) { const int st = (r >> 4) * 2 + (c >> 5), rr = r & 15, cc = c & 31, ob = rr * 64 + cc * 2; return st * 1024 + (ob ^ (((ob >> 9) & 1) << 5)); }
__host__ __device__ __forceinline__ void stage_rc(int b, int& R, int& C) { const int st = b / 1024, sb = b % 1024, swz = sb ^ (((sb >> 9) & 1) << 5); R = (st >> 1) * 16 + swz / 64; C = (st & 1) * 32 + (swz % 64) / 2; }
__host__ __device__ __forceinline__ int perm32(int rho) { const int n = rho >> 4, i = rho & 15; return 8 * (i >> 2) + 4 * n + (i & 3); }

struct Unit { int pm, pn; const char* A; const char* B; int chain; };
__device__ __forceinline__ const char* uptr(const char* p) { const unsigned long long v = (unsigned long long)p; const unsigned lo = __builtin_amdgcn_readfirstlane((unsigned)v), hi = __builtin_amdgcn_readfirstlane((unsigned)(v >> 32)); return (const char*)(((unsigned long long)hi << 32) | lo); }

struct StaticOrder {
    int nM, nN, nwg, G, c; const char* Ab; const char* Bb; size_t tstep;
    __device__ void init(const void* A, const void* Bt, int M, int N, int K, int G_, int c_) { nM = M / BM; nN = N / BM; nwg = nM * nN; G = G_; c = c_; Ab = (const char*)A; Bb = (const char*)Bt; tstep = (size_t)BM * K * 2; }
    __device__ bool next(int i, Unit& u) const {
        const long L = (long)i * G + c; if (L >= nwg) return false;
        int wgid = (int)L; { const int q = nwg / NXCD, r = nwg % NXCD, xcd = wgid % NXCD, off = wgid / NXCD; wgid = (xcd < r ? xcd * (q + 1) : r * (q + 1) + (xcd - r) * q) + off; }
        const int nig = WGM * nN, gid = wgid / nig, fm = gid * WGM, gsz = (nM - fm) < WGM ? (nM - fm) : WGM;
        u.pm = fm + ((wgid % nig) % gsz); u.pn = (wgid % nig) / gsz; u.A = Ab + (size_t)u.pm * tstep; u.B = Bb + (size_t)u.pn * tstep; u.chain = 0; return true;
    }
};
struct PairOrder {
    int nM, nN, nwg, G, c; const char *A0, *B0, *A1, *B1; size_t tstep;
    __device__ void init(const void* a0, const void* b0, const void* a1, const void* b1, int M, int N, int K, int G_, int c_) { nM = M / BM; nN = N / BM; nwg = nM * nN; G = G_; c = c_; A0 = (const char*)a0; B0 = (const char*)b0; A1 = (const char*)a1; B1 = (const char*)b1; tstep = (size_t)BM * K * 2; }
    __device__ bool next(int i, Unit& u) const {
        const long L = (long)(i >> 1) * G + c; if (L >= nwg) return false;
        const int t = (int)L; u.pm = t / nN; u.pn = t % nN;
        if (i & 1) { u.A = A1 + (size_t)u.pm * tstep; u.B = B1 + (size_t)u.pn * tstep; u.chain = 0; } else { u.A = A0 + (size_t)u.pm * tstep; u.B = B0 + (size_t)u.pn * tstep; u.chain = 1; }
        return true;
    }
};

struct EpiBf16 {
    static constexpr bool PERM = true, HAS_CHAIN = false;
    bf16_t* O; int ldc;
    __device__ __forceinline__ void chain(f32x4 (&)[2][2][4][2], const Unit&, int, int, int, int) const {}
    __device__ __forceinline__ void operator()(const f32x4 (&acc)[2][2][4][2], const Unit& u, int wr, int wc, int fr, int fq) const {
        const int row0 = u.pm * BM + wr * 64 + fr, col0 = u.pn * BM + wc * 32 + 8 * fq;
#pragma unroll
        for (int ai = 0; ai < 2; ++ai)
#pragma unroll
            for (int m = 0; m < 4; ++m) { bf16_t* rowp = O + (size_t)(row0 + ai * HALF + m * 16) * ldc + col0;
#pragma unroll
                for (int bj = 0; bj < 2; ++bj) { const f32x4 v0 = acc[ai][bj][m][0], v1 = acc[ai][bj][m][1];
                    u32x4 w; w.x = cvtpk(v0[0], v0[1]); w.y = cvtpk(v0[2], v0[3]); w.z = cvtpk(v1[0], v1[1]); w.w = cvtpk(v1[2], v1[3]);
                    *(u32x4*)(rowp + bj * HALF) = w; } }
    }
};
struct EpiResid {
    static constexpr bool PERM = false, HAS_CHAIN = false;
    const float* b0; const float* b1; float* out; const float* gate;
    __device__ __forceinline__ void chain(f32x4 (&)[2][2][4][2], const Unit&, int, int, int, int) const {}
    __device__ __forceinline__ void operator()(const f32x4 (&acc)[2][2][4][2], const Unit& u, int wr, int wc, int fr, int fq) const {
        const int rowt = u.pm * BM; const int cond = rowt < NCTX ? 0 : 1 + ((rowt - NCTX) >> 10);
        const float* base = rowt < NCTX ? b0 + (size_t)rowt * DM : b1 + (size_t)(rowt - NCTX) * DM;
        const int r0 = wr * 64 + fr, col0 = u.pn * BM + wc * 32 + 4 * fq;
        f32x4 gv[2][2];
#pragma unroll
        for (int bj = 0; bj < 2; ++bj)
#pragma unroll
            for (int n = 0; n < 2; ++n) gv[bj][n] = *(const f32x4*)(gate + cond * 6144 + col0 + bj * HALF + n * 16);
#pragma unroll
        for (int ai = 0; ai < 2; ++ai)
#pragma unroll
            for (int m = 0; m < 4; ++m) { const int r = r0 + ai * HALF + m * 16; const float* bp = base + (size_t)r * DM + col0; float* op = out + (size_t)(rowt + r) * DM + col0;
#pragma unroll
                for (int bj = 0; bj < 2; ++bj)
#pragma unroll
                    for (int n = 0; n < 2; ++n) { const f32x4 bs = *(const f32x4*)(bp + bj * HALF + n * 16); *(f32x4*)(op + bj * HALF + n * 16) = bs + gv[bj][n] * acc[ai][bj][m][n]; } }
    }
};
struct EpiGate {
    static constexpr bool PERM = true, HAS_CHAIN = false;
    const bf16_t* U; float* P; bf16_t* O;
    __device__ __forceinline__ void chain(f32x4 (&)[2][2][4][2], const Unit&, int, int, int, int) const {}
    __device__ __forceinline__ void operator()(const f32x4 (&acc)[2][2][4][2], const Unit& u, int wr, int wc, int fr, int fq) const {
        const int row0 = u.pm * BM + wr * 64 + fr, col0 = u.pn * BM + wc * 32 + 8 * fq;
        const char* Ub = (const char*)U; char* Ob = (char*)O; char* Pb = (char*)P;
        unsigned off = (unsigned)(row0 * NU + col0 + (u.chain ? UMG : UMN)) * 2u, oo = (unsigned)(row0 * DM + col0) * 2u;
#pragma unroll
        for (int ai = 0; ai < 2; ++ai)
#pragma unroll
            for (int m = 0; m < 4; ++m) {
                asm volatile("" : "+v"(off), "+v"(oo));
                const unsigned ro = off + (unsigned)((ai * HALF + m * 16) * NU) * 2u, wo = oo + (unsigned)((ai * HALF + m * 16) * DM) * 2u;
#pragma unroll
                for (int bj = 0; bj < 2; ++bj) { const u32x4 nn = *(const u32x4*)(Ub + (size_t)(ro + bj * HALF * 2)); const unsigned nw[4] = {nn.x, nn.y, nn.z, nn.w};
                    f32x4 v0, v1;
                    v0[0] = acc[ai][bj][m][0][0] * sigmoidf_(bflo(nw[0])); v0[1] = acc[ai][bj][m][0][1] * sigmoidf_(bfhi(nw[0])); v0[2] = acc[ai][bj][m][0][2] * sigmoidf_(bflo(nw[1])); v0[3] = acc[ai][bj][m][0][3] * sigmoidf_(bfhi(nw[1]));
                    v1[0] = acc[ai][bj][m][1][0] * sigmoidf_(bflo(nw[2])); v1[1] = acc[ai][bj][m][1][1] * sigmoidf_(bfhi(nw[2])); v1[2] = acc[ai][bj][m][1][2] * sigmoidf_(bflo(nw[3])); v1[3] = acc[ai][bj][m][1][3] * sigmoidf_(bfhi(nw[3]));
                    f32x4* pp = (f32x4*)(Pb + (size_t)(2u * (wo + bj * HALF * 2)));
                    if (u.chain) { pp[0] = v0; pp[1] = v1; }
                    else { v0 += pp[0]; v1 += pp[1]; u32x4 w; w.x = cvtpk(v0[0], v0[1]); w.y = cvtpk(v0[2], v0[3]); w.z = cvtpk(v1[0], v1[1]); w.w = cvtpk(v1[2], v1[3]);
                        *(u32x4*)(Ob + (size_t)(wo + bj * HALF * 2)) = w; } }
                asm volatile("" ::: "memory"); }
    }
};

template <class Epi, class Sched>
__device__ __forceinline__ void gemm_phase(LAS unsigned char* lds, const int K, const Sched& S, const Epi& E) {
    const int tid = threadIdx.x, wid = __builtin_amdgcn_readfirstlane(tid >> 6), lane = tid & 63, wr = wid >> 2, wc = wid & 3, fr = lane & 15, fq = lane >> 4;
    const int nt = K / BK;
    unsigned voffA[2], voffB[2];
#pragma unroll
    for (int i = 0; i < 2; ++i) { int R, C; stage_rc(tid * 16 + i * 8192, R, C); const int Rb = Epi::PERM ? ((R & ~31) + perm32(R & 31)) : R;
        voffA[i] = (unsigned)(R * K + C) * 2u; voffB[i] = (unsigned)(Rb * K + C) * 2u; }
    const size_t kstep = (size_t)(BK * 2);
    const size_t hstep = (size_t)HALF * K * 2;
    const unsigned ldsw = (unsigned)wid * 1024u;
    const int aoff = lds_byte(wr * 64 + fr, fq * 8), boff = lds_byte(wc * 32 + fr, fq * 8);
#define PG8_SA(b, h) (((b) * 2 + (h)) * HTB)
#define PG8_SB(b, h) ((4 + (b) * 2 + (h)) * HTB)
#define PG8_STAGE(bufoff, gbase, voff) do { _Pragma("unroll") for (int _i = 0; _i < 2; ++_i) \
        __builtin_amdgcn_global_load_lds((const unsigned*)((const char*)(gbase) + (voff)[_i]), (LAS unsigned*)(lds + (bufoff) + ldsw + _i * 8192), 16, 0, 0); } while (0)
#define PG8_LDA(dst, b, h) do { _Pragma("unroll") for (int m = 0; m < 4; ++m) _Pragma("unroll") for (int k = 0; k < 2; ++k) dst[m][k] = *(const LAS bf16x8*)(lds + PG8_SA(b, h) + aoff + m * 2048 + k * 1024); } while (0)
#define PG8_LDB(dst, b, h) do { _Pragma("unroll") for (int n = 0; n < 2; ++n) _Pragma("unroll") for (int k = 0; k < 2; ++k) dst[n][k] = *(const LAS bf16x8*)(lds + PG8_SB(b, h) + boff + n * 2048 + k * 1024); } while (0)
#define PG8_MMA(ai, bj, At, Bt) do { __builtin_amdgcn_s_setprio(1); _Pragma("unroll") for (int m = 0; m < 4; ++m) _Pragma("unroll") for (int n = 0; n < 2; ++n) _Pragma("unroll") for (int k = 0; k < 2; ++k) \
        acc[ai][bj][m][n] = __builtin_amdgcn_mfma_f32_16x16x32_bf16(Bt[n][k], At[m][k], acc[ai][bj][m][n], 0, 0, 0); __builtin_amdgcn_s_setprio(0); } while (0)
#define PG8_WAIT_V(n) asm volatile("s_waitcnt vmcnt(" #n ")" ::: "memory")
#define PG8_WAIT_L(n) asm volatile("s_waitcnt lgkmcnt(" #n ")" ::: "memory")
#define PG8_BAR __builtin_amdgcn_s_barrier()
#define PG8_SCHED __builtin_amdgcn_sched_barrier(0)
    Unit cur, nxt; int ui = 0;
    if (!S.next(0, cur)) return;
    f32x4 acc[2][2][4][2];
#pragma unroll
    for (int a = 0; a < 2; ++a)
#pragma unroll
        for (int b = 0; b < 2; ++b)
#pragma unroll
            for (int m = 0; m < 4; ++m)
#pragma unroll
                for (int n = 0; n < 2; ++n) acc[a][b][m][n] = (f32x4){0.f, 0.f, 0.f, 0.f};
    bf16x8 At[4][2], B0[2][2], B1[2][2];
    const char* cA = uptr(cur.A); const char* cB = uptr(cur.B);
    PG8_STAGE(PG8_SB(0, 0), cB, voffB); PG8_STAGE(PG8_SB(0, 1), cB + hstep, voffB); PG8_STAGE(PG8_SA(0, 0), cA, voffA); PG8_STAGE(PG8_SA(0, 1), cA + hstep, voffA);
    if (wr == 1) PG8_BAR;
    PG8_WAIT_V(2); PG8_BAR;
    PG8_STAGE(PG8_SB(1, 0), cB + kstep, voffB); PG8_STAGE(PG8_SA(1, 0), cA + kstep, voffA); PG8_STAGE(PG8_SB(1, 1), cB + hstep + kstep, voffB);
    PG8_WAIT_V(6); PG8_BAR;
    for (;;) {
        const bool has_next = S.next(ui + 1, nxt);
        const char* nA = uptr(has_next ? nxt.A : cA); const char* nB = uptr(has_next ? nxt.B : cB);
        for (int t = 0; t < nt; t += 2) {
            const bool last = (t == nt - 2);
            const char* a1 = cA + (size_t)(t + 1) * kstep;
            const char* a2 = last ? nA : cA + (size_t)(t + 2) * kstep; const char* b2 = last ? nB : cB + (size_t)(t + 2) * kstep;
            const char* a3 = a2 + kstep; const char* b3 = b2 + kstep;
            PG8_LDB(B0, 0, 0); PG8_LDB(B1, 0, 1); PG8_SCHED; PG8_LDA(At, 0, 0); PG8_STAGE(PG8_SA(1, 1), a1 + hstep, voffA);
            PG8_WAIT_V(8); PG8_WAIT_L(0); PG8_BAR; PG8_MMA(0, 0, At, B0); PG8_MMA(0, 1, At, B1); PG8_BAR; PG8_SCHED;
            PG8_LDA(At, 0, 1); PG8_STAGE(PG8_SB(0, 0), b2, voffB); PG8_STAGE(PG8_SB(0, 1), b2 + hstep, voffB); PG8_STAGE(PG8_SA(0, 0), a2, voffA);
            PG8_WAIT_V(8); PG8_WAIT_L(0); PG8_BAR; PG8_MMA(1, 0, At, B0); PG8_MMA(1, 1, At, B1); PG8_BAR; PG8_SCHED;
            PG8_LDB(B0, 1, 0); PG8_LDB(B1, 1, 1); PG8_SCHED; PG8_LDA(At, 1, 0); PG8_STAGE(PG8_SA(0, 1), a2 + hstep, voffA);
            PG8_WAIT_V(8); PG8_WAIT_L(0); PG8_BAR; PG8_MMA(0, 0, At, B0); PG8_MMA(0, 1, At, B1); PG8_BAR; PG8_SCHED;
            PG8_LDA(At, 1, 1); PG8_STAGE(PG8_SB(1, 0), b3, voffB); PG8_STAGE(PG8_SB(1, 1), b3 + hstep, voffB); PG8_STAGE(PG8_SA(1, 0), a3, voffA);
            PG8_WAIT_V(8); PG8_WAIT_L(0); PG8_BAR; PG8_MMA(1, 0, At, B0); PG8_MMA(1, 1, At, B1); PG8_BAR; PG8_SCHED;
        }
        if (wr == 0) PG8_BAR;
        if (Epi::HAS_CHAIN && cur.chain) { E.chain(acc, cur, wr, wc, fr, fq); }
        else {
            E(acc, cur, wr, wc, fr, fq);
#pragma unroll
            for (int a = 0; a < 2; ++a)
#pragma unroll
                for (int b = 0; b < 2; ++b)
#pragma unroll
                    for (int m = 0; m < 4; ++m)
#pragma unroll
                        for (int n = 0; n < 2; ++n) acc[a][b][m][n] = (f32x4){0.f, 0.f, 0.f, 0.f};
        }
        if (!has_next) break;
        cur = nxt; cA = nA; cB = nB; ++ui;
        if (wr == 1) PG8_BAR;
    }
    PG8_WAIT_V(0);
    PG8_BAR;
#undef PG8_SA
#undef PG8_SB
#undef PG8_STAGE
#undef PG8_LDA
#undef PG8_LDB
#undef PG8_MMA
#undef PG8_WAIT_V
#undef PG8_WAIT_L
#undef PG8_BAR
#undef PG8_SCHED
}
}

#define XB_TMO      128
#define XB_XCNT(j)  (256  + 64 * (j))
#define XB_XSUB(j)  (1280 + 64 * (j))
#define XB_XGEN(j)  (2304 + 64 * (j))
#define XB_TOP      3328
#define XB_TOPGEN   3392
#define XCD_BAR_WORDS 3456
#define XB_SPIN_CAP (1u << 22)
__device__ __forceinline__ unsigned xb_ld(unsigned* p)              { return __hip_atomic_load(p, __ATOMIC_RELAXED, __HIP_MEMORY_SCOPE_AGENT); }
__device__ __forceinline__ unsigned xb_add(unsigned* p, unsigned v) { return __hip_atomic_fetch_add(p, v, __ATOMIC_RELAXED, __HIP_MEMORY_SCOPE_AGENT); }
__device__ __forceinline__ unsigned xb_xcc_id() { return (unsigned)__builtin_amdgcn_s_getreg((3 << 11) | 20) & 0xFu; }
#define XB_SPIN(cond, bar) do { unsigned _sp = 0; while (cond) { __builtin_amdgcn_s_sleep(1); \
    if ((++_sp & 255u) == 0u) { if (xb_ld(&(bar)[XB_TMO])) break; if (_sp > XB_SPIN_CAP) { atomicAdd(&(bar)[XB_TMO], 1u); break; } } } } while (0)
struct XcdBarrier { unsigned* bar; unsigned x; volatile LAS unsigned* st; };
__device__ __forceinline__ XcdBarrier xcd_barrier_post(unsigned* bar, volatile LAS unsigned* st) {
    XcdBarrier b; b.bar = bar; b.x = xb_xcc_id(); b.st = st;
    if (threadIdx.x == 0) (void)xb_add(&bar[XB_XCNT(b.x)], 1u);
    return b;
}
__device__ __forceinline__ void xcd_barrier_complete(unsigned* bar, unsigned x, unsigned& nloc, unsigned& nx) {
    const unsigned G = gridDim.x * gridDim.y * gridDim.z;
    unsigned sum, cnt, mine, sp = 0u;
    for (;;) {
        sum = 0u; cnt = 0u; mine = 0u;
#pragma unroll
        for (unsigned j = 0; j < 16; ++j) { const unsigned c = xb_ld(&bar[XB_XCNT(j)]); sum += c; cnt += (c > 0u) ? 1u : 0u; mine = (j == x) ? c : mine; }
        if (sum == G) break;
        __builtin_amdgcn_s_sleep(1);
        if ((++sp & 255u) == 0u) { if (xb_ld(&bar[XB_TMO])) break; if (sp > XB_SPIN_CAP) { atomicAdd(&bar[XB_TMO], 1u); break; } }
    }
    nloc = mine > 0u ? mine : 1u; nx = cnt > 0u ? cnt : 1u;
}
__device__ __forceinline__ void xcd_barrier(const XcdBarrier& b) {
    asm volatile("s_waitcnt vmcnt(0)" ::: "memory");
    __syncthreads();
    if (threadIdx.x == 0) {
        unsigned* bar = b.bar;
        __builtin_amdgcn_s_waitcnt(0);
        unsigned nloc = b.st[0], nx = b.st[1];
        if (nloc == 0u) { xcd_barrier_complete(bar, b.x, nloc, nx); b.st[0] = nloc; b.st[1] = nx; }
        const unsigned old = xb_add(&bar[XB_XSUB(b.x)], 1u);
        const unsigned gen = old / nloc;
        if (old + 1u == (gen + 1u) * nloc) {
            __builtin_amdgcn_fence(__ATOMIC_RELEASE, "agent");
            asm volatile("s_waitcnt vmcnt(0)" ::: "memory");
            const unsigned og = xb_add(&bar[XB_TOP], 1u);
            const unsigned tg = og / nx;
            if (og + 1u == (tg + 1u) * nx) xb_add(&bar[XB_TOPGEN], 1u);
            else XB_SPIN(xb_ld(&bar[XB_TOPGEN]) == tg, bar);
            __builtin_amdgcn_fence(__ATOMIC_ACQUIRE, "agent");
            xb_add(&bar[XB_XGEN(b.x)], 1u);
            asm volatile("s_waitcnt vmcnt(0)" ::: "memory");
        } else {
            XB_SPIN(xb_ld(&bar[XB_XGEN(b.x)]) == gen, bar);
            __builtin_amdgcn_fence(__ATOMIC_ACQUIRE, "agent");
            asm volatile("s_waitcnt vmcnt(0)" ::: "memory");
        }
    }
    __syncthreads();
}

struct Frame {
    LAS unsigned char* lds;
    int tid, lane, wave, G, bid;
    const float* in[28];
    float* out; unsigned char* ws;
    __device__ __forceinline__ const float* xrow(int m) const { return m < NCTX ? in[0] + (size_t)m * DM : in[1] + (size_t)(m - NCTX) * DM; }
};
__device__ __forceinline__ int cond_of(int m) { return m < NCTX ? 0 : 1 + ((m - NCTX) >> 10); }

__device__ __forceinline__ void p0_transpose_item(const float* W, int N, int K, bf16_t* WT, int k0, int n0, int drow0, LAS float* scr, int lane) {
#pragma unroll 8
    for (int i = 0; i < 32; ++i) { const int kk = 2 * i + (lane >> 5); scr[kk * 33 + (lane & 31)] = W[(size_t)(k0 + kk) * N + n0 + (lane & 31)]; }
    asm volatile("s_waitcnt lgkmcnt(0)" ::: "memory");
    const int c = lane & 7;
#pragma unroll
    for (int j = 0; j < 4; ++j) { const int n = (lane >> 3) + 8 * j; const LAS float* s = scr + (8 * c) * 33 + n;
        u32x4 o; o.x = cvtpk(s[0 * 33], s[1 * 33]); o.y = cvtpk(s[2 * 33], s[3 * 33]); o.z = cvtpk(s[4 * 33], s[5 * 33]); o.w = cvtpk(s[6 * 33], s[7 * 33]);
        *(u32x4*)(WT + (size_t)(drow0 + n) * K + k0 + 8 * c) = o; }
    asm volatile("s_waitcnt lgkmcnt(0)" ::: "memory");
}
__device__ __forceinline__ void p0_prologue(Frame& F) {
    {
        LAS float* sc = (LAS float*)(F.lds);
        LAS float* red = (LAS float*)(F.lds + 12288);
        for (int i = F.tid; i < 3072; i += NTHR) { const int c = i >> 10, k = i & 1023; const float v = c == 0 ? F.in[7][k] : F.in[2][(c - 1) * 1024 + k]; sc[i] = siluf_(v); }
        __syncthreads();
        const float* wada = F.in[8]; const float* bada = F.in[9]; float* ada = (float*)(F.ws + WS_ADA);
        for (int cb = F.bid; cb < 256; cb += F.G) {
            if (F.tid < 384) {
                const int cq = F.tid % 6, kg = F.tid / 6;
                f32x4 a0 = {0.f, 0.f, 0.f, 0.f}, a1 = a0, a2 = a0;
#pragma unroll 4
                for (int kk = 0; kk < 16; ++kk) { const int k = 16 * kg + kk; const f32x4 w = *(const f32x4*)(wada + (size_t)k * 6144 + 24 * cb + 4 * cq);
                    a0 += w * sc[k]; a1 += w * sc[1024 + k]; a2 += w * sc[2048 + k]; }
#pragma unroll
                for (int e = 0; e < 4; ++e) { red[(0 * 64 + kg) * 24 + 4 * cq + e] = a0[e]; red[(1 * 64 + kg) * 24 + 4 * cq + e] = a1[e]; red[(2 * 64 + kg) * 24 + 4 * cq + e] = a2[e]; }
            }
            __syncthreads();
            if (F.tid < 72) { const int c = F.tid / 24, col = F.tid % 24; float s = 0.f;
                for (int kg = 0; kg < 64; ++kg) s += red[(c * 64 + kg) * 24 + col];
                ada[c * 6144 + 24 * cb + col] = s + bada[24 * cb + col]; }
            __syncthreads();
        }
    }
    LAS float* scr = (LAS float*)(F.lds + F.wave * 16384);
    const int gw = F.bid * NWAVES + F.wave, NGW = F.G * NWAVES;
    constexpr int I_IN = 16 * 161, I_GO = 8 * 32, I_NO = 8 * 32, I_OUT = 16 * 32, I_UP = 16 * 176, I_DN = 44 * 32;
    constexpr int NITEMS = I_IN + I_GO + I_NO + I_OUT + I_UP + I_DN;
    for (int it = gw; it < NITEMS; it += NGW) {
        int r = it;
        if (r < I_IN) { const int kb = r / 161, nb = r % 161;
            if (nb == 48) p0_transpose_item(F.in[11], DIN, 1024, (bf16_t*)(F.ws + WS_WZT), 64 * kb, 32 * nb, 0, scr, F.lane);
            else p0_transpose_item(F.in[11], DIN, 1024, (bf16_t*)(F.ws + WS_WIN), 64 * kb, 32 * nb, 32 * nb - (nb > 48 ? 32 : 0), scr, F.lane);
            continue; } r -= I_IN;
        if (r < I_GO) { p0_transpose_item(F.in[20], 1024, 512, (bf16_t*)(F.ws + WS_WGO), 64 * (r / 32), 32 * (r % 32), 32 * (r % 32), scr, F.lane); continue; } r -= I_GO;
        if (r < I_NO) { p0_transpose_item(F.in[21], 1024, 512, (bf16_t*)(F.ws + WS_WNO), 64 * (r / 32), 32 * (r % 32), 32 * (r % 32), scr, F.lane); continue; } r -= I_NO;
        if (r < I_OUT) { p0_transpose_item(F.in[22], 1024, 1024, (bf16_t*)(F.ws + WS_WOUT), 64 * (r / 32), 32 * (r % 32), 32 * (r % 32), scr, F.lane); continue; } r -= I_OUT;
        if (r < I_UP) { p0_transpose_item(F.in[24], NUP, 1024, (bf16_t*)(F.ws + WS_WUP), 64 * (r / 176), 32 * (r % 176), 32 * (r % 176), scr, F.lane); continue; } r -= I_UP;
        p0_transpose_item(F.in[27], 1024, DFF, (bf16_t*)(F.ws + WS_WDN), 64 * (r / 32), 32 * (r % 32), 32 * (r % 32), scr, F.lane);
    }
}

template <bool FROM_OUT>
__device__ __forceinline__ void norm_rows(Frame& F, const float* g, int off_sh, int off_sc) {
    const int gw = F.bid * NWAVES + F.wave, NGW = F.G * NWAVES;
    const float* ada = (const float*)(F.ws + WS_ADA);
    bf16_t* H = (bf16_t*)(F.ws + WS_H);
    for (int m = gw; m < MTOK; m += NGW) {
        const float* xr = FROM_OUT ? F.out + (size_t)m * DM : F.xrow(m);
        const float* ad = ada + cond_of(m) * 6144;
        f32x4 v[4]; float s = 0.f;
#pragma unroll
        for (int j = 0; j < 4; ++j) { v[j] = *(const f32x4*)(xr + 4 * F.lane + 256 * j); s += (v[j].x * v[j].x + v[j].y * v[j].y) + (v[j].z * v[j].z + v[j].w * v[j].w); }
        const float rinv = rsqrtf(wave_sum(s) * (1.f / DM) + EPS);
#pragma unroll
        for (int j = 0; j < 4; ++j) { const int c = 4 * F.lane + 256 * j;
            const f32x4 gg = *(const f32x4*)(g + c), sc = *(const f32x4*)(ad + off_sc + c), sh = *(const f32x4*)(ad + off_sh + c);
            const f32x4 o = v[j] * rinv * gg * (sc + 1.f) + sh;
            u32x2 w; w.x = cvtpk(o[0], o[1]); w.y = cvtpk(o[2], o[3]);
            *(u32x2*)(H + (size_t)m * DM + c) = w; }
    }
}

__device__ __forceinline__ void z_item(Frame& F, int j) {
    const bf16_t* H = (const bf16_t*)(F.ws + WS_H); const bf16_t* WzT = (const bf16_t*)(F.ws + WS_WZT); float* Z = (float*)(F.ws + WS_Z);
    const int r = F.lane & 31, hh = F.lane >> 5, row0 = 256 * j + 32 * F.wave;
    const bf16_t* ap = H + (size_t)(row0 + r) * DM + 8 * hh; const bf16_t* bp = WzT + (size_t)r * DM + 8 * hh;
    f32x16 acc = {};
#pragma unroll 8
    for (int ks = 0; ks < 64; ++ks) { const bf16x8 a = *(const bf16x8*)(ap + 16 * ks), b = *(const bf16x8*)(bp + 16 * ks); acc = __builtin_amdgcn_mfma_f32_32x32x16_bf16(a, b, acc, 0, 0, 0); }
#pragma unroll
    for (int i = 0; i < 16; ++i) Z[(size_t)(row0 + crow(i, hh)) * 32 + r] = acc[i];
}

__device__ __forceinline__ void kvout_rows(Frame& F, int m0, int nrows) {
    const bf16_t* U = (const bf16_t*)(F.ws + WS_U);
    const float* gk = F.in[18];
    for (int i = F.wave; i < nrows; i += NWAVES) {
        const int m = m0 + i;
        float k[8], v[8];
        unpack8(*(const u32x4*)(U + (size_t)m * NU + UNK + 8 * F.lane), k);
        unpack8(*(const u32x4*)(U + (size_t)m * NU + UNV + 8 * F.lane), v);
        float s = 0.f;
#pragma unroll
        for (int e = 0; e < 8; ++e) s += k[e] * k[e];
        s += __shfl_xor(s, 1); s += __shfl_xor(s, 2); s += __shfl_xor(s, 4);
        const float rinv = rsqrtf(s * (1.f / 64.f) + EPS);
        const int d0 = (8 * F.lane) & 63;
        f32x4 o0, o1;
#pragma unroll
        for (int e = 0; e < 4; ++e) { o0[e] = k[e] * rinv * gk[d0 + e]; o1[e] = k[4 + e] * rinv * gk[d0 + 4 + e]; }
        float* ok = F.out + O_NK + (size_t)m * 512 + 8 * F.lane; float* ov = F.out + O_NV + (size_t)m * 512 + 8 * F.lane;
        *(f32x4*)ok = o0; *(f32x4*)(ok + 4) = o1;
        *(f32x4*)ov = (f32x4){v[0], v[1], v[2], v[3]}; *(f32x4*)(ov + 4) = (f32x4){v[4], v[5], v[6], v[7]};
    }
}


__device__ __forceinline__ float logsigf_(float x) { return fminf(x, 0.f) - __logf(1.f + __expf(-fabsf(x))); }
constexpr int VLS = 160;
constexpr int STS = 72;

__device__ __forceinline__ void gla_stage_v(Frame& F, const bf16_t* U, int m0, int h, LAS bf16_t* VL) {
#pragma unroll
    for (int i = 0; i < 2; ++i) { const int p = F.tid + i * NTHR, row = p >> 4, c16 = p & 15;
        const u32x4 v = *(const u32x4*)(U + (size_t)(m0 + row) * NU + UV + 128 * h + 8 * c16);
        *(LAS u32x4*)(VL + row * VLS + 8 * c16) = v; }
}

__device__ __forceinline__ void gla_pass1_item(Frame& F, int item) {
    const bf16_t* U = (const bf16_t*)(F.ws + WS_U); const float* Z = (const float*)(F.ws + WS_Z);
    bf16_t* QK = (bf16_t*)(F.ws + WS_QK) + (size_t)item * 4 * 4096; float* KV = (float*)(F.ws + WS_KV) + (size_t)item * 2 * 8192; float* DEC = (float*)(F.ws + WS_DEC) + (size_t)item * 128;
    const int gc = item >> 2, h = item & 3, m0 = gc * 64, tid = F.tid;
    LAS float* ZL = (LAS float*)(F.lds);
    LAS float* WA = (LAS float*)(F.lds + 8192);
    LAS float* BA = (LAS float*)(F.lds + 16384);
    LAS float* LA = (LAS float*)(F.lds + 16896);
    LAS bf16_t* KP = (LAS bf16_t*)(F.lds + 49664);
    LAS bf16_t* VL = (LAS bf16_t*)(F.lds + 66048);
    { const int t = tid >> 3, c4 = tid & 7; *(LAS f32x4*)(ZL + t * 32 + 4 * c4) = *(const f32x4*)(Z + (size_t)(m0 + t) * 32 + 4 * c4); }
    { const int dir = tid >> 8, j = (tid & 255) >> 4, d4 = tid & 15; const float* w = dir ? F.in[14] : F.in[12];
      *(LAS f32x4*)(WA + (dir * 16 + j) * 64 + 4 * d4) = *(const f32x4*)(w + j * 256 + 64 * h + 4 * d4); }
    if (tid < 128) { const int dir = tid >> 6, d = tid & 63; BA[tid] = (dir ? F.in[15] : F.in[13])[64 * h + d]; }
    gla_stage_v(F, U, m0, h, VL);
    __syncthreads();
    { const int t = tid >> 3, d0 = (tid & 7) * 8;
#pragma unroll
      for (int dir = 0; dir < 2; ++dir) { float a[8];
#pragma unroll
        for (int e = 0; e < 8; ++e) a[e] = BA[dir * 64 + d0 + e];
#pragma unroll
        for (int j = 0; j < 16; ++j) { const float z = ZL[t * 32 + 16 * dir + j];
#pragma unroll
            for (int e = 0; e < 8; ++e) a[e] += z * WA[(dir * 16 + j) * 64 + d0 + e]; }
#pragma unroll
        for (int e = 0; e < 8; ++e) LA[(dir * 64 + t) * 64 + d0 + e] = logsigf_(a[e]) * (1.f / 16.f); } }
    __syncthreads();
    if (tid < 128) { const int dir = tid >> 6, d = tid & 63; float run = 0.f;
        if (dir == 0) { for (int t = 0; t < 64; ++t) { run += LA[t * 64 + d]; LA[t * 64 + d] = run; } }
        else { for (int t = 63; t >= 0; --t) { run += LA[(64 + t) * 64 + d]; LA[(64 + t) * 64 + d] = run; } } }
    __syncthreads();
    { const int t = tid >> 3, d0 = (tid & 7) * 8; float q[8], k[8];
      unpack8(*(const u32x4*)(U + (size_t)(m0 + t) * NU + UQ + 64 * h + d0), q); unpack8(*(const u32x4*)(U + (size_t)(m0 + t) * NU + UK + 64 * h + d0), k);
#pragma unroll
      for (int dir = 0; dir < 2; ++dir) { float qt[8], kt[8], kp[8];
#pragma unroll
        for (int e = 0; e < 8; ++e) { const float c = LA[(dir * 64 + t) * 64 + d0 + e], last = LA[(dir * 64 + (dir ? 0 : 63)) * 64 + d0 + e];
            qt[e] = q[e] * 0.125f * __expf(c); kt[e] = k[e] * __expf(-c); kp[e] = k[e] * __expf(last - c);
            if (t == 0) DEC[dir * 64 + d0 + e] = __expf(last); }
        *(u32x4*)(QK + (size_t)(2 * dir) * 4096 + t * 64 + d0) = pack8(qt); *(u32x4*)(QK + (size_t)(2 * dir + 1) * 4096 + t * 64 + d0) = pack8(kt);
        *(LAS u32x4*)(KP + (dir * 64 + t) * 64 + d0) = pack8(kp); } }
    __syncthreads();
    { const int l = F.lane, hh = l >> 5, g1 = (l >> 4) & 1, qq = (l & 15) >> 2, pp = l & 3, dvt = F.wave & 3, dt = F.wave >> 2;
#pragma unroll
      for (int dir = 0; dir < 2; ++dir) { f32x16 acc = {};
#pragma unroll
        for (int ks = 0; ks < 4; ++ks) { const int r0 = 16 * ks + 8 * hh + qq;
            const LAS bf16_t* va = VL + r0 * VLS + 32 * dvt + 16 * g1 + 4 * pp; const LAS bf16_t* kb = KP + (dir * 64 + r0) * 64 + 32 * dt + 16 * g1 + 4 * pp;
            const bf16x8 a = cat8(vtr(va), vtr(va + 4 * VLS)), b = cat8(vtr(kb), vtr(kb + 4 * 64));
            acc = __builtin_amdgcn_mfma_f32_32x32x16_bf16(a, b, acc, 0, 0, 0); }
#pragma unroll
        for (int r = 0; r < 16; ++r) KV[(size_t)dir * 8192 + (32 * dvt + crow(r, hh)) * 64 + 32 * dt + (l & 31)] = acc[r]; } }
    __syncthreads();
}

__device__ __forceinline__ void gla_pass2_item(Frame& F, int item) {
    const bf16_t* U = (const bf16_t*)(F.ws + WS_U); bf16_t* OG = (bf16_t*)(F.ws + WS_OG);
    const bf16_t* QKb = (const bf16_t*)(F.ws + WS_QK); const float* KVb = (const float*)(F.ws + WS_KV); const float* DECb = (const float*)(F.ws + WS_DEC);
    const int gc = item >> 2, h = item & 3, m0 = gc * 64, tid = F.tid;
    const bool ctx = gc < 64; const int n = ctx ? (gc & 3) : ((gc - 64) & 15), N = ctx ? 4 : 16, seq = ctx ? (gc >> 2) : 16 + ((gc - 64) >> 4);
    LAS bf16_t* ST = (LAS bf16_t*)(F.lds);
    LAS bf16_t* VL = (LAS bf16_t*)(F.lds + 36864);
    LAS float* SS = (LAS float*)(F.lds + 57344);
#pragma unroll
    for (int dir = 0; dir < 2; ++dir) {
        const float* s0 = (dir ? F.in[6] : F.in[5]) + (size_t)((ctx ? 0 : seq - 16) * 4 + h) * 8192;
        float* so = F.out + (dir ? O_SB : O_SF) + (size_t)(seq * 4 + h) * 8192;
        const int nprev = dir ? (N - 1 - n) : n;
        const bool fin = ctx && (dir ? n == 0 : n == N - 1);
#pragma unroll
        for (int j = 0; j < 4; ++j) { const int e4 = tid + NTHR * j, dv = e4 >> 4, d = (e4 & 15) * 4;
            f32x4 S = {0.f, 0.f, 0.f, 0.f};
            if (!ctx) {
#pragma unroll
                for (int e = 0; e < 4; ++e) S[e] = s0[(size_t)(d + e) * 128 + dv]; }
            for (int mm = 0; mm < nprev; ++mm) { const int it = (dir ? (gc + nprev - mm) : (gc - nprev + mm)) * 4 + h;
                const f32x4 dc = *(const f32x4*)(DECb + (size_t)it * 128 + dir * 64 + d), kv = *(const f32x4*)(KVb + (size_t)it * 16384 + dir * 8192 + dv * 64 + d);
                S = dc * S + kv; }
            u32x2 w; w.x = cvtpk(S[0], S[1]); w.y = cvtpk(S[2], S[3]);
            *(LAS u32x2*)(ST + (dir * 128 + dv) * STS + d) = w;
            if (fin) { const f32x4 dc = *(const f32x4*)(DECb + (size_t)item * 128 + dir * 64 + d), kv = *(const f32x4*)(KVb + (size_t)item * 16384 + dir * 8192 + dv * 64 + d);
                const f32x4 Sf = dc * S + kv;
#pragma unroll
                for (int e = 0; e < 4; ++e) so[(size_t)(d + e) * 128 + dv] = Sf[e]; } } }
    gla_stage_v(F, U, m0, h, VL);
    __syncthreads();
    const int l = F.lane, hh = l >> 5, c31 = l & 31, g1 = (l >> 4) & 1, qq = (l & 15) >> 2, pp = l & 3, dvt = F.wave & 3, tt = F.wave >> 2;
    f32x16 o = {};
#pragma unroll
    for (int dir = 0; dir < 2; ++dir) {
        const bf16_t* Qg = QKb + ((size_t)item * 4 + 2 * dir) * 4096; const bf16_t* Kg = Qg + 4096;
        bf16x8 qf[4];
#pragma unroll
        for (int ks = 0; ks < 4; ++ks) qf[ks] = *(const bf16x8*)(Qg + (32 * tt + c31) * 64 + 16 * ks + 8 * hh);
#pragma unroll
        for (int st = 0; st < 2; ++st) {
            if (dir == 0 ? st > tt : st < tt) continue;
            f32x16 p = {};
#pragma unroll
            for (int ks = 0; ks < 4; ++ks) { const bf16x8 kf = *(const bf16x8*)(Kg + (32 * st + c31) * 64 + 16 * ks + 8 * hh); p = __builtin_amdgcn_mfma_f32_32x32x16_bf16(kf, qf[ks], p, 0, 0, 0); }
            if (st == tt) {
#pragma unroll
                for (int r = 0; r < 16; ++r) { const int s = crow(r, hh); const bool keep = dir == 0 ? s <= c31 : s >= c31; p[r] = keep ? p[r] : 0.f; } }
#pragma unroll
            for (int s2 = 0; s2 < 2; ++s2) {
                u32x4 pw; pw.x = cvtpk(p[8 * s2 + 0], p[8 * s2 + 1]); pw.y = cvtpk(p[8 * s2 + 2], p[8 * s2 + 3]); pw.z = cvtpk(p[8 * s2 + 4], p[8 * s2 + 5]); pw.w = cvtpk(p[8 * s2 + 6], p[8 * s2 + 7]);
                const LAS bf16_t* va = VL + (32 * st + 16 * s2 + 4 * hh + qq) * VLS + 32 * dvt + 16 * g1 + 4 * pp;
                const bf16x8 a = cat8(vtr(va), vtr(va + 8 * VLS));
                o = __builtin_amdgcn_mfma_f32_32x32x16_bf16(a, __builtin_bit_cast(bf16x8, pw), o, 0, 0, 0); }
        }
#pragma unroll
        for (int ks = 0; ks < 4; ++ks) { const bf16x8 a = *(const LAS bf16x8*)(ST + (dir * 128 + 32 * dvt + c31) * STS + 16 * ks + 8 * hh); o = __builtin_amdgcn_mfma_f32_32x32x16_bf16(a, qf[ks], o, 0, 0, 0); }
    }
    { float ss = 0.f;
#pragma unroll
      for (int r = 0; r < 16; ++r) ss += o[r] * o[r];
      ss += __shfl_xor(ss, 32);
      if (hh == 0) SS[dvt * 64 + 32 * tt + c31] = ss; }
    __syncthreads();
    { const int t = 32 * tt + c31; const float tot = SS[t] + SS[64 + t] + SS[128 + t] + SS[192 + t]; const float rinv = rsqrtf(tot * (1.f / 128.f) + EPS);
      const float* gg = F.in[16]; const size_t m = (size_t)(m0 + t);
#pragma unroll
      for (int rg = 0; rg < 4; ++rg) { const int dv0 = 32 * dvt + 8 * rg + 4 * hh; const f32x4 g4 = *(const f32x4*)(gg + dv0);
          const u32x2 gr = *(const u32x2*)(U + m * NU + UR + 128 * h + dv0); const float r0 = bflo(gr.x), r1 = bfhi(gr.x), r2 = bflo(gr.y), r3 = bfhi(gr.y);
          u32x2 w; w.x = cvtpk(o[4 * rg + 0] * rinv * g4[0] * siluf_(r0), o[4 * rg + 1] * rinv * g4[1] * siluf_(r1)); w.y = cvtpk(o[4 * rg + 2] * rinv * g4[2] * siluf_(r2), o[4 * rg + 3] * rinv * g4[3] * siluf_(r3));
          *(u32x2*)(OG + m * 512 + 128 * h + dv0) = w; } }
    __syncthreads();
}

constexpr float QSC = 0.125f * LOG2E;
struct AttnLocal { const LAS float* rpb; int dr0; int qc0; };

template <bool FROMU, bool LOCAL>
__device__ __forceinline__ void attn_wave(Frame& F, const bf16_t* U, int qtok0, int h, int kbase, const float* ckeys, const LAS bf16_t* VLw, const AttnLocal& L, f32x16 (&o)[2], float& m_out, float& l_out) {
    const int l = F.lane, hh = l >> 5, c31 = l & 31, g1 = (l >> 4) & 1, qq = (l & 15) >> 2, pp = l & 3;
    const float* gq = F.in[17]; const float* gk = F.in[18];
    bf16x8 qf[4];
    { float f[4][8]; float ss = 0.f; const bf16_t* qp = U + (size_t)(qtok0 + c31) * NU + UNQ + 64 * h + 8 * hh;
#pragma unroll
      for (int ks = 0; ks < 4; ++ks) { unpack8(*(const u32x4*)(qp + 16 * ks), f[ks]);
#pragma unroll
          for (int e = 0; e < 8; ++e) ss += f[ks][e] * f[ks][e]; }
      ss += __shfl_xor(ss, 32);
      const float rinv = rsqrtf(ss * (1.f / 64.f) + EPS) * QSC;
#pragma unroll
      for (int ks = 0; ks < 4; ++ks) {
#pragma unroll
          for (int e = 0; e < 8; ++e) { const int d = 16 * ks + 8 * hh + e; f[ks][e] *= rinv * gq[d] * (FROMU ? gk[d] : 1.f); }
          qf[ks] = __builtin_bit_cast(bf16x8, pack8(f[ks])); } }
    float m_run = -1e30f, l_run = 0.f;
    o[0] = f32x16{}; o[1] = f32x16{};
    const bf16_t* kpu = U + (size_t)(kbase + c31) * NU + UNK + 64 * h + 8 * hh;
    const float* kpc = FROMU ? nullptr : ckeys + ((size_t)(kbase + c31) * 8 + h) * 64 + 8 * hh;
    u32x4 rawu[4]; f32x4 rawc[8];
    if (FROMU) {
#pragma unroll
        for (int ks = 0; ks < 4; ++ks) rawu[ks] = *(const u32x4*)(kpu + 16 * ks); }
    else {
#pragma unroll
        for (int ks = 0; ks < 4; ++ks) { rawc[2 * ks] = *(const f32x4*)(kpc + 16 * ks); rawc[2 * ks + 1] = *(const f32x4*)(kpc + 16 * ks + 4); } }
#pragma unroll 1
    for (int T = 0; T < 8; ++T) {
        bf16x8 kf[4];
        if (FROMU) { float f[4][8]; float ss = 0.f;
#pragma unroll
            for (int ks = 0; ks < 4; ++ks) { unpack8(rawu[ks], f[ks]);
#pragma unroll
                for (int e = 0; e < 8; ++e) ss += f[ks][e] * f[ks][e]; }
            if (T < 7) { const bf16_t* kn = kpu + (size_t)(32 * (T + 1)) * NU;
#pragma unroll
                for (int ks = 0; ks < 4; ++ks) rawu[ks] = *(const u32x4*)(kn + 16 * ks); }
            ss += __shfl_xor(ss, 32);
            const float rinv = rsqrtf(ss * (1.f / 64.f) + EPS);
#pragma unroll
            for (int ks = 0; ks < 4; ++ks) {
#pragma unroll
                for (int e = 0; e < 8; ++e) f[ks][e] *= rinv;
                kf[ks] = __builtin_bit_cast(bf16x8, pack8(f[ks])); } }
        else {
#pragma unroll
            for (int ks = 0; ks < 4; ++ks) { const f32x4 a = rawc[2 * ks], b = rawc[2 * ks + 1];
                u32x4 w; w.x = cvtpk(a[0], a[1]); w.y = cvtpk(a[2], a[3]); w.z = cvtpk(b[0], b[1]); w.w = cvtpk(b[2], b[3]); kf[ks] = __builtin_bit_cast(bf16x8, w); }
            if (T < 7) { const float* kn = kpc + (size_t)(32 * (T + 1)) * 512;
#pragma unroll
                for (int ks = 0; ks < 4; ++ks) { rawc[2 * ks] = *(const f32x4*)(kn + 16 * ks); rawc[2 * ks + 1] = *(const f32x4*)(kn + 16 * ks + 4); } } }
        f32x16 acc = {};
#pragma unroll
        for (int ks = 0; ks < 4; ++ks) acc = __builtin_amdgcn_mfma_f32_32x32x16_bf16(kf[ks], qf[ks], acc, 0, 0, 0);
        if (LOCAL) { const int c = L.qc0 + c31, cs = min(max(c - 8, 0), 48); const LAS float* rp = L.rpb + (L.dr0 + (T >> 1)) * 32;
#pragma unroll
            for (int r = 0; r < 16; ++r) { const int kc = 32 * (T & 1) + crow(r, hh); const bool inw = kc >= cs && kc < cs + 16; const int dc = min(max(kc - c + 15, 0), 31);
                acc[r] = inw ? acc[r] + rp[dc] : -INFINITY; } }
        float mx = acc[0];
#pragma unroll
        for (int r = 1; r < 16; ++r) mx = fmaxf(mx, acc[r]);
        mx = fmaxf(mx, __shfl_xor(mx, 32));
        const float mnew = fmaxf(m_run, mx), fsc = __builtin_amdgcn_exp2f(m_run - mnew);
        m_run = mnew; l_run *= fsc;
#pragma unroll
        for (int r = 0; r < 16; ++r) { o[0][r] *= fsc; o[1][r] *= fsc; }
#pragma unroll
        for (int r = 0; r < 16; ++r) { const float p = __builtin_amdgcn_exp2f(acc[r] - mnew); acc[r] = p; l_run += p; }
#pragma unroll
        for (int s2 = 0; s2 < 2; ++s2) {
            u32x4 pw; pw.x = cvtpk(acc[8 * s2 + 0], acc[8 * s2 + 1]); pw.y = cvtpk(acc[8 * s2 + 2], acc[8 * s2 + 3]); pw.z = cvtpk(acc[8 * s2 + 4], acc[8 * s2 + 5]); pw.w = cvtpk(acc[8 * s2 + 6], acc[8 * s2 + 7]);
            const bf16x8 pb = __builtin_bit_cast(bf16x8, pw);
#pragma unroll
            for (int dt = 0; dt < 2; ++dt) { const LAS bf16_t* va = VLw + (32 * T + 16 * s2 + 4 * hh + qq) * 64 + 32 * dt + 16 * g1 + 4 * pp;
                o[dt] = __builtin_amdgcn_mfma_f32_32x32x16_bf16(cat8(vtr(va), vtr(va + 8 * 64)), pb, o[dt], 0, 0, 0); } }
    }
    l_run += __shfl_xor(l_run, 32);
    const float mx = m_run, ls = l_run;
    m_out = mx; l_out = ls;
}

__device__ __forceinline__ void attn_ctx_unit(Frame& F, int unit) {
    const bf16_t* U = (const bf16_t*)(F.ws + WS_U); bf16_t* ON = (bf16_t*)(F.ws + WS_ON);
    const int b = unit >> 3, h = unit & 7, tok0 = b * 256;
    LAS bf16_t* VL = (LAS bf16_t*)(F.lds);
#pragma unroll
    for (int i = 0; i < 4; ++i) { const int p = F.tid + i * NTHR, row = p >> 3, c8 = p & 7;
        *(LAS u32x4*)(VL + row * 64 + 8 * c8) = *(const u32x4*)(U + (size_t)(tok0 + row) * NU + UNV + 64 * h + 8 * c8); }
    __syncthreads();
    f32x16 o[2]; float mx, ls; AttnLocal L{nullptr, 0, 0};
    attn_wave<true, false>(F, U, tok0 + 32 * F.wave, h, tok0, nullptr, VL, L, o, mx, ls);
    { const int hh = F.lane >> 5, c31 = F.lane & 31; const float inv = 1.f / ls; bf16_t* op = ON + (size_t)(tok0 + 32 * F.wave + c31) * 512 + 64 * h;
#pragma unroll
      for (int dt = 0; dt < 2; ++dt)
#pragma unroll
          for (int rg = 0; rg < 4; ++rg) { u32x2 w; w.x = cvtpk(o[dt][4 * rg] * inv, o[dt][4 * rg + 1] * inv); w.y = cvtpk(o[dt][4 * rg + 2] * inv, o[dt][4 * rg + 3] * inv);
              *(u32x2*)(op + 32 * dt + 8 * rg + 4 * hh) = w; } }
    __syncthreads();
}

__device__ __forceinline__ void attn_lat_unit(Frame& F, int unit) {
    const bf16_t* U = (const bf16_t*)(F.ws + WS_U); bf16_t* ON = (bf16_t*)(F.ws + WS_ON);
    const int r = unit & 15, h = (unit >> 4) & 7, bl = unit >> 7;
    const int rs = min(max(r - 4, 0), 8), ltok0 = NCTX + bl * 1024 + rs * 64, qrow0 = NCTX + bl * 1024 + r * 64;
    LAS bf16_t* VL = (LAS bf16_t*)(F.lds);
    LAS float* RPB = (LAS float*)(F.lds + 131072);
    LAS float* ML = (LAS float*)(F.lds + 133120);
    LAS float* PO = (LAS float*)(F.lds);
    const float* cv = F.in[4] + (size_t)bl * 512 * 512;
#pragma unroll
    for (int i = 0; i < 8; ++i) { const int p = F.tid + i * NTHR, row = p >> 3, c8 = p & 7;
        *(LAS u32x4*)(VL + row * 64 + 8 * c8) = *(const u32x4*)(U + (size_t)(ltok0 + row) * NU + UNV + 64 * h + 8 * c8); }
#pragma unroll
    for (int i = 0; i < 8; ++i) { const int p = F.tid + i * NTHR, row = p >> 3, c8 = p & 7; const float* vp = cv + ((size_t)row * 8 + h) * 64 + 8 * c8;
        const f32x4 a = *(const f32x4*)vp, b2 = *(const f32x4*)(vp + 4);
        u32x4 w; w.x = cvtpk(a[0], a[1]); w.y = cvtpk(a[2], a[3]); w.z = cvtpk(b2[0], b2[1]); w.w = cvtpk(b2[2], b2[3]);
        *(LAS u32x4*)(VL + (512 + row) * 64 + 8 * c8) = w; }
    if (F.tid < 480) { const int dr = F.tid >> 5, dc = F.tid & 31; RPB[F.tid] = dc < 31 ? F.in[19][(h * 15 + dr) * 31 + dc] * LOG2E : 0.f; }
    __syncthreads();
    const int qg = F.wave >> 2, kb = F.wave & 3;
    f32x16 o[2]; float mx, ls;
    if (kb < 2) { AttnLocal L{RPB, rs + 4 * kb - r + 7, 32 * qg}; attn_wave<true, true>(F, U, qrow0 + 32 * qg, h, ltok0 + 256 * kb, nullptr, VL + 256 * kb * 64, L, o, mx, ls); }
    else { AttnLocal L{nullptr, 0, 0}; attn_wave<false, false>(F, U, qrow0 + 32 * qg, h, bl * 512 + 256 * (kb - 2), F.in[3], VL + (512 + 256 * (kb - 2)) * 64, L, o, mx, ls); }
    __syncthreads();
    { const int hh = F.lane >> 5, c31 = F.lane & 31;
#pragma unroll
      for (int dt = 0; dt < 2; ++dt)
#pragma unroll
          for (int rr = 0; rr < 16; ++rr) PO[(F.wave * 64 + 32 * dt + crow(rr, hh)) * 32 + c31] = o[dt][rr];
      if (hh == 0) { ML[F.wave * 64 + c31] = mx; ML[F.wave * 64 + 32 + c31] = ls; } }
    __syncthreads();
    { const int q = F.tid & 31, dv8 = (F.tid >> 5) & 7, qg2 = F.tid >> 8;
      float M = -INFINITY;
#pragma unroll
      for (int w = 0; w < 4; ++w) M = fmaxf(M, ML[(4 * qg2 + w) * 64 + q]);
      float Ls = 0.f, acc[8];
#pragma unroll
      for (int e = 0; e < 8; ++e) acc[e] = 0.f;
#pragma unroll
      for (int w = 0; w < 4; ++w) { const int ww = 4 * qg2 + w; const float wt = __builtin_amdgcn_exp2f(ML[ww * 64 + q] - M); Ls += wt * ML[ww * 64 + 32 + q];
#pragma unroll
          for (int e = 0; e < 8; ++e) acc[e] += wt * PO[(ww * 64 + 8 * dv8 + e) * 32 + q]; }
      const float inv = 1.f / Ls;
#pragma unroll
      for (int e = 0; e < 8; ++e) acc[e] *= inv;
      *(u32x4*)(ON + (size_t)(qrow0 + 32 * qg2 + q) * 512 + 64 * h + 8 * dv8) = pack8(acc); }
    __syncthreads();
}

__device__ __forceinline__ void convgate_rows(Frame& F) {
    const bf16_t* U2 = (const bf16_t*)(F.ws + WS_U2); bf16_t* ACT = (bf16_t*)(F.ws + WS_ACT);
    const float* wc = F.in[25]; const float* bc = F.in[26];
    const int NV8 = DFF / 8;
    for (size_t idx = (size_t)F.bid * NTHR + F.tid; idx < (size_t)MTOK * NV8; idx += (size_t)F.G * NTHR) {
        const int m = (int)(idx / NV8), c = (int)(idx % NV8) * 8;
        const int T = m < NCTX ? 256 : 1024, t = m < NCTX ? (m & 255) : ((m - NCTX) & 1023);
        float a[8], g[8];
#pragma unroll
        for (int e = 0; e < 8; ++e) { a[e] = bc[c + e]; g[e] = bc[DFF + c + e]; }
#pragma unroll
        for (int j = 0; j < 3; ++j) { const int tt = t + j - 1; if (tt < 0 || tt >= T) continue;
            float ua[8], ug[8]; const bf16_t* u = U2 + (size_t)(m + j - 1) * NUP + c; unpack8(*(const u32x4*)u, ua); unpack8(*(const u32x4*)(u + DFF), ug);
#pragma unroll
            for (int e = 0; e < 8; ++e) { a[e] += wc[j * NUP + c + e] * ua[e]; g[e] += wc[j * NUP + DFF + c + e] * ug[e]; } }
        float o[8];
#pragma unroll
        for (int e = 0; e < 8; ++e) o[e] = a[e] * siluf_(g[e]);
        *(u32x4*)(ACT + (size_t)m * DFF + c) = pack8(o);
    }
}

namespace nv {
__device__ __forceinline__ float bf(const bf16_t* p) { return __uint_as_float((unsigned)(*p) << 16); }
__device__ __forceinline__ bf16_t tobf(float f) { return (bf16_t)(cvtpk(f, 0.f) & 0xffffu); }
__device__ __forceinline__ float logsig(float x) { return fminf(x, 0.f) - log1pf(expf(-fabsf(x))); }

__global__ void ada_k(const float* c_ctx, const float* c, const float* w, const float* b, float* ada) {
    const int idx = blockIdx.x * blockDim.x + threadIdx.x; if (idx >= 3 * 6144) return;
    const int cn = idx / 6144, j = idx % 6144; const float* cond = cn == 0 ? c_ctx : c + (cn - 1) * 1024;
    float s = b[j];
    for (int k = 0; k < 1024; ++k) { const float v = cond[k]; s += (v / (1.f + expf(-v))) * w[(size_t)k * 6144 + j]; }
    ada[idx] = s;
}
__global__ void norm_k(const float* x0, const float* x1, const float* g, const float* ada, int off_sh, int off_sc, bf16_t* H) {
    __shared__ float red[256];
    const int m = blockIdx.x; const float* xr = m < NCTX ? x0 + (size_t)m * DM : x1 + (size_t)(m - NCTX) * DM;
    float s = 0.f; for (int k = threadIdx.x; k < DM; k += 256) s += xr[k] * xr[k];
    red[threadIdx.x] = s; __syncthreads();
    for (int o = 128; o > 0; o >>= 1) { if (threadIdx.x < o) red[threadIdx.x] += red[threadIdx.x + o]; __syncthreads(); }
    const float rinv = rsqrtf(red[0] / DM + EPS); const float* ad = ada + cond_of(m) * 6144;
    for (int k = threadIdx.x; k < DM; k += 256) H[(size_t)m * DM + k] = tobf(xr[k] * rinv * g[k] * (1.f + ad[off_sc + k]) + ad[off_sh + k]);
}
struct GArgs { const bf16_t* A; const float* W; int K, ldw, M, N; };
template <class F> __global__ void gemm_k(GArgs g, F f) {
    const size_t idx = (size_t)blockIdx.x * blockDim.x + threadIdx.x; if (idx >= (size_t)g.M * g.N) return;
    const int m = (int)(idx / g.N), n = (int)(idx % g.N);
    float s = 0.f; const bf16_t* a = g.A + (size_t)m * g.K;
    for (int k = 0; k < g.K; ++k) s += bf(a + k) * g.W[(size_t)k * g.ldw + n];
    f(m, n, s);
}
struct StIn { bf16_t* U; float* Z; __device__ void operator()(int m, int n, float s) const { if (n >= 1536 && n < 1568) Z[(size_t)m * 32 + n - 1536] = s; else U[(size_t)m * NU + n - (n >= 1568 ? 32 : 0)] = tobf(s); } };
struct StBf { bf16_t* O; int ld, pad; __device__ void operator()(int m, int n, float s) const { O[(size_t)m * ld + n] = tobf(s); } };
struct StF32 { float* O; int ld, pad; __device__ void operator()(int m, int n, float s) const { O[(size_t)m * ld + n] = s; } };
struct StRes { const float* b0; const float* b1; float* out; const float* gate; __device__ void operator()(int m, int n, float s) const {
    const float base = m < NCTX ? b0[(size_t)m * DM + n] : b1[(size_t)(m - NCTX) * DM + n]; out[(size_t)m * DM + n] = base + gate[cond_of(m) * 6144 + n] * s; } };

__global__ void kvout_k(const bf16_t* U, const float* gk, float* out) {
    const int idx = blockIdx.x * blockDim.x + threadIdx.x; if (idx >= NCTX * 8) return;
    const int m = idx / 8, h = idx % 8; const bf16_t* k = U + (size_t)m * NU + UNK + 64 * h; const bf16_t* v = U + (size_t)m * NU + UNV + 64 * h;
    float s = 0.f; for (int d = 0; d < 64; ++d) s += bf(k + d) * bf(k + d);
    const float rinv = rsqrtf(s / 64.f + EPS);
    for (int d = 0; d < 64; ++d) { out[O_NK + (size_t)m * 512 + 64 * h + d] = bf(k + d) * rinv * gk[d]; out[O_NV + (size_t)m * 512 + 64 * h + d] = bf(v + d); }
}
__global__ void decay_k(const float* Z, const float* waf, const float* baf, const float* wab, const float* bab, float* Adec) {
    const int idx = blockIdx.x * blockDim.x + threadIdx.x; if (idx >= 2 * MTOK * 256) return;
    const int dir = idx / (MTOK * 256), m = (idx / 256) % MTOK, c = idx % 256; const float* w = dir ? wab : waf; const float* b = dir ? bab : baf;
    float s = b[c]; for (int j = 0; j < 16; ++j) s += Z[(size_t)m * 32 + 16 * dir + j] * w[j * 256 + c];
    Adec[idx] = expf(logsig(s) / 16.f);
}
__global__ void __launch_bounds__(256) gla_k(const bf16_t* U, const float* Adec, const float* s0f, const float* s0b, float* OT, float* out) {
    const int idx = blockIdx.x * blockDim.x + threadIdx.x; if (idx >= 18 * 4 * 2 * 128) return;
    const int dv = idx % 128, dir = (idx / 128) % 2, h = (idx / 256) % 4, seq = idx / 1024;
    const int T = seq < 16 ? 256 : 1024, base = seq < 16 ? seq * 256 : NCTX + (seq - 16) * 1024;
    float S[64];
    if (seq < 16) { for (int d = 0; d < 64; ++d) S[d] = 0.f; }
    else { const float* s0 = (dir ? s0b : s0f) + ((size_t)((seq - 16) * 4 + h) * 64) * 128; for (int d = 0; d < 64; ++d) S[d] = s0[d * 128 + dv]; }
    for (int st = 0; st < T; ++st) {
        const int m = base + (dir ? T - 1 - st : st);
        const bf16_t* u = U + (size_t)m * NU; const float v = bf(u + UV + 128 * h + dv); const float* a = Adec + ((size_t)dir * MTOK + m) * 256 + 64 * h;
        float o = 0.f;
#pragma unroll
        for (int d = 0; d < 64; ++d) { S[d] = a[d] * S[d] + bf(u + UK + 64 * h + d) * v; o += bf(u + UQ + 64 * h + d) * 0.125f * S[d]; }
        OT[((size_t)dir * MTOK + m) * 512 + 128 * h + dv] = o;
    }
    if (seq < 16) { float* os = out + (dir ? O_SB : O_SF) + ((size_t)(seq * 4 + h) * 64) * 128; for (int d = 0; d < 64; ++d) os[d * 128 + dv] = S[d]; }
}
__global__ void glanorm_k(const float* OT, const bf16_t* U, const float* gg, bf16_t* OG) {
    const int idx = blockIdx.x * blockDim.x + threadIdx.x; if (idx >= MTOK * 4) return;
    const int m = idx / 4, h = idx % 4; const float* a = OT + (size_t)m * 512 + 128 * h; const float* b = OT + ((size_t)MTOK + m) * 512 + 128 * h;
    float s = 0.f; for (int d = 0; d < 128; ++d) { const float o = a[d] + b[d]; s += o * o; }
    const float rinv = rsqrtf(s / 128.f + EPS);
    for (int d = 0; d < 128; ++d) { const float r = bf(U + (size_t)m * NU + UR + 128 * h + d); OG[(size_t)m * 512 + 128 * h + d] = tobf((a[d] + b[d]) * rinv * gg[d] * (r / (1.f + expf(-r)))); }
}
__global__ void __launch_bounds__(256) attn_k(const bf16_t* U, const float* gq, const float* gk, const float* ck, const float* cv, const float* rpb, bf16_t* ON) {
    const int idx = blockIdx.x * blockDim.x + threadIdx.x; if (idx >= MTOK * 16) return;
    const int m = idx / 16, h = (idx % 16) / 2, part = idx % 2;
    float q[64]; { float s = 0.f; const bf16_t* qp = U + (size_t)m * NU + UNQ + 64 * h;
#pragma unroll
        for (int d = 0; d < 64; ++d) { q[d] = bf(qp + d); s += q[d] * q[d]; }
        const float rinv = rsqrtf(s / 64.f + EPS);
#pragma unroll
        for (int d = 0; d < 64; ++d) q[d] *= rinv * gq[d] * 0.125f; }
    float mx = -INFINITY, l = 0.f, o[32];
#pragma unroll
    for (int d = 0; d < 32; ++d) o[d] = 0.f;
#define NV_STEP(sc, VEXPR) do { const float sc_ = (sc); const float mn_ = fmaxf(mx, sc_), f_ = expf(mx - mn_), p_ = expf(sc_ - mn_); l = l * f_ + p_; \
        _Pragma("unroll") for (int d = 0; d < 32; ++d) o[d] = o[d] * f_ + p_ * (VEXPR); mx = mn_; } while (0)
#define NV_UKEY(tok, bias) do { const bf16_t* kp = U + (size_t)(tok) * NU + UNK + 64 * h; const bf16_t* vp = U + (size_t)(tok) * NU + UNV + 64 * h + 32 * part; \
        float s_ = 0.f, dt_ = 0.f; _Pragma("unroll") for (int d = 0; d < 64; ++d) { const float k = bf(kp + d); s_ += k * k; dt_ += q[d] * k * gk[d]; } \
        NV_STEP(dt_ * rsqrtf(s_ / 64.f + EPS) + (bias), bf(vp + d)); } while (0)
    if (m < NCTX) { const int b0 = (m / 256) * 256; for (int j = 0; j < 256; ++j) NV_UKEY(b0 + j, 0.f); }
    else {
        const int bl = (m - NCTX) / 1024, t = (m - NCTX) % 1024, r = t / 64, c = t % 64;
        const int rs = min(max(r - 4, 0), 8), cs = min(max(c - 8, 0), 48);
        for (int i = 0; i < 8; ++i) for (int kc = cs; kc < cs + 16; ++kc) { const int kr = rs + i; const int dc = min(max(kc - c, -15), 15) + 15;
            NV_UKEY(NCTX + bl * 1024 + kr * 64 + kc, rpb[(h * 15 + (kr - r + 7)) * 31 + dc]); }
        for (int lk = 0; lk < 512; ++lk) { const float* kp = ck + ((size_t)(bl * 512 + lk) * 8 + h) * 64; const float* vp = cv + ((size_t)(bl * 512 + lk) * 8 + h) * 64 + 32 * part;
            float dt = 0.f;
#pragma unroll
            for (int d = 0; d < 64; ++d) dt += q[d] * kp[d];
            NV_STEP(dt, vp[d]); }
    }
#pragma unroll
    for (int d = 0; d < 32; ++d) ON[(size_t)m * 512 + 64 * h + 32 * part + d] = tobf(o[d] / l);
#undef NV_STEP
#undef NV_UKEY
}
__global__ void mix_k(const float* BG, const float* BN, const bf16_t* U, bf16_t* MIX) {
    const size_t idx = (size_t)blockIdx.x * blockDim.x + threadIdx.x; if (idx >= (size_t)MTOK * DM) return;
    const int m = (int)(idx / DM), n = (int)(idx % DM); const float mg = bf(U + (size_t)m * NU + UMG + n), mn = bf(U + (size_t)m * NU + UMN + n);
    MIX[idx] = tobf(BG[idx] / (1.f + expf(-mg)) + BN[idx] / (1.f + expf(-mn)));
}
__global__ void convgate_k(const bf16_t* U2, const float* wc, const float* bc, bf16_t* ACT) {
    const size_t idx = (size_t)blockIdx.x * blockDim.x + threadIdx.x; if (idx >= (size_t)MTOK * DFF) return;
    const int m = (int)(idx / DFF), c = (int)(idx % DFF);
    const int T = m < NCTX ? 256 : 1024, t = m < NCTX ? m % 256 : (m - NCTX) % 1024;
    float a = bc[c], g = bc[DFF + c];
    for (int j = 0; j < 3; ++j) { const int tt = t + j - 1; if (tt < 0 || tt >= T) continue; const bf16_t* u = U2 + (size_t)(m + j - 1) * NUP; a += wc[j * NUP + c] * bf(u + c); g += wc[j * NUP + DFF + c] * bf(u + DFF + c); }
    ACT[idx] = tobf(a * (g / (1.f + expf(-g))));
}
}

struct Args { const float* in[28]; float* out; unsigned char* ws; int ph_lo, ph_hi; };

__global__ void __launch_bounds__(NTHR, 2) fwd_kernel(Args args) {
    extern __shared__ __attribute__((aligned(16))) unsigned char lds_raw[];
    Frame F;
    F.lds = (LAS unsigned char*)lds_raw;
    F.tid = threadIdx.x; F.lane = F.tid & 63; F.wave = __builtin_amdgcn_readfirstlane(F.tid >> 6);
    F.G = gridDim.x; F.bid = blockIdx.x;
#pragma unroll
    for (int i = 0; i < 28; ++i) F.in[i] = args.in[i];
    F.out = args.out; F.ws = args.ws;
    const int lo = args.ph_lo, hi = args.ph_hi;
    const bool multi = (hi - lo) > 1;
    volatile LAS unsigned* MISC = (volatile LAS unsigned*)(F.lds + MISC_OFF);
    if (F.tid < 16) MISC[F.tid] = 0u;
    __syncthreads();
    XcdBarrier bar; bar.bar = (unsigned*)(F.ws + WS_CTL) + 4096; bar.x = 0; bar.st = MISC + 8;
    if (multi) bar = xcd_barrier_post((unsigned*)(F.ws + WS_CTL) + 4096, MISC + 8);
#define IN(k) (lo <= (k) && (k) < hi)
#define GRID_BAR() do { if (multi) xcd_barrier(bar); } while (0)

    if (IN(0)) { p0_prologue(F); GRID_BAR(); }
    if (IN(1)) { norm_rows<false>(F, F.in[10], 0, 1024); GRID_BAR(); }
    if (IN(2)) {
        pg8::StaticOrder S; S.init(F.ws + WS_H, F.ws + WS_WIN, MTOK, NU, DM, F.G, F.bid);
        pg8::EpiBf16 E{(bf16_t*)(F.ws + WS_U), NU};
        pg8::gemm_phase(F.lds, DM, S, E);
        for (int j = F.G - 1 - F.bid; j < 24; j += F.G) z_item(F, j);
        GRID_BAR();
    }
    if (IN(6)) { for (int u = F.bid; u < 384; u += F.G) { if (u < 256) attn_lat_unit(F, u); else attn_ctx_unit(F, u - 256); } }
    if (IN(4)) { for (int it = F.bid; it < 384; it += F.G) gla_pass1_item(F, it); }
    if (IN(3)) { for (int c = F.bid; c < 256; c += F.G) kvout_rows(F, 16 * c, 16); }
    if (IN(3) || IN(4) || IN(6)) GRID_BAR();
    if (IN(5)) {
        if (F.G == 256) { if (F.bid < 128) gla_pass2_item(F, 256 + F.bid); else { gla_pass2_item(F, F.bid - 128); gla_pass2_item(F, F.bid); } }
        else for (int it = F.bid; it < 384; it += F.G) gla_pass2_item(F, it);
        GRID_BAR();
    }
    if (IN(7)) {
        pg8::PairOrder S; S.init(F.ws + WS_OG, F.ws + WS_WGO, F.ws + WS_ON, F.ws + WS_WNO, MTOK, DM, 512, F.G, F.bid);
        pg8::EpiGate E{(const bf16_t*)(F.ws + WS_U), (float*)(F.ws + WS_BG), (bf16_t*)(F.ws + WS_MIX)};
        pg8::gemm_phase(F.lds, 512, S, E);
        GRID_BAR();
    }
    if (IN(8)) {
        pg8::StaticOrder S; S.init(F.ws + WS_MIX, F.ws + WS_WOUT, MTOK, DM, DM, F.G, F.bid);
        pg8::EpiResid E{F.in[0], F.in[1], F.out, (const float*)(F.ws + WS_ADA) + 2048};
        pg8::gemm_phase(F.lds, DM, S, E);
        GRID_BAR();
    }
    if (IN(9)) { norm_rows<true>(F, F.in[23], 3072, 4096); GRID_BAR(); }
    if (IN(10)) {
        pg8::StaticOrder S; S.init(F.ws + WS_H, F.ws + WS_WUP, MTOK, NUP, DM, F.G, F.bid);
        pg8::EpiBf16 E{(bf16_t*)(F.ws + WS_U2), NUP};
        pg8::gemm_phase(F.lds, DM, S, E);
        GRID_BAR();
    }
    if (IN(11)) { convgate_rows(F); GRID_BAR(); }
    if (IN(12)) {
        pg8::StaticOrder S; S.init(F.ws + WS_ACT, F.ws + WS_WDN, MTOK, DM, DFF, F.G, F.bid);
        pg8::EpiResid E{F.out, F.out + (size_t)NCTX * DM, F.out, (const float*)(F.ws + WS_ADA) + 5120};
        pg8::gemm_phase(F.lds, DFF, S, E);
    }
#undef IN
}

#ifndef FUSED_MASK
#define FUSED_MASK 0xFFFu
#endif
constexpr unsigned FUSED = FUSED_MASK;
constexpr size_t WS_ADEC = 168 * MiB, WS_OT = 181 * MiB, WS_BN = 72 * MiB;

extern "C" void kernel_launch(void* const* d_in, const int* in_sizes, int n_in, void* d_out, int out_size, void* d_ws, size_t ws_size, hipStream_t stream) {
    static int grid = 0;
    if (grid == 0) {
        if (n_in != 28 || ws_size < WS_END) { fprintf(stderr, "kernel_launch: unexpected n_in %d / ws %zu\n", n_in, ws_size); grid = -1; return; }
        int dev = 0, cus = 0, per_cu = 0;
        (void)hipGetDevice(&dev);
        (void)hipDeviceGetAttribute(&cus, hipDeviceAttributeMultiprocessorCount, dev);
        (void)hipFuncSetAttribute((const void*)fwd_kernel, hipFuncAttributeMaxDynamicSharedMemorySize, LDS_BYTES);
        (void)hipOccupancyMaxActiveBlocksPerMultiprocessor(&per_cu, (const void*)fwd_kernel, NTHR, LDS_BYTES);
        (void)hipGetLastError();
        if (per_cu < 1) { fprintf(stderr, "kernel_launch: occupancy query reports 0 workgroups per CU\n"); grid = -1; return; }
        grid = cus;
        if (grid > 256) grid = 256;
    }
    if (grid < 0) return;
    (void)hipMemsetAsync((char*)d_ws + WS_CTL, 0, CTL_BYTES, stream);
    Args a{};
    for (int i = 0; i < 28; ++i) a.in[i] = (const float*)d_in[i];
    a.out = (float*)d_out; a.ws = (unsigned char*)d_ws;
    const float* const* in = (const float* const*)d_in;
    unsigned char* ws = (unsigned char*)d_ws; float* out = (float*)d_out;
    bf16_t *H = (bf16_t*)(ws + WS_H), *U = (bf16_t*)(ws + WS_U), *OG = (bf16_t*)(ws + WS_OG), *ON = (bf16_t*)(ws + WS_ON), *MIX = (bf16_t*)(ws + WS_MIX), *U2 = (bf16_t*)(ws + WS_U2), *ACT = (bf16_t*)(ws + WS_ACT);
    float *ADA = (float*)(ws + WS_ADA), *Z = (float*)(ws + WS_Z), *ADEC = (float*)(ws + WS_ADEC), *OT = (float*)(ws + WS_OT), *BG = (float*)(ws + WS_BG), *BN = (float*)(ws + WS_BN);
    if (ONE_LAUNCH) {
        a.ph_lo = 0; a.ph_hi = 13;
        void* kargs[] = {&a};
        hipError_t e = hipLaunchCooperativeKernel((const void*)fwd_kernel, dim3(grid), dim3(NTHR), kargs, LDS_BYTES, stream);
        if (e != hipSuccess) fprintf(stderr, "kernel_launch: cooperative launch failed: %s (grid %d)\n", hipGetErrorString(e), grid);
        return;
    }
    auto fused = [&](int p) { a.ph_lo = p; a.ph_hi = p + 1; hipLaunchKernelGGL(fwd_kernel, dim3(grid), dim3(NTHR), LDS_BYTES, stream, a); };
    auto nb = [](size_t n) { return dim3((unsigned)((n + 255) / 256)); };
    if (FUSED & 1u) fused(0);
    else { if (FUSED) fused(0); hipLaunchKernelGGL(nv::ada_k, nb(3 * 6144), dim3(256), 0, stream, in[7], in[2], in[8], in[9], ADA); }
    if (FUSED & 2u) fused(1); else hipLaunchKernelGGL(nv::norm_k, dim3(MTOK), dim3(256), 0, stream, in[0], in[1], in[10], (const float*)ADA, 0, 1024, H);
    if (FUSED & 4u) fused(2); else hipLaunchKernelGGL(nv::gemm_k<nv::StIn>, nb((size_t)MTOK * DIN), dim3(256), 0, stream, nv::GArgs{H, in[11], 1024, DIN, MTOK, DIN}, nv::StIn{U, Z});
    if (FUSED & 8u) fused(3); else hipLaunchKernelGGL(nv::kvout_k, nb(NCTX * 8), dim3(256), 0, stream, (const bf16_t*)U, in[18], out);
    if (FUSED & 0x10u) { fused(4); fused(5); }
    else {
    hipLaunchKernelGGL(nv::decay_k, nb((size_t)2 * MTOK * 256), dim3(256), 0, stream, (const float*)Z, in[12], in[13], in[14], in[15], ADEC);
    hipLaunchKernelGGL(nv::gla_k, nb(18 * 4 * 2 * 128), dim3(256), 0, stream, (const bf16_t*)U, (const float*)ADEC, in[5], in[6], OT, out);
    hipLaunchKernelGGL(nv::glanorm_k, nb(MTOK * 4), dim3(256), 0, stream, (const float*)OT, (const bf16_t*)U, in[16], OG);
    }
    if (FUSED & 0x20u) fused(6); else
    hipLaunchKernelGGL(nv::attn_k, nb(MTOK * 16), dim3(256), 0, stream, (const bf16_t*)U, in[17], in[18], in[3], in[4], in[19], ON);
    if (FUSED & 0x40u) fused(7); else {
    hipLaunchKernelGGL(nv::gemm_k<nv::StF32>, nb((size_t)MTOK * DM), dim3(256), 0, stream, nv::GArgs{OG, in[20], 512, DM, MTOK, DM}, nv::StF32{BG, DM, 0});
    hipLaunchKernelGGL(nv::gemm_k<nv::StF32>, nb((size_t)MTOK * DM), dim3(256), 0, stream, nv::GArgs{ON, in[21], 512, DM, MTOK, DM}, nv::StF32{BN, DM, 0});
    hipLaunchKernelGGL(nv::mix_k, nb((size_t)MTOK * DM), dim3(256), 0, stream, (const float*)BG, (const float*)BN, (const bf16_t*)U, MIX);
    }
    if (FUSED & 0x80u) fused(8); else
    hipLaunchKernelGGL(nv::gemm_k<nv::StRes>, nb((size_t)MTOK * DM), dim3(256), 0, stream, nv::GArgs{MIX, in[22], DM, DM, MTOK, DM}, nv::StRes{in[0], in[1], out, ADA + 2048});
    if (FUSED & 0x100u) fused(9); else
    hipLaunchKernelGGL(nv::norm_k, dim3(MTOK), dim3(256), 0, stream, (const float*)out, (const float*)(out + (size_t)NCTX * DM), in[23], (const float*)ADA, 3072, 4096, H);
    if (FUSED & 0x200u) fused(10); else
    hipLaunchKernelGGL(nv::gemm_k<nv::StBf>, nb((size_t)MTOK * NUP), dim3(256), 0, stream, nv::GArgs{H, in[24], DM, NUP, MTOK, NUP}, nv::StBf{U2, NUP, 0});
    if (FUSED & 0x400u) fused(11); else
    hipLaunchKernelGGL(nv::convgate_k, nb((size_t)MTOK * DFF), dim3(256), 0, stream, (const bf16_t*)U2, in[25], in[26], ACT);
    if (FUSED & 0x800u) fused(12); else
    hipLaunchKernelGGL(nv::gemm_k<nv::StRes>, nb((size_t)MTOK * DM), dim3(256), 0, stream, nv::GArgs{ACT, in[27], DFF, DM, MTOK, DM}, nv::StRes{(const float*)out, (const float*)(out + (size_t)NCTX * DM), out, ADA + 5120});
}
```

```cpp
#include <hip/hip_runtime.h>
#include <cstdio>
#include <cstdint>

#ifndef HOST_REP
#define HOST_REP -1
#endif
#ifndef REP_MASK
#define REP_MASK 0u
#endif
#ifndef ONE_LAUNCH
#define ONE_LAUNCH 1
#endif

#define LAS __attribute__((address_space(3)))
#define GAS __attribute__((address_space(1)))
typedef unsigned short bf16_t;
typedef short bf16x8 __attribute__((ext_vector_type(8)));
typedef short s16x4 __attribute__((ext_vector_type(4)));
typedef float f32x2 __attribute__((ext_vector_type(2)));
typedef float f32x4 __attribute__((ext_vector_type(4)));
typedef float f32x16 __attribute__((ext_vector_type(16)));
typedef unsigned u32x2 __attribute__((ext_vector_type(2)));
typedef unsigned u32x4 __attribute__((ext_vector_type(4)));
typedef __bf16 bf16x2_t __attribute__((ext_vector_type(2)));

constexpr int DM = 1024, NCTX = 4096, NLAT = 2048, MTOK = 6144, DIN = 5152, NU = 5120, DFF = 2816, NUP = 5632;
constexpr int UQ = 0, UK = 256, UV = 512, UR = 1024, UNQ = 1536, UNK = 2048, UNV = 2560, UMG = 3072, UMN = 4096;
constexpr float EPS = 1e-6f;
constexpr float LOG2E = 1.4426950408889634f;
constexpr size_t O_YP = 0, O_YS = 4194304, O_NK = 6291456, O_NV = 8388608, O_SF = 10485760, O_SB = 11010048;
constexpr size_t MiB = 1u << 20;
constexpr size_t WS_CTL = 0, CTL_BYTES = 1 * MiB;
constexpr size_t WS_ADA = 1 * MiB;
constexpr size_t WS_WZT = 2 * MiB;
constexpr size_t WS_WIN = 3 * MiB;
constexpr size_t WS_WGO = 13 * MiB;
constexpr size_t WS_WNO = 14 * MiB;
constexpr size_t WS_WOUT = 15 * MiB;
constexpr size_t WS_WUP = 17 * MiB;
constexpr size_t WS_WDN = 28 * MiB;
constexpr size_t WS_H = 34 * MiB;
constexpr size_t WS_Z = 46 * MiB;
constexpr size_t WS_OG = 47 * MiB;
constexpr size_t WS_ON = 53 * MiB;
constexpr size_t WS_DEC = 59 * MiB;
constexpr size_t WS_QK = 60 * MiB;
constexpr size_t WS_KV = 72 * MiB;
constexpr size_t WS_MIX = 96 * MiB;
constexpr size_t WS_U = 108 * MiB;
constexpr size_t WS_U2 = 168 * MiB;
constexpr size_t WS_ACT = 108 * MiB;
constexpr size_t WS_BG = 205 * MiB;
constexpr size_t WS_END = 234 * MiB;

constexpr int NWAVES = 8, NTHR = 512;
constexpr int LDS_BYTES = 147456;
constexpr int RING_BYTES = 131072;
constexpr int MISC_OFF = RING_BYTES + 8192;

__device__ __forceinline__ unsigned cvtpk(float lo, float hi) { f32x2 v = {lo, hi}; bf16x2_t b = __builtin_convertvector(v, bf16x2_t); return __builtin_bit_cast(unsigned, b); }
__device__ __forceinline__ float bflo(unsigned u) { return __uint_as_float(u << 16); }
__device__ __forceinline__ float bfhi(unsigned u) { return __uint_as_float(u & 0xffff0000u); }
__device__ __forceinline__ float wave_sum(float v) {
#pragma unroll
    for (int o = 1; o < 64; o <<= 1) v += __shfl_xor(v, o);
    return v;
}
__device__ __forceinline__ float sigmoidf_(float x) { return 1.f / (1.f + __expf(-x)); }
__device__ __forceinline__ float siluf_(float x) { return x / (1.f + __expf(-x)); }
__device__ __forceinline__ int crow(int r, int hi) { return (r & 3) + 8 * (r >> 2) + 4 * hi; }
__device__ __forceinline__ s16x4 vtr(const LAS void* p) { typedef short v4i16_t __attribute__((ext_vector_type(4))); return __builtin_bit_cast(s16x4, __builtin_amdgcn_ds_read_tr16_b64_v4i16((LAS v4i16_t*)p)); }
__device__ __forceinline__ bf16x8 cat8(s16x4 lo, s16x4 hi) { return (bf16x8){lo[0], lo[1], lo[2], lo[3], hi[0], hi[1], hi[2], hi[3]}; }
__device__ __forceinline__ void unpack8(u32x4 v, float (&f)[8]) { f[0] = bflo(v.x); f[1] = bfhi(v.x); f[2] = bflo(v.y); f[3] = bfhi(v.y); f[4] = bflo(v.z); f[5] = bfhi(v.z); f[6] = bflo(v.w); f[7] = bfhi(v.w); }
__device__ __forceinline__ u32x4 pack8(const float (&f)[8]) { u32x4 v; v.x = cvtpk(f[0], f[1]); v.y = cvtpk(f[2], f[3]); v.z = cvtpk(f[4], f[5]); v.w = cvtpk(f[6], f[7]); return v; }

namespace pg8 {
constexpr int BM = 256, BK = 64, HALF = 128, HTB = HALF * BK * 2, STAGE_BYTES = 8 * HTB, NXCD = 8, WGM = 8;
__host__ __device__ __forceinline__ int lds_byte(int r, int c) { const int st = (r >> 4) * 2 + (c >> 5), rr = r & 15, cc = c & 31, ob = rr * 64 + cc * 2; return st * 1024 + (ob ^ (((ob >> 9) & 1) << 5)); }
__host__ __device__ __forceinline__ void stage_rc(int b, int& R, int& C) { const int st = b / 1024, sb = b % 1024, swz = sb ^ (((sb >> 9) & 1) << 5); R = (st >> 1) * 16 + swz / 64; C = (st & 1) * 32 + (swz % 64) / 2; }
__host__ __device__ __forceinline__ int perm32(int rho) { const int n = rho >> 4, i = rho & 15; return 8 * (i >> 2) + 4 * n + (i & 3); }

struct Unit { int pm, pn; const char* A; const char* B; int chain; };
__device__ __forceinline__ const char* uptr(const char* p) { const unsigned long long v = (unsigned long long)p; const unsigned lo = __builtin_amdgcn_readfirstlane((unsigned)v), hi = __builtin_amdgcn_readfirstlane((unsigned)(v >> 32)); return (const char*)(((unsigned long long)hi << 32) | lo); }

struct StaticOrder {
    int nM, nN, nwg, G, c; const char* Ab; const char* Bb; size_t tstep;
    __device__ void init(const void* A, const void* Bt, int M, int N, int K, int G_, int c_) { nM = M / BM; nN = N / BM; nwg = nM * nN; G = G_; c = c_; Ab = (const char*)A; Bb = (const char*)Bt; tstep = (size_t)BM * K * 2; }
    __device__ bool next(int i, Unit& u) const {
        const long L = (long)i * G + c; if (L >= nwg) return false;
        int wgid = (int)L; { const int q = nwg / NXCD, r = nwg % NXCD, xcd = wgid % NXCD, off = wgid / NXCD; wgid = (xcd < r ? xcd * (q + 1) : r * (q + 1) + (xcd - r) * q) + off; }
        const int nig = WGM * nN, gid = wgid / nig, fm = gid * WGM, gsz = (nM - fm) < WGM ? (nM - fm) : WGM;
        u.pm = fm + ((wgid % nig) % gsz); u.pn = (wgid % nig) / gsz; u.A = Ab + (size_t)u.pm * tstep; u.B = Bb + (size_t)u.pn * tstep; u.chain = 0; return true;
    }
};
struct PairOrder {
    int nM, nN, nwg, G, c; const char *A0, *B0, *A1, *B1; size_t tstep;
    __device__ void init(const void* a0, const void* b0, const void* a1, const void* b1, int M, int N, int K, int G_, int c_) { nM = M / BM; nN = N / BM; nwg = nM * nN; G = G_; c = c_; A0 = (const char*)a0; B0 = (const char*)b0; A1 = (const char*)a1; B1 = (const char*)b1; tstep = (size_t)BM * K * 2; }
    __device__ bool next(int i, Unit& u) const {
        const long L = (long)(i >> 1) * G + c; if (L >= nwg) return false;
        const int t = (int)L; u.pm = t / nN; u.pn = t % nN;
        if (i & 1) { u.A = A1 + (size_t)u.pm * tstep; u.B = B1 + (size_t)u.pn * tstep; u.chain = 0; } else { u.A = A0 + (size_t)u.pm * tstep; u.B = B0 + (size_t)u.pn * tstep; u.chain = 1; }
        return true;
    }
};

struct EpiBf16 {
    static constexpr bool PERM = true, HAS_CHAIN = false;
    bf16_t* O; int ldc;
    __device__ __forceinline__ void chain(f32x4 (&)[2][2][4][2], const Unit&, int, int, int, int) const {}
    __device__ __forceinline__ void operator()(const f32x4 (&acc)[2][2][4][2], const Unit& u, int wr, int wc, int fr, int fq) const {
        const int row0 = u.pm * BM + wr * 64 + fr, col0 = u.pn * BM + wc * 32 + 8 * fq;
#pragma unroll
        for (int ai = 0; ai < 2; ++ai)
#pragma unroll
            for (int m = 0; m < 4; ++m) { bf16_t* rowp = O + (size_t)(row0 + ai * HALF + m * 16) * ldc + col0;
#pragma unroll
                for (int bj = 0; bj < 2; ++bj) { const f32x4 v0 = acc[ai][bj][m][0], v1 = acc[ai][bj][m][1];
                    u32x4 w; w.x = cvtpk(v0[0], v0[1]); w.y = cvtpk(v0[2], v0[3]); w.z = cvtpk(v1[0], v1[1]); w.w = cvtpk(v1[2], v1[3]);
                    *(u32x4*)(rowp + bj * HALF) = w; } }
    }
};
struct EpiResid {
    static constexpr bool PERM = false, HAS_CHAIN = false;
    const float* b0; const float* b1; float* out; const float* gate;
    __device__ __forceinline__ void chain(f32x4 (&)[2][2][4][2], const Unit&, int, int, int, int) const {}
    __device__ __forceinline__ void operator()(const f32x4 (&acc)[2][2][4][2], const Unit& u, int wr, int wc, int fr, int fq) const {
        const int rowt = u.pm * BM; const int cond = rowt < NCTX ? 0 : 1 + ((rowt - NCTX) >> 10);
        const char* base = (const char*)(rowt < NCTX ? b0 + (size_t)rowt * DM : b1 + (size_t)(rowt - NCTX) * DM); char* ob = (char*)(out + (size_t)rowt * DM);
        const int col0 = u.pn * BM + wc * 32 + 4 * fq;
        unsigned off = (unsigned)((wr * 64 + fr) * DM + col0) * 4u;
        f32x4 gv[2][2];
#pragma unroll
        for (int bj = 0; bj < 2; ++bj)
#pragma unroll
            for (int n = 0; n < 2; ++n) gv[bj][n] = *(const f32x4*)(gate + cond * 6144 + col0 + bj * HALF + n * 16);
#pragma unroll
        for (int ai = 0; ai < 2; ++ai)
#pragma unroll
            for (int m = 0; m < 4; ++m) {
                asm volatile("" : "+v"(off));
                const unsigned ro = off + (unsigned)((ai * HALF + m * 16) * DM) * 4u;
#pragma unroll
                for (int bj = 0; bj < 2; ++bj)
#pragma unroll
                    for (int n = 0; n < 2; ++n) { const unsigned o2 = ro + (unsigned)(bj * HALF + n * 16) * 4u; const f32x4 bs = *(const f32x4*)(base + (size_t)o2); *(f32x4*)(ob + (size_t)o2) = bs + gv[bj][n] * acc[ai][bj][m][n]; }
                asm volatile("" ::: "memory"); }
    }
};
struct EpiGate {
    static constexpr bool PERM = true, HAS_CHAIN = false;
    const bf16_t* U; float* P; bf16_t* O;
    __device__ __forceinline__ void chain(f32x4 (&)[2][2][4][2], const Unit&, int, int, int, int) const {}
    __device__ __forceinline__ void operator()(const f32x4 (&acc)[2][2][4][2], const Unit& u, int wr, int wc, int fr, int fq) const {
        const int row0 = u.pm * BM + wr * 64 + fr, col0 = u.pn * BM + wc * 32 + 8 * fq;
        const char* Ub = (const char*)U; char* Ob = (char*)O; char* Pb = (char*)P;
        unsigned off = (unsigned)(row0 * NU + col0 + (u.chain ? UMG : UMN)) * 2u, oo = (unsigned)(row0 * DM + col0) * 2u;
#pragma unroll
        for (int ai = 0; ai < 2; ++ai)
#pragma unroll
            for (int m = 0; m < 4; ++m) {
                asm volatile("" : "+v"(off), "+v"(oo));
                const unsigned ro = off + (unsigned)((ai * HALF + m * 16) * NU) * 2u, wo = oo + (unsigned)((ai * HALF + m * 16) * DM) * 2u;
#pragma unroll
                for (int bj = 0; bj < 2; ++bj) { const u32x4 nn = *(const u32x4*)(Ub + (size_t)(ro + bj * HALF * 2)); const unsigned nw[4] = {nn.x, nn.y, nn.z, nn.w};
                    f32x4 v0, v1;
                    v0[0] = acc[ai][bj][m][0][0] * sigmoidf_(bflo(nw[0])); v0[1] = acc[ai][bj][m][0][1] * sigmoidf_(bfhi(nw[0])); v0[2] = acc[ai][bj][m][0][2] * sigmoidf_(bflo(nw[1])); v0[3] = acc[ai][bj][m][0][3] * sigmoidf_(bfhi(nw[1]));
                    v1[0] = acc[ai][bj][m][1][0] * sigmoidf_(bflo(nw[2])); v1[1] = acc[ai][bj][m][1][1] * sigmoidf_(bfhi(nw[2])); v1[2] = acc[ai][bj][m][1][2] * sigmoidf_(bflo(nw[3])); v1[3] = acc[ai][bj][m][1][3] * sigmoidf_(bfhi(nw[3]));
                    f32x4* pp = (f32x4*)(Pb + (size_t)(2u * (wo + bj * HALF * 2)));
                    if (u.chain) { pp[0] = v0; pp[1] = v1; }
                    else { v0 += pp[0]; v1 += pp[1]; u32x4 w; w.x = cvtpk(v0[0], v0[1]); w.y = cvtpk(v0[2], v0[3]); w.z = cvtpk(v1[0], v1[1]); w.w = cvtpk(v1[2], v1[3]);
                        *(u32x4*)(Ob + (size_t)(wo + bj * HALF * 2)) = w; } }
                asm volatile("" ::: "memory"); }
    }
};

template <class Epi, class Sched>
__device__ __forceinline__ void gemm_phase(LAS unsigned char* lds, const int K, const Sched& S, const Epi& E) {
    const int tid = threadIdx.x, wid = __builtin_amdgcn_readfirstlane(tid >> 6), lane = tid & 63, wr = wid >> 2, wc = wid & 3, fr = lane & 15, fq = lane >> 4;
    const int nt = K / BK;
    unsigned voffA[2], voffB[2];
#pragma unroll
    for (int i = 0; i < 2; ++i) { int R, C; stage_rc(tid * 16 + i * 8192, R, C); const int Rb = Epi::PERM ? ((R & ~31) + perm32(R & 31)) : R;
        voffA[i] = (unsigned)(R * K + C) * 2u; voffB[i] = (unsigned)(Rb * K + C) * 2u; }
    const size_t kstep = (size_t)(BK * 2);
    const size_t hstep = (size_t)HALF * K * 2;
    const unsigned ldsw = (unsigned)wid * 1024u;
    const int aoff = lds_byte(wr * 64 + fr, fq * 8), boff = lds_byte(wc * 32 + fr, fq * 8);
#define PG8_SA(b, h) (((b) * 2 + (h)) * HTB)
#define PG8_SB(b, h) ((4 + (b) * 2 + (h)) * HTB)
#define PG8_STAGE(bufoff, gbase, voff) do { _Pragma("unroll") for (int _i = 0; _i < 2; ++_i) \
        __builtin_amdgcn_global_load_lds((const unsigned*)((const char*)(gbase) + (voff)[_i]), (LAS unsigned*)(lds + (bufoff) + ldsw + _i * 8192), 16, 0, 0); } while (0)
#define PG8_LDA(dst, b, h) do { _Pragma("unroll") for (int m = 0; m < 4; ++m) _Pragma("unroll") for (int k = 0; k < 2; ++k) dst[m][k] = *(const LAS bf16x8*)(lds + PG8_SA(b, h) + aoff + m * 2048 + k * 1024); } while (0)
#define PG8_LDB(dst, b, h) do { _Pragma("unroll") for (int n = 0; n < 2; ++n) _Pragma("unroll") for (int k = 0; k < 2; ++k) dst[n][k] = *(const LAS bf16x8*)(lds + PG8_SB(b, h) + boff + n * 2048 + k * 1024); } while (0)
#define PG8_MMA(ai, bj, At, Bt) do { __builtin_amdgcn_s_setprio(1); _Pragma("unroll") for (int m = 0; m < 4; ++m) _Pragma("unroll") for (int n = 0; n < 2; ++n) _Pragma("unroll") for (int k = 0; k < 2; ++k) \
        acc[ai][bj][m][n] = __builtin_amdgcn_mfma_f32_16x16x32_bf16(Bt[n][k], At[m][k], acc[ai][bj][m][n], 0, 0, 0); __builtin_amdgcn_s_setprio(0); } while (0)
#define PG8_WAIT_V(n) asm volatile("s_waitcnt vmcnt(" #n ")" ::: "memory")
#define PG8_WAIT_L(n) asm volatile("s_waitcnt lgkmcnt(" #n ")" ::: "memory")
#define PG8_BAR __builtin_amdgcn_s_barrier()
#define PG8_SCHED __builtin_amdgcn_sched_barrier(0)
    Unit cur, nxt; int ui = 0;
    if (!S.next(0, cur)) return;
    f32x4 acc[2][2][4][2];
#pragma unroll
    for (int a = 0; a < 2; ++a)
#pragma unroll
        for (int b = 0; b < 2; ++b)
#pragma unroll
            for (int m = 0; m < 4; ++m)
#pragma unroll
                for (int n = 0; n < 2; ++n) acc[a][b][m][n] = (f32x4){0.f, 0.f, 0.f, 0.f};
    bf16x8 At[4][2], B0[2][2], B1[2][2];
    const char* cA = uptr(cur.A); const char* cB = uptr(cur.B);
    PG8_STAGE(PG8_SB(0, 0), cB, voffB); PG8_STAGE(PG8_SB(0, 1), cB + hstep, voffB); PG8_STAGE(PG8_SA(0, 0), cA, voffA); PG8_STAGE(PG8_SA(0, 1), cA + hstep, voffA);
    if (wr == 1) PG8_BAR;
    PG8_WAIT_V(2); PG8_BAR;
    PG8_STAGE(PG8_SB(1, 0), cB + kstep, voffB); PG8_STAGE(PG8_SA(1, 0), cA + kstep, voffA); PG8_STAGE(PG8_SB(1, 1), cB + hstep + kstep, voffB);
    PG8_WAIT_V(6); PG8_BAR;
    for (;;) {
        const bool has_next = S.next(ui + 1, nxt);
        const char* nA = uptr(has_next ? nxt.A : cA); const char* nB = uptr(has_next ? nxt.B : cB);
        for (int t = 0; t < nt; t += 2) {
            const bool last = (t == nt - 2);
            const char* a1 = cA + (size_t)(t + 1) * kstep;
            const char* a2 = last ? nA : cA + (size_t)(t + 2) * kstep; const char* b2 = last ? nB : cB + (size_t)(t + 2) * kstep;
            const char* a3 = a2 + kstep; const char* b3 = b2 + kstep;
            PG8_LDB(B0, 0, 0); PG8_LDB(B1, 0, 1); PG8_SCHED; PG8_LDA(At, 0, 0); PG8_STAGE(PG8_SA(1, 1), a1 + hstep, voffA);
            PG8_WAIT_V(8); PG8_WAIT_L(0); PG8_BAR; PG8_MMA(0, 0, At, B0); PG8_MMA(0, 1, At, B1); PG8_BAR; PG8_SCHED;
            PG8_LDA(At, 0, 1); PG8_STAGE(PG8_SB(0, 0), b2, voffB); PG8_STAGE(PG8_SB(0, 1), b2 + hstep, voffB); PG8_STAGE(PG8_SA(0, 0), a2, voffA);
            PG8_WAIT_V(8); PG8_WAIT_L(0); PG8_BAR; PG8_MMA(1, 0, At, B0); PG8_MMA(1, 1, At, B1); PG8_BAR; PG8_SCHED;
            PG8_LDB(B0, 1, 0); PG8_LDB(B1, 1, 1); PG8_SCHED; PG8_LDA(At, 1, 0); PG8_STAGE(PG8_SA(0, 1), a2 + hstep, voffA);
            PG8_WAIT_V(8); PG8_WAIT_L(0); PG8_BAR; PG8_MMA(0, 0, At, B0); PG8_MMA(0, 1, At, B1); PG8_BAR; PG8_SCHED;
            PG8_LDA(At, 1, 1); PG8_STAGE(PG8_SB(1, 0), b3, voffB); PG8_STAGE(PG8_SB(1, 1), b3 + hstep, voffB); PG8_STAGE(PG8_SA(1, 0), a3, voffA);
            PG8_WAIT_V(8); PG8_WAIT_L(0); PG8_BAR; PG8_MMA(1, 0, At, B0); PG8_MMA(1, 1, At, B1); PG8_BAR; PG8_SCHED;
        }
        if (wr == 0) PG8_BAR;
        if (Epi::HAS_CHAIN && cur.chain) { E.chain(acc, cur, wr, wc, fr, fq); }
        else {
            E(acc, cur, wr, wc, fr, fq);
#pragma unroll
            for (int a = 0; a < 2; ++a)
#pragma unroll
                for (int b = 0; b < 2; ++b)
#pragma unroll
                    for (int m = 0; m < 4; ++m)
#pragma unroll
                        for (int n = 0; n < 2; ++n) acc[a][b][m][n] = (f32x4){0.f, 0.f, 0.f, 0.f};
        }
        if (!has_next) break;
        cur = nxt; cA = nA; cB = nB; ++ui;
        if (wr == 1) PG8_BAR;
    }
    PG8_WAIT_V(0);
    PG8_BAR;
#undef PG8_SA
#undef PG8_SB
#undef PG8_STAGE
#undef PG8_LDA
#undef PG8_LDB
#undef PG8_MMA
#undef PG8_WAIT_V
#undef PG8_WAIT_L
#undef PG8_BAR
#undef PG8_SCHED
}
}

#define XB_TMO      128
#define XB_XCNT(j)  (256  + 64 * (j))
#define XB_XSUB(j)  (1280 + 64 * (j))
#define XB_XGEN(j)  (2304 + 64 * (j))
#define XB_TOP      3328
#define XB_TOPGEN   3392
#define XCD_BAR_WORDS 3456
#define XB_SPIN_CAP (1u << 22)
__device__ __forceinline__ unsigned xb_ld(unsigned* p)              { return __hip_atomic_load(p, __ATOMIC_RELAXED, __HIP_MEMORY_SCOPE_AGENT); }
__device__ __forceinline__ unsigned xb_add(unsigned* p, unsigned v) { return __hip_atomic_fetch_add(p, v, __ATOMIC_RELAXED, __HIP_MEMORY_SCOPE_AGENT); }
__device__ __forceinline__ unsigned xb_xcc_id() { return (unsigned)__builtin_amdgcn_s_getreg((3 << 11) | 20) & 0xFu; }
#define XB_SPIN(cond, bar) do { unsigned _sp = 0; while (cond) { __builtin_amdgcn_s_sleep(1); \
    if ((++_sp & 255u) == 0u) { if (xb_ld(&(bar)[XB_TMO])) break; if (_sp > XB_SPIN_CAP) { atomicAdd(&(bar)[XB_TMO], 1u); break; } } } } while (0)
struct XcdBarrier { unsigned* bar; unsigned x; volatile LAS unsigned* st; };
__device__ __forceinline__ XcdBarrier xcd_barrier_post(unsigned* bar, volatile LAS unsigned* st) {
    XcdBarrier b; b.bar = bar; b.x = xb_xcc_id(); b.st = st;
    if (threadIdx.x == 0) (void)xb_add(&bar[XB_XCNT(b.x)], 1u);
    return b;
}
__device__ __forceinline__ void xcd_barrier_complete(unsigned* bar, unsigned x, unsigned& nloc, unsigned& nx) {
    const unsigned G = gridDim.x * gridDim.y * gridDim.z;
    unsigned sum, cnt, mine, sp = 0u;
    for (;;) {
        sum = 0u; cnt = 0u; mine = 0u;
#pragma unroll
        for (unsigned j = 0; j < 16; ++j) { const unsigned c = xb_ld(&bar[XB_XCNT(j)]); sum += c; cnt += (c > 0u) ? 1u : 0u; mine = (j == x) ? c : mine; }
        if (sum == G) break;
        __builtin_amdgcn_s_sleep(1);
        if ((++sp & 255u) == 0u) { if (xb_ld(&bar[XB_TMO])) break; if (sp > XB_SPIN_CAP) { atomicAdd(&bar[XB_TMO], 1u); break; } }
    }
    nloc = mine > 0u ? mine : 1u; nx = cnt > 0u ? cnt : 1u;
}
__device__ __forceinline__ void xcd_barrier(const XcdBarrier& b) {
    asm volatile("s_waitcnt vmcnt(0)" ::: "memory");
    __syncthreads();
    if (threadIdx.x == 0) {
        unsigned* bar = b.bar;
        __builtin_amdgcn_s_waitcnt(0);
        unsigned nloc = b.st[0], nx = b.st[1];
        if (nloc == 0u) { xcd_barrier_complete(bar, b.x, nloc, nx); b.st[0] = nloc; b.st[1] = nx; }
        const unsigned old = xb_add(&bar[XB_XSUB(b.x)], 1u);
        const unsigned gen = old / nloc;
        if (old + 1u == (gen + 1u) * nloc) {
            __builtin_amdgcn_fence(__ATOMIC_RELEASE, "agent");
            asm volatile("s_waitcnt vmcnt(0)" ::: "memory");
            const unsigned og = xb_add(&bar[XB_TOP], 1u);
            const unsigned tg = og / nx;
            if (og + 1u == (tg + 1u) * nx) xb_add(&bar[XB_TOPGEN], 1u);
            else XB_SPIN(xb_ld(&bar[XB_TOPGEN]) == tg, bar);
            __builtin_amdgcn_fence(__ATOMIC_ACQUIRE, "agent");
            xb_add(&bar[XB_XGEN(b.x)], 1u);
            asm volatile("s_waitcnt vmcnt(0)" ::: "memory");
        } else {
            XB_SPIN(xb_ld(&bar[XB_XGEN(b.x)]) == gen, bar);
            __builtin_amdgcn_fence(__ATOMIC_ACQUIRE, "agent");
            asm volatile("s_waitcnt vmcnt(0)" ::: "memory");
        }
    }
    __syncthreads();
}

struct Frame {
    LAS unsigned char* lds;
    int tid, lane, wave, G, bid;
    const float* in[28];
    float* out; unsigned char* ws;
    __device__ __forceinline__ const float* xrow(int m) const { return m < NCTX ? in[0] + (size_t)m * DM : in[1] + (size_t)(m - NCTX) * DM; }
};
__device__ __forceinline__ int cond_of(int m) { return m < NCTX ? 0 : 1 + ((m - NCTX) >> 10); }

__device__ __forceinline__ void p0_transpose_item(const float* W, int N, int K, bf16_t* WT, int k0, int n0, int drow0, LAS float* scr, int lane) {
#pragma unroll 8
    for (int i = 0; i < 32; ++i) { const int kk = 2 * i + (lane >> 5); scr[kk * 33 + (lane & 31)] = W[(size_t)(k0 + kk) * N + n0 + (lane & 31)]; }
    asm volatile("s_waitcnt lgkmcnt(0)" ::: "memory");
    const int c = lane & 7;
#pragma unroll
    for (int j = 0; j < 4; ++j) { const int n = (lane >> 3) + 8 * j; const LAS float* s = scr + (8 * c) * 33 + n;
        u32x4 o; o.x = cvtpk(s[0 * 33], s[1 * 33]); o.y = cvtpk(s[2 * 33], s[3 * 33]); o.z = cvtpk(s[4 * 33], s[5 * 33]); o.w = cvtpk(s[6 * 33], s[7 * 33]);
        *(u32x4*)(WT + (size_t)(drow0 + n) * K + k0 + 8 * c) = o; }
    asm volatile("s_waitcnt lgkmcnt(0)" ::: "memory");
}
__device__ __forceinline__ void p0_prologue(Frame& F) {
    {
        LAS float* sc = (LAS float*)(F.lds);
        LAS float* red = (LAS float*)(F.lds + 12288);
        for (int i = F.tid; i < 3072; i += NTHR) { const int c = i >> 10, k = i & 1023; const float v = c == 0 ? F.in[7][k] : F.in[2][(c - 1) * 1024 + k]; sc[i] = siluf_(v); }
        __syncthreads();
        const float* wada = F.in[8]; const float* bada = F.in[9]; float* ada = (float*)(F.ws + WS_ADA);
        for (int cb = F.bid; cb < 256; cb += F.G) {
            if (F.tid < 384) {
                const int cq = F.tid % 6, kg = F.tid / 6;
                f32x4 a0 = {0.f, 0.f, 0.f, 0.f}, a1 = a0, a2 = a0;
#pragma unroll 4
                for (int kk = 0; kk < 16; ++kk) { const int k = 16 * kg + kk; const f32x4 w = *(const f32x4*)(wada + (size_t)k * 6144 + 24 * cb + 4 * cq);
                    a0 += w * sc[k]; a1 += w * sc[1024 + k]; a2 += w * sc[2048 + k]; }
#pragma unroll
                for (int e = 0; e < 4; ++e) { red[(0 * 64 + kg) * 24 + 4 * cq + e] = a0[e]; red[(1 * 64 + kg) * 24 + 4 * cq + e] = a1[e]; red[(2 * 64 + kg) * 24 + 4 * cq + e] = a2[e]; }
            }
            __syncthreads();
            if (F.tid < 72) { const int c = F.tid / 24, col = F.tid % 24; float s = 0.f;
                for (int kg = 0; kg < 64; ++kg) s += red[(c * 64 + kg) * 24 + col];
                ada[c * 6144 + 24 * cb + col] = s + bada[24 * cb + col]; }
            __syncthreads();
        }
    }
    LAS float* scr = (LAS float*)(F.lds + F.wave * 16384);
    const int gw = F.bid * NWAVES + F.wave, NGW = F.G * NWAVES;
    constexpr int I_IN = 16 * 161, I_GO = 8 * 32, I_NO = 8 * 32, I_OUT = 16 * 32, I_UP = 16 * 176, I_DN = 44 * 32;
    constexpr int NITEMS = I_IN + I_GO + I_NO + I_OUT + I_UP + I_DN;
    for (int it = gw; it < NITEMS; it += NGW) {
        int r = it;
        if (r < I_IN) { const int kb = r / 161, nb = r % 161;
            if (nb == 48) p0_transpose_item(F.in[11], DIN, 1024, (bf16_t*)(F.ws + WS_WZT), 64 * kb, 32 * nb, 0, scr, F.lane);
            else p0_transpose_item(F.in[11], DIN, 1024, (bf16_t*)(F.ws + WS_WIN), 64 * kb, 32 * nb, 32 * nb - (nb > 48 ? 32 : 0), scr, F.lane);
            continue; } r -= I_IN;
        if (r < I_GO) { p0_transpose_item(F.in[20], 1024, 512, (bf16_t*)(F.ws + WS_WGO), 64 * (r / 32), 32 * (r % 32), 32 * (r % 32), scr, F.lane); continue; } r -= I_GO;
        if (r < I_NO) { p0_transpose_item(F.in[21], 1024, 512, (bf16_t*)(F.ws + WS_WNO), 64 * (r / 32), 32 * (r % 32), 32 * (r % 32), scr, F.lane); continue; } r -= I_NO;
        if (r < I_OUT) { p0_transpose_item(F.in[22], 1024, 1024, (bf16_t*)(F.ws + WS_WOUT), 64 * (r / 32), 32 * (r % 32), 32 * (r % 32), scr, F.lane); continue; } r -= I_OUT;
        if (r < I_UP) { p0_transpose_item(F.in[24], NUP, 1024, (bf16_t*)(F.ws + WS_WUP), 64 * (r / 176), 32 * (r % 176), 32 * (r % 176), scr, F.lane); continue; } r -= I_UP;
        p0_transpose_item(F.in[27], 1024, DFF, (bf16_t*)(F.ws + WS_WDN), 64 * (r / 32), 32 * (r % 32), 32 * (r % 32), scr, F.lane);
    }
}

template <bool FROM_OUT>
__device__ __forceinline__ void norm_rows(Frame& F, const float* g, int off_sh, int off_sc) {
    const int gw = F.bid * NWAVES + F.wave, NGW = F.G * NWAVES;
    const float* ada = (const float*)(F.ws + WS_ADA);
    bf16_t* H = (bf16_t*)(F.ws + WS_H);
    for (int mb = gw; mb < MTOK; mb += 3 * NGW) {
        f32x4 v[3][4];
#pragma unroll
        for (int r = 0; r < 3; ++r) { const int m = mb + r * NGW; if (m < MTOK) { const float* xr = FROM_OUT ? F.out + (size_t)m * DM : F.xrow(m);
#pragma unroll
            for (int j = 0; j < 4; ++j) v[r][j] = *(const f32x4*)(xr + 4 * F.lane + 256 * j); } }
#pragma unroll
        for (int r = 0; r < 3; ++r) { const int m = mb + r * NGW; if (m >= MTOK) break;
            const float* ad = ada + cond_of(m) * 6144;
            f32x4 gg[4], sc[4], sh[4];
#pragma unroll
            for (int j = 0; j < 4; ++j) { const int c = 4 * F.lane + 256 * j; gg[j] = *(const f32x4*)(g + c); sc[j] = *(const f32x4*)(ad + off_sc + c); sh[j] = *(const f32x4*)(ad + off_sh + c); }
            float s = 0.f;
#pragma unroll
            for (int j = 0; j < 4; ++j) s += (v[r][j].x * v[r][j].x + v[r][j].y * v[r][j].y) + (v[r][j].z * v[r][j].z + v[r][j].w * v[r][j].w);
            const float rinv = rsqrtf(wave_sum(s) * (1.f / DM) + EPS);
#pragma unroll
            for (int j = 0; j < 4; ++j) { const int c = 4 * F.lane + 256 * j;
                const f32x4 o = v[r][j] * rinv * gg[j] * (sc[j] + 1.f) + sh[j];
                u32x2 w; w.x = cvtpk(o[0], o[1]); w.y = cvtpk(o[2], o[3]);
                *(u32x2*)(H + (size_t)m * DM + c) = w; } }
    }
}

__device__ __forceinline__ void z_item(Frame& F, int j) {
    const bf16_t* H = (const bf16_t*)(F.ws + WS_H); const bf16_t* WzT = (const bf16_t*)(F.ws + WS_WZT); float* Z = (float*)(F.ws + WS_Z);
    const int r = F.lane & 31, hh = F.lane >> 5, row0 = 256 * j + 32 * F.wave;
    const bf16_t* ap = H + (size_t)(row0 + r) * DM + 8 * hh; const bf16_t* bp = WzT + (size_t)r * DM + 8 * hh;
    f32x16 acc = {};
#pragma unroll 8
    for (int ks = 0; ks < 64; ++ks) { const bf16x8 a = *(const bf16x8*)(ap + 16 * ks), b = *(const bf16x8*)(bp + 16 * ks); acc = __builtin_amdgcn_mfma_f32_32x32x16_bf16(a, b, acc, 0, 0, 0); }
#pragma unroll
    for (int i = 0; i < 16; ++i) Z[(size_t)(row0 + crow(i, hh)) * 32 + r] = acc[i];
}

__device__ __forceinline__ void kvout_rows(Frame& F, int m0, int nrows) {
    const bf16_t* U = (const bf16_t*)(F.ws + WS_U);
    const float* gk = F.in[18];
    for (int i = F.wave; i < nrows; i += NWAVES) {
        const int m = m0 + i;
        float k[8], v[8];
        unpack8(*(const u32x4*)(U + (size_t)m * NU + UNK + 8 * F.lane), k);
        unpack8(*(const u32x4*)(U + (size_t)m * NU + UNV + 8 * F.lane), v);
        float s = 0.f;
#pragma unroll
        for (int e = 0; e < 8; ++e) s += k[e] * k[e];
        s += __shfl_xor(s, 1); s += __shfl_xor(s, 2); s += __shfl_xor(s, 4);
        const float rinv = rsqrtf(s * (1.f / 64.f) + EPS);
        const int d0 = (8 * F.lane) & 63;
        f32x4 o0, o1;
#pragma unroll
        for (int e = 0; e < 4; ++e) { o0[e] = k[e] * rinv * gk[d0 + e]; o1[e] = k[4 + e] * rinv * gk[d0 + 4 + e]; }
        float* ok = F.out + O_NK + (size_t)m * 512 + 8 * F.lane; float* ov = F.out + O_NV + (size_t)m * 512 + 8 * F.lane;
        *(f32x4*)ok = o0; *(f32x4*)(ok + 4) = o1;
        *(f32x4*)ov = (f32x4){v[0], v[1], v[2], v[3]}; *(f32x4*)(ov + 4) = (f32x4){v[4], v[5], v[6], v[7]};
    }
}


__device__ __forceinline__ float logsigf_(float x) { return fminf(x, 0.f) - __logf(1.f + __expf(-fabsf(x))); }
constexpr int VLS = 160;
constexpr int STS = 72;

__device__ __forceinline__ void gla_stage_v(Frame& F, const bf16_t* U, int m0, int h, LAS bf16_t* VL) {
#pragma unroll
    for (int i = 0; i < 2; ++i) { const int p = F.tid + i * NTHR, row = p >> 4, c16 = p & 15;
        const u32x4 v = *(const u32x4*)(U + (size_t)(m0 + row) * NU + UV + 128 * h + 8 * c16);
        *(LAS u32x4*)(VL + row * VLS + 8 * c16) = v; }
}

__device__ __forceinline__ void gla_pass1_item(Frame& F, int item) {
    const bf16_t* U = (const bf16_t*)(F.ws + WS_U); const float* Z = (const float*)(F.ws + WS_Z);
    bf16_t* QK = (bf16_t*)(F.ws + WS_QK) + (size_t)item * 4 * 4096; float* KV = (float*)(F.ws + WS_KV) + (size_t)item * 2 * 8192; float* DEC = (float*)(F.ws + WS_DEC) + (size_t)item * 128;
    const int gc = item >> 2, h = item & 3, m0 = gc * 64, tid = F.tid;
    LAS float* ZL = (LAS float*)(F.lds);
    LAS float* WA = (LAS float*)(F.lds + 8192);
    LAS float* BA = (LAS float*)(F.lds + 16384);
    LAS float* LA = (LAS float*)(F.lds + 16896);
    LAS bf16_t* KP = (LAS bf16_t*)(F.lds + 49664);
    LAS bf16_t* VL = (LAS bf16_t*)(F.lds + 66048);
    { const int t = tid >> 3, c4 = tid & 7; *(LAS f32x4*)(ZL + t * 32 + 4 * c4) = *(const f32x4*)(Z + (size_t)(m0 + t) * 32 + 4 * c4); }
    { const int dir = tid >> 8, j = (tid & 255) >> 4, d4 = tid & 15; const float* w = dir ? F.in[14] : F.in[12];
      *(LAS f32x4*)(WA + (dir * 16 + j) * 64 + 4 * d4) = *(const f32x4*)(w + j * 256 + 64 * h + 4 * d4); }
    if (tid < 128) { const int dir = tid >> 6, d = tid & 63; BA[tid] = (dir ? F.in[15] : F.in[13])[64 * h + d]; }
    gla_stage_v(F, U, m0, h, VL);
    __syncthreads();
    { const int t = tid >> 3, d0 = (tid & 7) * 8;
#pragma unroll
      for (int dir = 0; dir < 2; ++dir) { float a[8];
#pragma unroll
        for (int e = 0; e < 8; ++e) a[e] = BA[dir * 64 + d0 + e];
#pragma unroll
        for (int j = 0; j < 16; ++j) { const float z = ZL[t * 32 + 16 * dir + j];
#pragma unroll
            for (int e = 0; e < 8; ++e) a[e] += z * WA[(dir * 16 + j) * 64 + d0 + e]; }
#pragma unroll
        for (int e = 0; e < 8; ++e) LA[(dir * 64 + t) * 64 + d0 + e] = logsigf_(a[e]) * (1.f / 16.f); } }
    __syncthreads();
    if (tid < 128) { const int dir = tid >> 6, d = tid & 63; float run = 0.f;
        if (dir == 0) { for (int t = 0; t < 64; ++t) { run += LA[t * 64 + d]; LA[t * 64 + d] = run; } }
        else { for (int t = 63; t >= 0; --t) { run += LA[(64 + t) * 64 + d]; LA[(64 + t) * 64 + d] = run; } } }
    __syncthreads();
    { const int t = tid >> 3, d0 = (tid & 7) * 8; float q[8], k[8];
      unpack8(*(const u32x4*)(U + (size_t)(m0 + t) * NU + UQ + 64 * h + d0), q); unpack8(*(const u32x4*)(U + (size_t)(m0 + t) * NU + UK + 64 * h + d0), k);
#pragma unroll
      for (int dir = 0; dir < 2; ++dir) { float qt[8], kt[8], kp[8];
#pragma unroll
        for (int e = 0; e < 8; ++e) { const float c = LA[(dir * 64 + t) * 64 + d0 + e], last = LA[(dir * 64 + (dir ? 0 : 63)) * 64 + d0 + e];
            qt[e] = q[e] * 0.125f * __expf(c); kt[e] = k[e] * __expf(-c); kp[e] = k[e] * __expf(last - c);
            if (t == 0) DEC[dir * 64 + d0 + e] = __expf(last); }
        *(u32x4*)(QK + (size_t)(2 * dir) * 4096 + t * 64 + d0) = pack8(qt); *(u32x4*)(QK + (size_t)(2 * dir + 1) * 4096 + t * 64 + d0) = pack8(kt);
        *(LAS u32x4*)(KP + (dir * 64 + t) * 64 + d0) = pack8(kp); } }
    __syncthreads();
    { const int l = F.lane, hh = l >> 5, g1 = (l >> 4) & 1, qq = (l & 15) >> 2, pp = l & 3, dvt = F.wave & 3, dt = F.wave >> 2;
#pragma unroll
      for (int dir = 0; dir < 2; ++dir) { f32x16 acc = {};
#pragma unroll
        for (int ks = 0; ks < 4; ++ks) { const int r0 = 16 * ks + 8 * hh + qq;
            const LAS bf16_t* va = VL + r0 * VLS + 32 * dvt + 16 * g1 + 4 * pp; const LAS bf16_t* kb = KP + (dir * 64 + r0) * 64 + 32 * dt + 16 * g1 + 4 * pp;
            const bf16x8 a = cat8(vtr(va), vtr(va + 4 * VLS)), b = cat8(vtr(kb), vtr(kb + 4 * 64));
            acc = __builtin_amdgcn_mfma_f32_32x32x16_bf16(a, b, acc, 0, 0, 0); }
#pragma unroll
        for (int r = 0; r < 16; ++r) KV[(size_t)dir * 8192 + (32 * dvt + crow(r, hh)) * 64 + 32 * dt + (l & 31)] = acc[r]; } }
    __syncthreads();
}

__device__ __forceinline__ void gla_pass2_item(Frame& F, int item) {
    const bf16_t* U = (const bf16_t*)(F.ws + WS_U); bf16_t* OG = (bf16_t*)(F.ws + WS_OG);
    const bf16_t* QKb = (const bf16_t*)(F.ws + WS_QK); const float* KVb = (const float*)(F.ws + WS_KV); const float* DECb = (const float*)(F.ws + WS_DEC);
    const int gc = item >> 2, h = item & 3, m0 = gc * 64, tid = F.tid;
    const bool ctx = gc < 64; const int n = ctx ? (gc & 3) : ((gc - 64) & 15), N = ctx ? 4 : 16, seq = ctx ? (gc >> 2) : 16 + ((gc - 64) >> 4);
    LAS bf16_t* ST = (LAS bf16_t*)(F.lds);
    LAS bf16_t* VL = (LAS bf16_t*)(F.lds + 36864);
    LAS float* SS = (LAS float*)(F.lds + 57344);
#pragma unroll
    for (int dir = 0; dir < 2; ++dir) {
        const float* s0 = (dir ? F.in[6] : F.in[5]) + (size_t)((ctx ? 0 : seq - 16) * 4 + h) * 8192;
        float* so = F.out + (dir ? O_SB : O_SF) + (size_t)(seq * 4 + h) * 8192;
        const int nprev = dir ? (N - 1 - n) : n;
        const bool fin = ctx && (dir ? n == 0 : n == N - 1);
#pragma unroll 1
        for (int j = 0; j < 4; ++j) { const int e4 = tid + NTHR * j, dv = e4 >> 4, d = (e4 & 15) * 4;
            f32x4 S = {0.f, 0.f, 0.f, 0.f};
            if (!ctx) {
#pragma unroll
                for (int e = 0; e < 4; ++e) S[e] = s0[(size_t)(d + e) * 128 + dv]; }
            for (int m0_ = 0; m0_ < nprev; m0_ += 8) {
                f32x4 dcb[8], kvb[8];
#pragma unroll
                for (int u = 0; u < 8; ++u) { const int mm = m0_ + u; if (mm < nprev) { const int it = (dir ? (gc + nprev - mm) : (gc - nprev + mm)) * 4 + h;
                    dcb[u] = *(const f32x4*)(DECb + (size_t)it * 128 + dir * 64 + d); kvb[u] = *(const f32x4*)(KVb + (size_t)it * 16384 + dir * 8192 + dv * 64 + d); } }
#pragma unroll
                for (int u = 0; u < 8; ++u) if (m0_ + u < nprev) S = dcb[u] * S + kvb[u];
            }
            u32x2 w; w.x = cvtpk(S[0], S[1]); w.y = cvtpk(S[2], S[3]);
            *(LAS u32x2*)(ST + (dir * 128 + dv) * STS + d) = w;
            if (fin) { const f32x4 dc = *(const f32x4*)(DECb + (size_t)item * 128 + dir * 64 + d), kv = *(const f32x4*)(KVb + (size_t)item * 16384 + dir * 8192 + dv * 64 + d);
                const f32x4 Sf = dc * S + kv;
#pragma unroll
                for (int e = 0; e < 4; ++e) so[(size_t)(d + e) * 128 + dv] = Sf[e]; } } }
    gla_stage_v(F, U, m0, h, VL);
    __syncthreads();
    const int l = F.lane, hh = l >> 5, c31 = l & 31, g1 = (l >> 4) & 1, qq = (l & 15) >> 2, pp = l & 3, dvt = F.wave & 3, tt = F.wave >> 2;
    f32x16 o = {};
#pragma unroll
    for (int dir = 0; dir < 2; ++dir) {
        const bf16_t* Qg = QKb + ((size_t)item * 4 + 2 * dir) * 4096; const bf16_t* Kg = Qg + 4096;
        bf16x8 qf[4];
#pragma unroll
        for (int ks = 0; ks < 4; ++ks) qf[ks] = *(const bf16x8*)(Qg + (32 * tt + c31) * 64 + 16 * ks + 8 * hh);
#pragma unroll
        for (int st = 0; st < 2; ++st) {
            if (dir == 0 ? st > tt : st < tt) continue;
            f32x16 p = {};
#pragma unroll
            for (int ks = 0; ks < 4; ++ks) { const bf16x8 kf = *(const bf16x8*)(Kg + (32 * st + c31) * 64 + 16 * ks + 8 * hh); p = __builtin_amdgcn_mfma_f32_32x32x16_bf16(kf, qf[ks], p, 0, 0, 0); }
            if (st == tt) {
#pragma unroll
                for (int r = 0; r < 16; ++r) { const int s = crow(r, hh); const bool keep = dir == 0 ? s <= c31 : s >= c31; p[r] = keep ? p[r] : 0.f; } }
#pragma unroll
            for (int s2 = 0; s2 < 2; ++s2) {
                u32x4 pw; pw.x = cvtpk(p[8 * s2 + 0], p[8 * s2 + 1]); pw.y = cvtpk(p[8 * s2 + 2], p[8 * s2 + 3]); pw.z = cvtpk(p[8 * s2 + 4], p[8 * s2 + 5]); pw.w = cvtpk(p[8 * s2 + 6], p[8 * s2 + 7]);
                const LAS bf16_t* va = VL + (32 * st + 16 * s2 + 4 * hh + qq) * VLS + 32 * dvt + 16 * g1 + 4 * pp;
                const bf16x8 a = cat8(vtr(va), vtr(va + 8 * VLS));
                o = __builtin_amdgcn_mfma_f32_32x32x16_bf16(a, __builtin_bit_cast(bf16x8, pw), o, 0, 0, 0); }
        }
#pragma unroll
        for (int ks = 0; ks < 4; ++ks) { const bf16x8 a = *(const LAS bf16x8*)(ST + (dir * 128 + 32 * dvt + c31) * STS + 16 * ks + 8 * hh); o = __builtin_amdgcn_mfma_f32_32x32x16_bf16(a, qf[ks], o, 0, 0, 0); }
    }
    { float ss = 0.f;
#pragma unroll
      for (int r = 0; r < 16; ++r) ss += o[r] * o[r];
      ss += __shfl_xor(ss, 32);
      if (hh == 0) SS[dvt * 64 + 32 * tt + c31] = ss; }
    __syncthreads();
    { const int t = 32 * tt + c31; const float tot = SS[t] + SS[64 + t] + SS[128 + t] + SS[192 + t]; const float rinv = rsqrtf(tot * (1.f / 128.f) + EPS);
      const float* gg = F.in[16]; const size_t m = (size_t)(m0 + t);
#pragma unroll
      for (int rg = 0; rg < 4; ++rg) { const int dv0 = 32 * dvt + 8 * rg + 4 * hh; const f32x4 g4 = *(const f32x4*)(gg + dv0);
          const u32x2 gr = *(const u32x2*)(U + m * NU + UR + 128 * h + dv0); const float r0 = bflo(gr.x), r1 = bfhi(gr.x), r2 = bflo(gr.y), r3 = bfhi(gr.y);
          u32x2 w; w.x = cvtpk(o[4 * rg + 0] * rinv * g4[0] * siluf_(r0), o[4 * rg + 1] * rinv * g4[1] * siluf_(r1)); w.y = cvtpk(o[4 * rg + 2] * rinv * g4[2] * siluf_(r2), o[4 * rg + 3] * rinv * g4[3] * siluf_(r3));
          *(u32x2*)(OG + m * 512 + 128 * h + dv0) = w; } }
    __syncthreads();
}

constexpr float QSC = 0.125f * LOG2E;
struct AttnLocal { const LAS float* rpb; int dr0; int qc0; };

template <bool FROMU, bool LOCAL>
__device__ __forceinline__ void attn_wave(Frame& F, const bf16_t* U, int qtok0, int h, int kbase, const float* ckeys, const LAS bf16_t* VLw, const AttnLocal& L, f32x16 (&o)[2], float& m_out, float& l_out) {
    const int l = F.lane, hh = l >> 5, c31 = l & 31, g1 = (l >> 4) & 1, qq = (l & 15) >> 2, pp = l & 3;
    const float* gq = F.in[17]; const float* gk = F.in[18];
    bf16x8 qf[4];
    { float f[4][8]; float ss = 0.f; const bf16_t* qp = U + (size_t)(qtok0 + c31) * NU + UNQ + 64 * h + 8 * hh;
#pragma unroll
      for (int ks = 0; ks < 4; ++ks) { unpack8(*(const u32x4*)(qp + 16 * ks), f[ks]);
#pragma unroll
          for (int e = 0; e < 8; ++e) ss += f[ks][e] * f[ks][e]; }
      ss += __shfl_xor(ss, 32);
      const float rinv = rsqrtf(ss * (1.f / 64.f) + EPS) * QSC;
#pragma unroll
      for (int ks = 0; ks < 4; ++ks) {
#pragma unroll
          for (int e = 0; e < 8; ++e) { const int d = 16 * ks + 8 * hh + e; f[ks][e] *= rinv * gq[d] * (FROMU ? gk[d] : 1.f); }
          qf[ks] = __builtin_bit_cast(bf16x8, pack8(f[ks])); } }
    float m_run = -1e30f, l_run = 0.f;
    o[0] = f32x16{}; o[1] = f32x16{};
    const bf16_t* kpu = U + (size_t)(kbase + c31) * NU + UNK + 64 * h + 8 * hh;
    const float* kpc = FROMU ? nullptr : ckeys + ((size_t)(kbase + c31) * 8 + h) * 64 + 8 * hh;
    u32x4 rawu[4]; f32x4 rawc[8];
    if (FROMU) {
#pragma unroll
        for (int ks = 0; ks < 4; ++ks) rawu[ks] = *(const u32x4*)(kpu + 16 * ks); }
    else {
#pragma unroll
        for (int ks = 0; ks < 4; ++ks) { rawc[2 * ks] = *(const f32x4*)(kpc + 16 * ks); rawc[2 * ks + 1] = *(const f32x4*)(kpc + 16 * ks + 4); } }
#pragma unroll 1
    for (int T = 0; T < 8; ++T) {
        bf16x8 kf[4];
        if (FROMU) { float f[4][8]; float ss = 0.f;
#pragma unroll
            for (int ks = 0; ks < 4; ++ks) { unpack8(rawu[ks], f[ks]);
#pragma unroll
                for (int e = 0; e < 8; ++e) ss += f[ks][e] * f[ks][e]; }
            if (T < 7) { const bf16_t* kn = kpu + (size_t)(32 * (T + 1)) * NU;
#pragma unroll
                for (int ks = 0; ks < 4; ++ks) rawu[ks] = *(const u32x4*)(kn + 16 * ks); }
            ss += __shfl_xor(ss, 32);
            const float rinv = rsqrtf(ss * (1.f / 64.f) + EPS);
#pragma unroll
            for (int ks = 0; ks < 4; ++ks) {
#pragma unroll
                for (int e = 0; e < 8; ++e) f[ks][e] *= rinv;
                kf[ks] = __builtin_bit_cast(bf16x8, pack8(f[ks])); } }
        else {
#pragma unroll
            for (int ks = 0; ks < 4; ++ks) { const f32x4 a = rawc[2 * ks], b = rawc[2 * ks + 1];
                u32x4 w; w.x = cvtpk(a[0], a[1]); w.y = cvtpk(a[2], a[3]); w.z = cvtpk(b[0], b[1]); w.w = cvtpk(b[2], b[3]); kf[ks] = __builtin_bit_cast(bf16x8, w); }
            if (T < 7) { const float* kn = kpc + (size_t)(32 * (T + 1)) * 512;
#pragma unroll
                for (int ks = 0; ks < 4; ++ks) { rawc[2 * ks] = *(const f32x4*)(kn + 16 * ks); rawc[2 * ks + 1] = *(const f32x4*)(kn + 16 * ks + 4); } } }
        f32x16 acc = {};
#pragma unroll
        for (int ks = 0; ks < 4; ++ks) acc = __builtin_amdgcn_mfma_f32_32x32x16_bf16(kf[ks], qf[ks], acc, 0, 0, 0);
        if (LOCAL) { const int c = L.qc0 + c31, cs = min(max(c - 8, 0), 48); const LAS float* rp = L.rpb + (L.dr0 + (T >> 1)) * 32;
#pragma unroll
            for (int r = 0; r < 16; ++r) { const int kc = 32 * (T & 1) + crow(r, hh); const bool inw = kc >= cs && kc < cs + 16; const int dc = min(max(kc - c + 15, 0), 31);
                acc[r] = inw ? acc[r] + rp[dc] : -INFINITY; } }
        float mx = acc[0];
#pragma unroll
        for (int r = 1; r < 16; ++r) mx = fmaxf(mx, acc[r]);
        mx = fmaxf(mx, __shfl_xor(mx, 32));
        const float mnew = fmaxf(m_run, mx), fsc = __builtin_amdgcn_exp2f(m_run - mnew);
        m_run = mnew; l_run *= fsc;
#pragma unroll
        for (int r = 0; r < 16; ++r) { o[0][r] *= fsc; o[1][r] *= fsc; }
#pragma unroll
        for (int r = 0; r < 16; ++r) { const float p = __builtin_amdgcn_exp2f(acc[r] - mnew); acc[r] = p; l_run += p; }
#pragma unroll
        for (int s2 = 0; s2 < 2; ++s2) {
            u32x4 pw; pw.x = cvtpk(acc[8 * s2 + 0], acc[8 * s2 + 1]); pw.y = cvtpk(acc[8 * s2 + 2], acc[8 * s2 + 3]); pw.z = cvtpk(acc[8 * s2 + 4], acc[8 * s2 + 5]); pw.w = cvtpk(acc[8 * s2 + 6], acc[8 * s2 + 7]);
            const bf16x8 pb = __builtin_bit_cast(bf16x8, pw);
#pragma unroll
            for (int dt = 0; dt < 2; ++dt) { const LAS bf16_t* va = VLw + (32 * T + 16 * s2 + 4 * hh + qq) * 64 + 32 * dt + 16 * g1 + 4 * pp;
                o[dt] = __builtin_amdgcn_mfma_f32_32x32x16_bf16(cat8(vtr(va), vtr(va + 8 * 64)), pb, o[dt], 0, 0, 0); } }
    }
    l_run += __shfl_xor(l_run, 32);
    const float mx = m_run, ls = l_run;
    m_out = mx; l_out = ls;
}

__device__ __forceinline__ void attn_ctx_unit(Frame& F, int unit) {
    const bf16_t* U = (const bf16_t*)(F.ws + WS_U); bf16_t* ON = (bf16_t*)(F.ws + WS_ON);
    const int b = unit >> 3, h = unit & 7, tok0 = b * 256;
    LAS bf16_t* VL = (LAS bf16_t*)(F.lds);
#pragma unroll
    for (int i = 0; i < 4; ++i) { const int p = F.tid + i * NTHR, row = p >> 3, c8 = p & 7;
        *(LAS u32x4*)(VL + row * 64 + 8 * c8) = *(const u32x4*)(U + (size_t)(tok0 + row) * NU + UNV + 64 * h + 8 * c8); }
    __syncthreads();
    f32x16 o[2]; float mx, ls; AttnLocal L{nullptr, 0, 0};
    attn_wave<true, false>(F, U, tok0 + 32 * F.wave, h, tok0, nullptr, VL, L, o, mx, ls);
    { const int hh = F.lane >> 5, c31 = F.lane & 31; const float inv = 1.f / ls; bf16_t* op = ON + (size_t)(tok0 + 32 * F.wave + c31) * 512 + 64 * h;
#pragma unroll
      for (int dt = 0; dt < 2; ++dt)
#pragma unroll
          for (int rg = 0; rg < 4; ++rg) { u32x2 w; w.x = cvtpk(o[dt][4 * rg] * inv, o[dt][4 * rg + 1] * inv); w.y = cvtpk(o[dt][4 * rg + 2] * inv, o[dt][4 * rg + 3] * inv);
              *(u32x2*)(op + 32 * dt + 8 * rg + 4 * hh) = w; } }
    __syncthreads();
}

__device__ __forceinline__ void attn_lat_unit(Frame& F, int unit) {
    const bf16_t* U = (const bf16_t*)(F.ws + WS_U); bf16_t* ON = (bf16_t*)(F.ws + WS_ON);
    const int r = unit & 15, h = (unit >> 4) & 7, bl = unit >> 7;
    const int rs = min(max(r - 4, 0), 8), ltok0 = NCTX + bl * 1024 + rs * 64, qrow0 = NCTX + bl * 1024 + r * 64;
    LAS bf16_t* VL = (LAS bf16_t*)(F.lds);
    LAS float* RPB = (LAS float*)(F.lds + 131072);
    LAS float* ML = (LAS float*)(F.lds + 133120);
    LAS float* PO = (LAS float*)(F.lds);
    const float* cv = F.in[4] + (size_t)bl * 512 * 512;
#pragma unroll
    for (int i = 0; i < 8; ++i) { const int p = F.tid + i * NTHR, row = p >> 3, c8 = p & 7;
        *(LAS u32x4*)(VL + row * 64 + 8 * c8) = *(const u32x4*)(U + (size_t)(ltok0 + row) * NU + UNV + 64 * h + 8 * c8); }
#pragma unroll
    for (int i = 0; i < 8; ++i) { const int p = F.tid + i * NTHR, row = p >> 3, c8 = p & 7; const float* vp = cv + ((size_t)row * 8 + h) * 64 + 8 * c8;
        const f32x4 a = *(const f32x4*)vp, b2 = *(const f32x4*)(vp + 4);
        u32x4 w; w.x = cvtpk(a[0], a[1]); w.y = cvtpk(a[2], a[3]); w.z = cvtpk(b2[0], b2[1]); w.w = cvtpk(b2[2], b2[3]);
        *(LAS u32x4*)(VL + (512 + row) * 64 + 8 * c8) = w; }
    if (F.tid < 480) { const int dr = F.tid >> 5, dc = F.tid & 31; RPB[F.tid] = dc < 31 ? F.in[19][(h * 15 + dr) * 31 + dc] * LOG2E : 0.f; }
    __syncthreads();
    const int qg = F.wave >> 2, kb = F.wave & 3;
    f32x16 o[2]; float mx, ls;
    if (kb < 2) { AttnLocal L{RPB, rs + 4 * kb - r + 7, 32 * qg}; attn_wave<true, true>(F, U, qrow0 + 32 * qg, h, ltok0 + 256 * kb, nullptr, VL + 256 * kb * 64, L, o, mx, ls); }
    else { AttnLocal L{nullptr, 0, 0}; attn_wave<false, false>(F, U, qrow0 + 32 * qg, h, bl * 512 + 256 * (kb - 2), F.in[3], VL + (512 + 256 * (kb - 2)) * 64, L, o, mx, ls); }
    __syncthreads();
    { const int hh = F.lane >> 5, c31 = F.lane & 31;
#pragma unroll
      for (int dt = 0; dt < 2; ++dt)
#pragma unroll
          for (int rr = 0; rr < 16; ++rr) PO[(F.wave * 64 + 32 * dt + crow(rr, hh)) * 32 + c31] = o[dt][rr];
      if (hh == 0) { ML[F.wave * 64 + c31] = mx; ML[F.wave * 64 + 32 + c31] = ls; } }
    __syncthreads();
    { const int q = F.tid & 31, dv8 = (F.tid >> 5) & 7, qg2 = F.tid >> 8;
      float M = -INFINITY;
#pragma unroll
      for (int w = 0; w < 4; ++w) M = fmaxf(M, ML[(4 * qg2 + w) * 64 + q]);
      float Ls = 0.f, acc[8];
#pragma unroll
      for (int e = 0; e < 8; ++e) acc[e] = 0.f;
#pragma unroll
      for (int w = 0; w < 4; ++w) { const int ww = 4 * qg2 + w; const float wt = __builtin_amdgcn_exp2f(ML[ww * 64 + q] - M); Ls += wt * ML[ww * 64 + 32 + q];
#pragma unroll
          for (int e = 0; e < 8; ++e) acc[e] += wt * PO[(ww * 64 + 8 * dv8 + e) * 32 + q]; }
      const float inv = 1.f / Ls;
#pragma unroll
      for (int e = 0; e < 8; ++e) acc[e] *= inv;
      *(u32x4*)(ON + (size_t)(qrow0 + 32 * qg2 + q) * 512 + 64 * h + 8 * dv8) = pack8(acc); }
    __syncthreads();
}

__device__ __forceinline__ void convgate_rows(Frame& F) {
    const bf16_t* U2 = (const bf16_t*)(F.ws + WS_U2); bf16_t* ACT = (bf16_t*)(F.ws + WS_ACT);
    const float* wc = F.in[25]; const float* bc = F.in[26];
    constexpr int NV8 = DFF / 8, RUN = 16, NRUN = MTOK / RUN;
    for (int idx = F.bid * NTHR + F.tid; idx < NV8 * NRUN; idx += F.G * NTHR) {
        const int cg = idx % NV8, run = idx / NV8, c = cg * 8, m0 = run * RUN;
        const int T = m0 < NCTX ? 256 : 1024, t0 = m0 < NCTX ? (m0 & 255) : ((m0 - NCTX) & 1023);
        float wa[3][8], wg[3][8], ba[8], bg[8];
#pragma unroll
        for (int j = 0; j < 3; ++j) { const f32x4 x0 = *(const f32x4*)(wc + j * NUP + c), x1 = *(const f32x4*)(wc + j * NUP + c + 4), y0 = *(const f32x4*)(wc + j * NUP + DFF + c), y1 = *(const f32x4*)(wc + j * NUP + DFF + c + 4);
#pragma unroll
            for (int e = 0; e < 4; ++e) { wa[j][e] = x0[e]; wa[j][4 + e] = x1[e]; wg[j][e] = y0[e]; wg[j][4 + e] = y1[e]; } }
        { const f32x4 x0 = *(const f32x4*)(bc + c), x1 = *(const f32x4*)(bc + c + 4), y0 = *(const f32x4*)(bc + DFF + c), y1 = *(const f32x4*)(bc + DFF + c + 4);
#pragma unroll
          for (int e = 0; e < 4; ++e) { ba[e] = x0[e]; ba[4 + e] = x1[e]; bg[e] = y0[e]; bg[4 + e] = y1[e]; } }
        const bf16_t* up = U2 + (size_t)m0 * NUP + c;
        float pa[8], pg[8], ca[8], cg_[8], na[8], ng[8];
        if (t0 > 0) { unpack8(*(const u32x4*)(up - NUP), pa); unpack8(*(const u32x4*)(up - NUP + DFF), pg); }
        else {
#pragma unroll
            for (int e = 0; e < 8; ++e) { pa[e] = 0.f; pg[e] = 0.f; } }
        unpack8(*(const u32x4*)up, ca); unpack8(*(const u32x4*)(up + DFF), cg_);
#pragma unroll 4
        for (int i = 0; i < RUN; ++i) {
            if (t0 + i + 1 < T) { unpack8(*(const u32x4*)(up + (size_t)(i + 1) * NUP), na); unpack8(*(const u32x4*)(up + (size_t)(i + 1) * NUP + DFF), ng); }
            else {
#pragma unroll
                for (int e = 0; e < 8; ++e) { na[e] = 0.f; ng[e] = 0.f; } }
            float o[8];
#pragma unroll
            for (int e = 0; e < 8; ++e) { const float a = ba[e] + wa[0][e] * pa[e] + wa[1][e] * ca[e] + wa[2][e] * na[e], g = bg[e] + wg[0][e] * pg[e] + wg[1][e] * cg_[e] + wg[2][e] * ng[e];
                o[e] = a * siluf_(g); pa[e] = ca[e]; pg[e] = cg_[e]; ca[e] = na[e]; cg_[e] = ng[e]; }
            *(u32x4*)(ACT + (size_t)(m0 + i) * DFF + c) = pack8(o);
        }
    }
}

namespace nv {
__device__ __forceinline__ float bf(const bf16_t* p) { return __uint_as_float((unsigned)(*p) << 16); }
__device__ __forceinline__ bf16_t tobf(float f) { return (bf16_t)(cvtpk(f, 0.f) & 0xffffu); }
__device__ __forceinline__ float logsig(float x) { return fminf(x, 0.f) - log1pf(expf(-fabsf(x))); }

__global__ void ada_k(const float* c_ctx, const float* c, const float* w, const float* b, float* ada) {
    const int idx = blockIdx.x * blockDim.x + threadIdx.x; if (idx >= 3 * 6144) return;
    const int cn = idx / 6144, j = idx % 6144; const float* cond = cn == 0 ? c_ctx : c + (cn - 1) * 1024;
    float s = b[j];
    for (int k = 0; k < 1024; ++k) { const float v = cond[k]; s += (v / (1.f + expf(-v))) * w[(size_t)k * 6144 + j]; }
    ada[idx] = s;
}
__global__ void norm_k(const float* x0, const float* x1, const float* g, const float* ada, int off_sh, int off_sc, bf16_t* H) {
    __shared__ float red[256];
    const int m = blockIdx.x; const float* xr = m < NCTX ? x0 + (size_t)m * DM : x1 + (size_t)(m - NCTX) * DM;
    float s = 0.f; for (int k = threadIdx.x; k < DM; k += 256) s += xr[k] * xr[k];
    red[threadIdx.x] = s; __syncthreads();
    for (int o = 128; o > 0; o >>= 1) { if (threadIdx.x < o) red[threadIdx.x] += red[threadIdx.x + o]; __syncthreads(); }
    const float rinv = rsqrtf(red[0] / DM + EPS); const float* ad = ada + cond_of(m) * 6144;
    for (int k = threadIdx.x; k < DM; k += 256) H[(size_t)m * DM + k] = tobf(xr[k] * rinv * g[k] * (1.f + ad[off_sc + k]) + ad[off_sh + k]);
}
struct GArgs { const bf16_t* A; const float* W; int K, ldw, M, N; };
template <class F> __global__ void gemm_k(GArgs g, F f) {
    const size_t idx = (size_t)blockIdx.x * blockDim.x + threadIdx.x; if (idx >= (size_t)g.M * g.N) return;
    const int m = (int)(idx / g.N), n = (int)(idx % g.N);
    float s = 0.f; const bf16_t* a = g.A + (size_t)m * g.K;
    for (int k = 0; k < g.K; ++k) s += bf(a + k) * g.W[(size_t)k * g.ldw + n];
    f(m, n, s);
}
struct StIn { bf16_t* U; float* Z; __device__ void operator()(int m, int n, float s) const { if (n >= 1536 && n < 1568) Z[(size_t)m * 32 + n - 1536] = s; else U[(size_t)m * NU + n - (n >= 1568 ? 32 : 0)] = tobf(s); } };
struct StBf { bf16_t* O; int ld, pad; __device__ void operator()(int m, int n, float s) const { O[(size_t)m * ld + n] = tobf(s); } };
struct StF32 { float* O; int ld, pad; __device__ void operator()(int m, int n, float s) const { O[(size_t)m * ld + n] = s; } };
struct StRes { const float* b0; const float* b1; float* out; const float* gate; __device__ void operator()(int m, int n, float s) const {
    const float base = m < NCTX ? b0[(size_t)m * DM + n] : b1[(size_t)(m - NCTX) * DM + n]; out[(size_t)m * DM + n] = base + gate[cond_of(m) * 6144 + n] * s; } };

__global__ void kvout_k(const bf16_t* U, const float* gk, float* out) {
    const int idx = blockIdx.x * blockDim.x + threadIdx.x; if (idx >= NCTX * 8) return;
    const int m = idx / 8, h = idx % 8; const bf16_t* k = U + (size_t)m * NU + UNK + 64 * h; const bf16_t* v = U + (size_t)m * NU + UNV + 64 * h;
    float s = 0.f; for (int d = 0; d < 64; ++d) s += bf(k + d) * bf(k + d);
    const float rinv = rsqrtf(s / 64.f + EPS);
    for (int d = 0; d < 64; ++d) { out[O_NK + (size_t)m * 512 + 64 * h + d] = bf(k + d) * rinv * gk[d]; out[O_NV + (size_t)m * 512 + 64 * h + d] = bf(v + d); }
}
__global__ void decay_k(const float* Z, const float* waf, const float* baf, const float* wab, const float* bab, float* Adec) {
    const int idx = blockIdx.x * blockDim.x + threadIdx.x; if (idx >= 2 * MTOK * 256) return;
    const int dir = idx / (MTOK * 256), m = (idx / 256) % MTOK, c = idx % 256; const float* w = dir ? wab : waf; const float* b = dir ? bab : baf;
    float s = b[c]; for (int j = 0; j < 16; ++j) s += Z[(size_t)m * 32 + 16 * dir + j] * w[j * 256 + c];
    Adec[idx] = expf(logsig(s) / 16.f);
}
__global__ void __launch_bounds__(256) gla_k(const bf16_t* U, const float* Adec, const float* s0f, const float* s0b, float* OT, float* out) {
    const int idx = blockIdx.x * blockDim.x + threadIdx.x; if (idx >= 18 * 4 * 2 * 128) return;
    const int dv = idx % 128, dir = (idx / 128) % 2, h = (idx / 256) % 4, seq = idx / 1024;
    const int T = seq < 16 ? 256 : 1024, base = seq < 16 ? seq * 256 : NCTX + (seq - 16) * 1024;
    float S[64];
    if (seq < 16) { for (int d = 0; d < 64; ++d) S[d] = 0.f; }
    else { const float* s0 = (dir ? s0b : s0f) + ((size_t)((seq - 16) * 4 + h) * 64) * 128; for (int d = 0; d < 64; ++d) S[d] = s0[d * 128 + dv]; }
    for (int st = 0; st < T; ++st) {
        const int m = base + (dir ? T - 1 - st : st);
        const bf16_t* u = U + (size_t)m * NU; const float v = bf(u + UV + 128 * h + dv); const float* a = Adec + ((size_t)dir * MTOK + m) * 256 + 64 * h;
        float o = 0.f;
#pragma unroll
        for (int d = 0; d < 64; ++d) { S[d] = a[d] * S[d] + bf(u + UK + 64 * h + d) * v; o += bf(u + UQ + 64 * h + d) * 0.125f * S[d]; }
        OT[((size_t)dir * MTOK + m) * 512 + 128 * h + dv] = o;
    }
    if (seq < 16) { float* os = out + (dir ? O_SB : O_SF) + ((size_t)(seq * 4 + h) * 64) * 128; for (int d = 0; d < 64; ++d) os[d * 128 + dv] = S[d]; }
}
__global__ void glanorm_k(const float* OT, const bf16_t* U, const float* gg, bf16_t* OG) {
    const int idx = blockIdx.x * blockDim.x + threadIdx.x; if (idx >= MTOK * 4) return;
    const int m = idx / 4, h = idx % 4; const float* a = OT + (size_t)m * 512 + 128 * h; const float* b = OT + ((size_t)MTOK + m) * 512 + 128 * h;
    float s = 0.f; for (int d = 0; d < 128; ++d) { const float o = a[d] + b[d]; s += o * o; }
    const float rinv = rsqrtf(s / 128.f + EPS);
    for (int d = 0; d < 128; ++d) { const float r = bf(U + (size_t)m * NU + UR + 128 * h + d); OG[(size_t)m * 512 + 128 * h + d] = tobf((a[d] + b[d]) * rinv * gg[d] * (r / (1.f + expf(-r)))); }
}
__global__ void __launch_bounds__(256) attn_k(const bf16_t* U, const float* gq, const float* gk, const float* ck, const float* cv, const float* rpb, bf16_t* ON) {
    const int idx = blockIdx.x * blockDim.x + threadIdx.x; if (idx >= MTOK * 16) return;
    const int m = idx / 16, h = (idx % 16) / 2, part = idx % 2;
    float q[64]; { float s = 0.f; const bf16_t* qp = U + (size_t)m * NU + UNQ + 64 * h;
#pragma unroll
        for (int d = 0; d < 64; ++d) { q[d] = bf(qp + d); s += q[d] * q[d]; }
        const float rinv = rsqrtf(s / 64.f + EPS);
#pragma unroll
        for (int d = 0; d < 64; ++d) q[d] *= rinv * gq[d] * 0.125f; }
    float mx = -INFINITY, l = 0.f, o[32];
#pragma unroll
    for (int d = 0; d < 32; ++d) o[d] = 0.f;
#define NV_STEP(sc, VEXPR) do { const float sc_ = (sc); const float mn_ = fmaxf(mx, sc_), f_ = expf(mx - mn_), p_ = expf(sc_ - mn_); l = l * f_ + p_; \
        _Pragma("unroll") for (int d = 0; d < 32; ++d) o[d] = o[d] * f_ + p_ * (VEXPR); mx = mn_; } while (0)
#define NV_UKEY(tok, bias) do { const bf16_t* kp = U + (size_t)(tok) * NU + UNK + 64 * h; const bf16_t* vp = U + (size_t)(tok) * NU + UNV + 64 * h + 32 * part; \
        float s_ = 0.f, dt_ = 0.f; _Pragma("unroll") for (int d = 0; d < 64; ++d) { const float k = bf(kp + d); s_ += k * k; dt_ += q[d] * k * gk[d]; } \
        NV_STEP(dt_ * rsqrtf(s_ / 64.f + EPS) + (bias), bf(vp + d)); } while (0)
    if (m < NCTX) { const int b0 = (m / 256) * 256; for (int j = 0; j < 256; ++j) NV_UKEY(b0 + j, 0.f); }
    else {
        const int bl = (m - NCTX) / 1024, t = (m - NCTX) % 1024, r = t / 64, c = t % 64;
        const int rs = min(max(r - 4, 0), 8), cs = min(max(c - 8, 0), 48);
        for (int i = 0; i < 8; ++i) for (int kc = cs; kc < cs + 16; ++kc) { const int kr = rs + i; const int dc = min(max(kc - c, -15), 15) + 15;
            NV_UKEY(NCTX + bl * 1024 + kr * 64 + kc, rpb[(h * 15 + (kr - r + 7)) * 31 + dc]); }
        for (int lk = 0; lk < 512; ++lk) { const float* kp = ck + ((size_t)(bl * 512 + lk) * 8 + h) * 64; const float* vp = cv + ((size_t)(bl * 512 + lk) * 8 + h) * 64 + 32 * part;
            float dt = 0.f;
#pragma unroll
            for (int d = 0; d < 64; ++d) dt += q[d] * kp[d];
            NV_STEP(dt, vp[d]); }
    }
#pragma unroll
    for (int d = 0; d < 32; ++d) ON[(size_t)m * 512 + 64 * h + 32 * part + d] = tobf(o[d] / l);
#undef NV_STEP
#undef NV_UKEY
}
__global__ void mix_k(const float* BG, const float* BN, const bf16_t* U, bf16_t* MIX) {
    const size_t idx = (size_t)blockIdx.x * blockDim.x + threadIdx.x; if (idx >= (size_t)MTOK * DM) return;
    const int m = (int)(idx / DM), n = (int)(idx % DM); const float mg = bf(U + (size_t)m * NU + UMG + n), mn = bf(U + (size_t)m * NU + UMN + n);
    MIX[idx] = tobf(BG[idx] / (1.f + expf(-mg)) + BN[idx] / (1.f + expf(-mn)));
}
__global__ void convgate_k(const bf16_t* U2, const float* wc, const float* bc, bf16_t* ACT) {
    const size_t idx = (size_t)blockIdx.x * blockDim.x + threadIdx.x; if (idx >= (size_t)MTOK * DFF) return;
    const int m = (int)(idx / DFF), c = (int)(idx % DFF);
    const int T = m < NCTX ? 256 : 1024, t = m < NCTX ? m % 256 : (m - NCTX) % 1024;
    float a = bc[c], g = bc[DFF + c];
    for (int j = 0; j < 3; ++j) { const int tt = t + j - 1; if (tt < 0 || tt >= T) continue; const bf16_t* u = U2 + (size_t)(m + j - 1) * NUP; a += wc[j * NUP + c] * bf(u + c); g += wc[j * NUP + DFF + c] * bf(u + DFF + c); }
    ACT[idx] = tobf(a * (g / (1.f + expf(-g))));
}
}

struct Args { const float* in[28]; float* out; unsigned char* ws; int ph_lo, ph_hi; };

__global__ void __launch_bounds__(NTHR, 2) fwd_kernel(Args args) {
    extern __shared__ __attribute__((aligned(16))) unsigned char lds_raw[];
    Frame F;
    F.lds = (LAS unsigned char*)lds_raw;
    F.tid = threadIdx.x; F.lane = F.tid & 63; F.wave = __builtin_amdgcn_readfirstlane(F.tid >> 6);
    F.G = gridDim.x; F.bid = blockIdx.x;
#pragma unroll
    for (int i = 0; i < 28; ++i) F.in[i] = args.in[i];
    F.out = args.out; F.ws = args.ws;
    const int lo = args.ph_lo, hi = args.ph_hi;
    const bool multi = (hi - lo) > 1;
    volatile LAS unsigned* MISC = (volatile LAS unsigned*)(F.lds + MISC_OFF);
    if (F.tid < 16) MISC[F.tid] = 0u;
    __syncthreads();
    XcdBarrier bar; bar.bar = (unsigned*)(F.ws + WS_CTL) + 4096; bar.x = 0; bar.st = MISC + 8;
    if (multi) bar = xcd_barrier_post((unsigned*)(F.ws + WS_CTL) + 4096, MISC + 8);
#define IN(k) (lo <= (k) && (k) < hi)
#define REP(k) for (int rep_ = 0; rep_ < (((REP_MASK) >> (k)) & 1u ? 2 : 1); ++rep_)
#define GRID_BAR() do { if (multi) xcd_barrier(bar); } while (0)

    REP(0) if (IN(0)) { p0_prologue(F); GRID_BAR(); }
    REP(1) if (IN(1)) { norm_rows<false>(F, F.in[10], 0, 1024); GRID_BAR(); }
    REP(2) if (IN(2)) {
        pg8::StaticOrder S; S.init(F.ws + WS_H, F.ws + WS_WIN, MTOK, NU, DM, F.G, F.bid);
        pg8::EpiBf16 E{(bf16_t*)(F.ws + WS_U), NU};
        pg8::gemm_phase(F.lds, DM, S, E);
        for (int j = F.G - 1 - F.bid; j < 24; j += F.G) z_item(F, j);
        GRID_BAR();
    }
    REP(6) {
    if (IN(6)) { for (int u = F.bid; u < 384; u += F.G) { if (u < 256) attn_lat_unit(F, u); else attn_ctx_unit(F, u - 256); } }
    if (IN(4)) { for (int it = F.bid; it < 384; it += F.G) gla_pass1_item(F, it); }
    if (IN(3)) { for (int c = F.bid; c < 256; c += F.G) kvout_rows(F, 16 * c, 16); }
    if (IN(3) || IN(4) || IN(6)) GRID_BAR();
    }
    REP(5) if (IN(5)) {
        if (F.G == 256) { if (F.bid < 128) gla_pass2_item(F, 256 + F.bid); else { gla_pass2_item(F, F.bid - 128); gla_pass2_item(F, F.bid); } }
        else for (int it = F.bid; it < 384; it += F.G) gla_pass2_item(F, it);
        GRID_BAR();
    }
    REP(7) if (IN(7)) {
        pg8::PairOrder S; S.init(F.ws + WS_OG, F.ws + WS_WGO, F.ws + WS_ON, F.ws + WS_WNO, MTOK, DM, 512, F.G, F.bid);
        pg8::EpiGate E{(const bf16_t*)(F.ws + WS_U), (float*)(F.ws + WS_BG), (bf16_t*)(F.ws + WS_MIX)};
        pg8::gemm_phase(F.lds, 512, S, E);
        GRID_BAR();
    }
    REP(8) if (IN(8)) {
        pg8::StaticOrder S; S.init(F.ws + WS_MIX, F.ws + WS_WOUT, MTOK, DM, DM, F.G, F.bid);
        pg8::EpiResid E{F.in[0], F.in[1], F.out, (const float*)(F.ws + WS_ADA) + 2048};
        pg8::gemm_phase(F.lds, DM, S, E);
        GRID_BAR();
    }
    REP(9) if (IN(9)) { norm_rows<true>(F, F.in[23], 3072, 4096); GRID_BAR(); }
    REP(10) if (IN(10)) {
        pg8::StaticOrder S; S.init(F.ws + WS_H, F.ws + WS_WUP, MTOK, NUP, DM, F.G, F.bid);
        pg8::EpiBf16 E{(bf16_t*)(F.ws + WS_U2), NUP};
        pg8::gemm_phase(F.lds, DM, S, E);
        GRID_BAR();
    }
    REP(11) if (IN(11)) { convgate_rows(F); GRID_BAR(); }
    if (IN(12)) {
        pg8::StaticOrder S; S.init(F.ws + WS_ACT, F.ws + WS_WDN, MTOK, DM, DFF, F.G, F.bid);
        pg8::EpiResid E{F.out, F.out + (size_t)NCTX * DM, F.out, (const float*)(F.ws + WS_ADA) + 5120};
        pg8::gemm_phase(F.lds, DFF, S, E);
    }
#undef IN
}

#ifndef FUSED_MASK
#define FUSED_MASK 0xFFFu
#endif
constexpr unsigned FUSED = FUSED_MASK;
constexpr size_t WS_ADEC = 168 * MiB, WS_OT = 181 * MiB, WS_BN = 72 * MiB;

extern "C" void kernel_launch(void* const* d_in, const int* in_sizes, int n_in, void* d_out, int out_size, void* d_ws, size_t ws_size, hipStream_t stream) {
    static int grid = 0;
    if (grid == 0) {
        if (n_in != 28 || ws_size < WS_END) { fprintf(stderr, "kernel_launch: unexpected n_in %d / ws %zu\n", n_in, ws_size); grid = -1; return; }
        int dev = 0, cus = 0, per_cu = 0;
        (void)hipGetDevice(&dev);
        (void)hipDeviceGetAttribute(&cus, hipDeviceAttributeMultiprocessorCount, dev);
        (void)hipFuncSetAttribute((const void*)fwd_kernel, hipFuncAttributeMaxDynamicSharedMemorySize, LDS_BYTES);
        (void)hipOccupancyMaxActiveBlocksPerMultiprocessor(&per_cu, (const void*)fwd_kernel, NTHR, LDS_BYTES);
        (void)hipGetLastError();
        if (per_cu < 1) { fprintf(stderr, "kernel_launch: occupancy query reports 0 workgroups per CU\n"); grid = -1; return; }
        grid = cus;
        if (grid > 256) grid = 256;
    }
    if (grid < 0) return;
    (void)hipMemsetAsync((char*)d_ws + WS_CTL, 0, CTL_BYTES, stream);
    Args a{};
    for (int i = 0; i < 28; ++i) a.in[i] = (const float*)d_in[i];
    a.out = (float*)d_out; a.ws = (unsigned char*)d_ws;
    const float* const* in = (const float* const*)d_in;
    unsigned char* ws = (unsigned char*)d_ws; float* out = (float*)d_out;
    bf16_t *H = (bf16_t*)(ws + WS_H), *U = (bf16_t*)(ws + WS_U), *OG = (bf16_t*)(ws + WS_OG), *ON = (bf16_t*)(ws + WS_ON), *MIX = (bf16_t*)(ws + WS_MIX), *U2 = (bf16_t*)(ws + WS_U2), *ACT = (bf16_t*)(ws + WS_ACT);
    float *ADA = (float*)(ws + WS_ADA), *Z = (float*)(ws + WS_Z), *ADEC = (float*)(ws + WS_ADEC), *OT = (float*)(ws + WS_OT), *BG = (float*)(ws + WS_BG), *BN = (float*)(ws + WS_BN);
    if (ONE_LAUNCH) {
        a.ph_lo = 0; a.ph_hi = 13;
        void* kargs[] = {&a};
        hipError_t e = hipLaunchCooperativeKernel((const void*)fwd_kernel, dim3(grid), dim3(NTHR), kargs, LDS_BYTES, stream);
        if (e != hipSuccess) fprintf(stderr, "kernel_launch: cooperative launch failed: %s (grid %d)\n", hipGetErrorString(e), grid);
        return;
    }
    auto fused = [&](int p) { a.ph_lo = p; a.ph_hi = p + 1; for (int r_ = 0; r_ < (p == HOST_REP ? 2 : 1); ++r_) hipLaunchKernelGGL(fwd_kernel, dim3(grid), dim3(NTHR), LDS_BYTES, stream, a); };
    auto nb = [](size_t n) { return dim3((unsigned)((n + 255) / 256)); };
    if (FUSED & 1u) fused(0);
    else { if (FUSED) fused(0); hipLaunchKernelGGL(nv::ada_k, nb(3 * 6144), dim3(256), 0, stream, in[7], in[2], in[8], in[9], ADA); }
    if (FUSED & 2u) fused(1); else hipLaunchKernelGGL(nv::norm_k, dim3(MTOK), dim3(256), 0, stream, in[0], in[1], in[10], (const float*)ADA, 0, 1024, H);
    if (FUSED & 4u) fused(2); else hipLaunchKernelGGL(nv::gemm_k<nv::StIn>, nb((size_t)MTOK * DIN), dim3(256), 0, stream, nv::GArgs{H, in[11], 1024, DIN, MTOK, DIN}, nv::StIn{U, Z});
    if (FUSED & 8u) fused(3); else hipLaunchKernelGGL(nv::kvout_k, nb(NCTX * 8), dim3(256), 0, stream, (const bf16_t*)U, in[18], out);
    if (FUSED & 0x10u) { fused(4); fused(5); }
    else {
    hipLaunchKernelGGL(nv::decay_k, nb((size_t)2 * MTOK * 256), dim3(256), 0, stream, (const float*)Z, in[12], in[13], in[14], in[15], ADEC);
    hipLaunchKernelGGL(nv::gla_k, nb(18 * 4 * 2 * 128), dim3(256), 0, stream, (const bf16_t*)U, (const float*)ADEC, in[5], in[6], OT, out);
    hipLaunchKernelGGL(nv::glanorm_k, nb(MTOK * 4), dim3(256), 0, stream, (const float*)OT, (const bf16_t*)U, in[16], OG);
    }
    if (FUSED & 0x20u) fused(6); else
    hipLaunchKernelGGL(nv::attn_k, nb(MTOK * 16), dim3(256), 0, stream, (const bf16_t*)U, in[17], in[18], in[3], in[4], in[19], ON);
    if (FUSED & 0x40u) fused(7); else {
    hipLaunchKernelGGL(nv::gemm_k<nv::StF32>, nb((size_t)MTOK * DM), dim3(256), 0, stream, nv::GArgs{OG, in[20], 512, DM, MTOK, DM}, nv::StF32{BG, DM, 0});
    hipLaunchKernelGGL(nv::gemm_k<nv::StF32>, nb((size_t)MTOK * DM), dim3(256), 0, stream, nv::GArgs{ON, in[21], 512, DM, MTOK, DM}, nv::StF32{BN, DM, 0});
    hipLaunchKernelGGL(nv::mix_k, nb((size_t)MTOK * DM), dim3(256), 0, stream, (const float*)BG, (const float*)BN, (const bf16_t*)U, MIX);
    }
    if (FUSED & 0x80u) fused(8); else
    hipLaunchKernelGGL(nv::gemm_k<nv::StRes>, nb((size_t)MTOK * DM), dim3(256), 0, stream, nv::GArgs{MIX, in[22], DM, DM, MTOK, DM}, nv::StRes{in[0], in[1], out, ADA + 2048});
    if (FUSED & 0x100u) fused(9); else
    hipLaunchKernelGGL(nv::norm_k, dim3(MTOK), dim3(256), 0, stream, (const float*)out, (const float*)(out + (size_t)NCTX * DM), in[23], (const float*)ADA, 3072, 4096, H);
    if (FUSED & 0x200u) fused(10); else
    hipLaunchKernelGGL(nv::gemm_k<nv::StBf>, nb((size_t)MTOK * NUP), dim3(256), 0, stream, nv::GArgs{H, in[24], DM, NUP, MTOK, NUP}, nv::StBf{U2, NUP, 0});
    if (FUSED & 0x400u) fused(11); else
    hipLaunchKernelGGL(nv::convgate_k, nb((size_t)MTOK * DFF), dim3(256), 0, stream, (const bf16_t*)U2, in[25], in[26], ACT);
    if (FUSED & 0x800u) fused(12); else
    hipLaunchKernelGGL(nv::gemm_k<nv::StRes>, nb((size_t)MTOK * DM), dim3(256), 0, stream, nv::GArgs{ACT, in[27], DFF, DM, MTOK, DM}, nv::StRes{(const float*)out, (const float*)(out + (size_t)NCTX * DM), out, ADA + 5120});
}
```

```cpp
#include <hip/hip_runtime.h>
#include <cstdio>
#include <cstdint>

#ifndef PROBE_IDX
#define PROBE_IDX 0
#endif
#ifndef PROBE_A
#define PROBE_A 0
#endif
#ifndef PROBE_B
#define PROBE_B 0
#endif
#ifndef PROBE_BLOCK
#define PROBE_BLOCK 0
#endif
#ifndef PROBE_SPLIT
#define PROBE_SPLIT 0
#endif
#ifndef HOST_REP
#define HOST_REP -1
#endif
#ifndef REP_MASK
#define REP_MASK 0u
#endif
#ifndef ONE_LAUNCH
#define ONE_LAUNCH 1
#endif

#define LAS __attribute__((address_space(3)))
#define GAS __attribute__((address_space(1)))
typedef unsigned short bf16_t;
typedef short bf16x8 __attribute__((ext_vector_type(8)));
typedef short s16x4 __attribute__((ext_vector_type(4)));
typedef float f32x2 __attribute__((ext_vector_type(2)));
typedef float f32x4 __attribute__((ext_vector_type(4)));
typedef float f32x16 __attribute__((ext_vector_type(16)));
typedef unsigned u32x2 __attribute__((ext_vector_type(2)));
typedef unsigned u32x4 __attribute__((ext_vector_type(4)));
typedef __bf16 bf16x2_t __attribute__((ext_vector_type(2)));

constexpr int DM = 1024, NCTX = 4096, NLAT = 2048, MTOK = 6144, DIN = 5152, NU = 5120, DFF = 2816, NUP = 5632;
constexpr int UQ = 0, UK = 256, UV = 512, UR = 1024, UNQ = 1536, UNK = 2048, UNV = 2560, UMG = 3072, UMN = 4096;
constexpr float EPS = 1e-6f;
constexpr float LOG2E = 1.4426950408889634f;
constexpr size_t O_YP = 0, O_YS = 4194304, O_NK = 6291456, O_NV = 8388608, O_SF = 10485760, O_SB = 11010048;
constexpr size_t MiB = 1u << 20;
constexpr size_t WS_CTL = 0, CTL_BYTES = 1 * MiB;
constexpr size_t WS_ADA = 1 * MiB;
constexpr size_t WS_WGO = 2 * MiB;
constexpr size_t WS_WIN = 3 * MiB;
constexpr size_t WS_WZT = 13 * MiB;
constexpr size_t WS_WNO = 14 * MiB;
constexpr size_t WS_WOUT = 15 * MiB;
constexpr size_t WS_WUP = 17 * MiB;
constexpr size_t WS_WDN = 28 * MiB;
constexpr size_t WS_H = 34 * MiB;
constexpr size_t WS_Z = 46 * MiB;
constexpr size_t WS_OG = 47 * MiB;
constexpr size_t WS_ON = 53 * MiB;
constexpr size_t WS_DEC = 59 * MiB;
constexpr size_t WS_QK = 60 * MiB;
constexpr size_t WS_KV = 72 * MiB;
constexpr size_t WS_SS = 84 * MiB;
constexpr size_t WS_MIX = 96 * MiB;
constexpr size_t WS_U = 108 * MiB;
constexpr size_t WS_U2 = 168 * MiB;
constexpr size_t WS_ACT = 108 * MiB;
constexpr size_t WS_PART0 = 205 * MiB, WS_PART1 = 181 * MiB;
constexpr size_t WS_MIXN = 72 * MiB;
constexpr size_t WS_BG = 205 * MiB;
constexpr size_t WS_GATE = 229 * MiB;
constexpr size_t WS_END = 253 * MiB;

constexpr int NWAVES = 8, NTHR = 512;
constexpr int LDS_BYTES = 147456;
constexpr int RING_BYTES = 131072;
constexpr int MISC_OFF = RING_BYTES + 12288;

__device__ __forceinline__ unsigned cvtpk(float lo, float hi) { f32x2 v = {lo, hi}; bf16x2_t b = __builtin_convertvector(v, bf16x2_t); return __builtin_bit_cast(unsigned, b); }
__device__ __forceinline__ float bflo(unsigned u) { return __uint_as_float(u << 16); }
__device__ __forceinline__ float bfhi(unsigned u) { return __uint_as_float(u & 0xffff0000u); }
__device__ __forceinline__ float wave_sum(float v) {
#pragma unroll
    for (int o = 1; o < 64; o <<= 1) v += __shfl_xor(v, o);
    return v;
}
__device__ __forceinline__ float sigmoidf_(float x) { return __builtin_amdgcn_rcpf(1.f + __builtin_amdgcn_exp2f(-LOG2E * x)); }
__device__ __forceinline__ float siluf_(float x) { return x * __builtin_amdgcn_rcpf(1.f + __builtin_amdgcn_exp2f(-LOG2E * x)); }
__device__ __forceinline__ int crow(int r, int hi) { return (r & 3) + 8 * (r >> 2) + 4 * hi; }
__device__ __forceinline__ s16x4 vtr(const LAS void* p) { typedef short v4i16_t __attribute__((ext_vector_type(4))); return __builtin_bit_cast(s16x4, __builtin_amdgcn_ds_read_tr16_b64_v4i16((LAS v4i16_t*)p)); }
__device__ __forceinline__ bf16x8 cat8(s16x4 lo, s16x4 hi) { return (bf16x8){lo[0], lo[1], lo[2], lo[3], hi[0], hi[1], hi[2], hi[3]}; }
__device__ __forceinline__ void unpack8(u32x4 v, float (&f)[8]) { f[0] = bflo(v.x); f[1] = bfhi(v.x); f[2] = bflo(v.y); f[3] = bfhi(v.y); f[4] = bflo(v.z); f[5] = bfhi(v.z); f[6] = bflo(v.w); f[7] = bfhi(v.w); }
__device__ __forceinline__ u32x4 pack8(const float (&f)[8]) { u32x4 v; v.x = cvtpk(f[0], f[1]); v.y = cvtpk(f[2], f[3]); v.z = cvtpk(f[4], f[5]); v.w = cvtpk(f[6], f[7]); return v; }

namespace pg8 {
constexpr int BM = 256, BK = 64, HALF = 128, HTB = HALF * BK * 2, STAGE_BYTES = 8 * HTB, NXCD = 8, WGM = 8;
__host__ __device__ __forceinline__ int lds_byte(int r, int c) { const int st = (r >> 4) * 2 + (c >> 5), rr = r & 15, cc = c & 31, ob = rr * 64 + cc * 2; return st * 1024 + (ob ^ (((ob >> 9) & 1) << 5)); }
__host__ __device__ __forceinline__ void stage_rc(int b, int& R, int& C) { const int st = b / 1024, sb = b % 1024, swz = sb ^ (((sb >> 9) & 1) << 5); R = (st >> 1) * 16 + swz / 64; C = (st & 1) * 32 + (swz % 64) / 2; }
__host__ __device__ __forceinline__ int perm32(int rho) { const int n = rho >> 4, i = rho & 15; return 8 * (i >> 2) + 4 * n + (i & 3); }

struct Unit { int pm, pn; const char* A; const char* B; int aux; };
__device__ __forceinline__ const char* uptr(const char* p) { const unsigned long long v = (unsigned long long)p; const unsigned lo = __builtin_amdgcn_readfirstlane((unsigned)v), hi = __builtin_amdgcn_readfirstlane((unsigned)(v >> 32)); return (const char*)(((unsigned long long)hi << 32) | lo); }

struct StaticOrder {
    int nM, nN, nwg, G, c; const char* Ab; const char* Bb; size_t tstepA, tstepB;
    __device__ void init(const void* A, const void* Bt, int M, int N, int lda, int ldb, int G_, int c_) { nM = M / BM; nN = N / BM; nwg = nM * nN; G = G_; c = c_; Ab = (const char*)A; Bb = (const char*)Bt; tstepA = (size_t)BM * lda * 2; tstepB = (size_t)BM * ldb * 2; }
    __device__ bool next(int i, Unit& u) const {
        const long L = (long)i * G + c; if (L >= nwg) return false;
        int wgid = (int)L; { const int q = nwg / NXCD, r = nwg % NXCD, xcd = wgid % NXCD, off = wgid / NXCD; wgid = (xcd < r ? xcd * (q + 1) : r * (q + 1) + (xcd - r) * q) + off; }
        const int nig = WGM * nN, gid = wgid / nig, fm = gid * WGM, gsz = (nM - fm) < WGM ? (nM - fm) : WGM;
        u.pm = fm + ((wgid % nig) % gsz); u.pn = (wgid % nig) / gsz; u.A = Ab + (size_t)u.pm * tstepA; u.B = Bb + (size_t)u.pn * tstepB; u.aux = 0; return true;
    }
};
struct DualOrder {
    int nM, nN, nwg, G, c; const char *A0, *B0, *A1, *B1; size_t tstepA, tstepB;
    __device__ void init(const void* a0, const void* b0, const void* a1, const void* b1, int M, int N, int lda, int ldb, int G_, int c_) { nM = M / BM; nN = N / BM; nwg = nM * nN; G = G_; c = c_;
        A0 = (const char*)a0; B0 = (const char*)b0; A1 = (const char*)a1; B1 = (const char*)b1; tstepA = (size_t)BM * lda * 2; tstepB = (size_t)BM * ldb * 2; }
    __device__ bool next(int i, Unit& u) const {
        int t, aux;
        if (G == 256 && nM == 24 && nN == 4) {
            if (i > 0) return false;
            const int x = c & 7, j = c >> 3; if (j >= 24) return false;
            u.pm = 3 * x + (j >> 3); u.pn = (j & 7) >> 1; aux = j & 1;
        } else {
            const long L = (long)i * G + c; if (L >= 2 * nwg) return false;
            t = (int)(L >> 1); aux = (int)(L & 1); u.pm = t / nN; u.pn = t % nN;
        }
        u.aux = aux;
        u.A = (aux ? A1 : A0) + (size_t)u.pm * tstepA; u.B = (aux ? B1 : B0) + (size_t)u.pn * tstepB; return true;
    }
};

struct EpiBf16 {
    static constexpr bool PERM = true;
    bf16_t* O; int ldc;
    bf16_t* O1; bf16_t* G; int gate_pn0;
    float* Zo; int z_pn;
    __device__ __forceinline__ void operator()(const f32x4 (&acc)[2][2][4][2], const Unit& u, int wr, int wc, int fr, int fq) const {
        if (u.pn == z_pn) {
            if (wc == 0) { float* zp = Zo + (size_t)(u.pm * BM + wr * 64 + fr) * 32 + 8 * fq;
#pragma unroll
                for (int ai = 0; ai < 2; ++ai)
#pragma unroll
                    for (int m = 0; m < 4; ++m) { *(f32x4*)(zp + (ai * HALF + m * 16) * 32) = acc[ai][0][m][0]; *(f32x4*)(zp + (ai * HALF + m * 16) * 32 + 4) = acc[ai][0][m][1]; } }
            return;
        }
        if (u.pn >= gate_pn0) {
            bf16_t* gp = G + ((size_t)(u.pm * 8 + (u.pn - gate_pn0)) << 16) + ((wr * 4 + wc) * 64 + fq * 16 + fr) * 8;
#pragma unroll
            for (int ai = 0; ai < 2; ++ai)
#pragma unroll
                for (int m = 0; m < 4; ++m)
#pragma unroll
                    for (int bj = 0; bj < 2; ++bj) { const f32x4 v0 = acc[ai][bj][m][0], v1 = acc[ai][bj][m][1];
                        u32x4 w; w.x = cvtpk(sigmoidf_(v0[0]), sigmoidf_(v0[1])); w.y = cvtpk(sigmoidf_(v0[2]), sigmoidf_(v0[3])); w.z = cvtpk(sigmoidf_(v1[0]), sigmoidf_(v1[1])); w.w = cvtpk(sigmoidf_(v1[2]), sigmoidf_(v1[3]));
                        *(u32x4*)(gp + ((ai * 4 + m) * 2 + bj) * 4096) = w; }
            return;
        }
        bf16_t* Ob = u.aux ? O1 : O;
        const int row0 = u.pm * BM + wr * 64 + fr, col0 = u.pn * BM + wc * 32 + 8 * fq;
#pragma unroll
        for (int ai = 0; ai < 2; ++ai)
#pragma unroll
            for (int m = 0; m < 4; ++m) { bf16_t* rowp = Ob + (size_t)(row0 + ai * HALF + m * 16) * ldc + col0;
#pragma unroll
                for (int bj = 0; bj < 2; ++bj) { const f32x4 v0 = acc[ai][bj][m][0], v1 = acc[ai][bj][m][1];
                    u32x4 w; w.x = cvtpk(v0[0], v0[1]); w.y = cvtpk(v0[2], v0[3]); w.z = cvtpk(v1[0], v1[1]); w.w = cvtpk(v1[2], v1[3]);
                    *(u32x4*)(rowp + bj * HALF) = w; } }
    }
};
struct EpiPart {
    static constexpr bool PERM = false;
    float* P0; float* P1; int ldc;
    __device__ __forceinline__ void operator()(const f32x4 (&acc)[2][2][4][2], const Unit& u, int wr, int wc, int fr, int fq) const {
        float* P = u.aux ? P1 : P0; const int row0 = u.pm * BM + wr * 64 + fr, col0 = u.pn * BM + wc * 32 + 4 * fq;
#pragma unroll
        for (int ai = 0; ai < 2; ++ai)
#pragma unroll
            for (int m = 0; m < 4; ++m) { float* rowp = P + (size_t)(row0 + ai * HALF + m * 16) * ldc + col0;
#pragma unroll
                for (int bj = 0; bj < 2; ++bj)
#pragma unroll
                    for (int n = 0; n < 2; ++n) *(f32x4*)(rowp + bj * HALF + n * 16) = acc[ai][bj][m][n]; }
    }
};
struct EpiGate {
    static constexpr bool PERM = true;
    const bf16_t* G; bf16_t* O0; bf16_t* O1;
    __device__ __forceinline__ void operator()(const f32x4 (&acc)[2][2][4][2], const Unit& u, int wr, int wc, int fr, int fq) const {
        const int row0 = u.pm * BM + wr * 64 + fr, col0 = u.pn * BM + wc * 32 + 8 * fq;
        const bf16_t* gp = G + ((size_t)(u.pm * 8 + u.aux * 4 + u.pn) << 16) + ((wr * 4 + wc) * 64 + fq * 16 + fr) * 8;
        bf16_t* Ob = u.aux ? O1 : O0;
#pragma unroll
        for (int ai = 0; ai < 2; ++ai)
#pragma unroll
            for (int m = 0; m < 4; ++m) { bf16_t* rowp = Ob + (size_t)(row0 + ai * HALF + m * 16) * DM + col0;
#pragma unroll
                for (int bj = 0; bj < 2; ++bj) { const u32x4 nn = *(const u32x4*)(gp + ((ai * 4 + m) * 2 + bj) * 4096); const unsigned nw[4] = {nn.x, nn.y, nn.z, nn.w};
                    u32x4 w;
                    w.x = cvtpk(acc[ai][bj][m][0][0] * bflo(nw[0]), acc[ai][bj][m][0][1] * bfhi(nw[0])); w.y = cvtpk(acc[ai][bj][m][0][2] * bflo(nw[1]), acc[ai][bj][m][0][3] * bfhi(nw[1]));
                    w.z = cvtpk(acc[ai][bj][m][1][0] * bflo(nw[2]), acc[ai][bj][m][1][1] * bfhi(nw[2])); w.w = cvtpk(acc[ai][bj][m][1][2] * bflo(nw[3]), acc[ai][bj][m][1][3] * bfhi(nw[3]));
                    *(u32x4*)(rowp + bj * HALF) = w; } }
    }
};

template <class Epi, class Sched>
__device__ __forceinline__ void gemm_phase(LAS unsigned char* lds, const int K, const int lda, const int ldb, const Sched& S, const Epi& E) {
    const int tid = threadIdx.x, wid = __builtin_amdgcn_readfirstlane(tid >> 6), lane = tid & 63, wr = wid >> 2, wc = wid & 3, fr = lane & 15, fq = lane >> 4;
    const int nt = K / BK;
    unsigned voffA[2], voffB[2];
#pragma unroll
    for (int i = 0; i < 2; ++i) { int R, C; stage_rc(tid * 16 + i * 8192, R, C); const int Rb = Epi::PERM ? ((R & ~31) + perm32(R & 31)) : R;
        voffA[i] = (unsigned)(R * lda + C) * 2u; voffB[i] = (unsigned)(Rb * ldb + C) * 2u; }
    const size_t kstep = (size_t)(BK * 2);
    const size_t hstepA = (size_t)HALF * lda * 2, hstepB = (size_t)HALF * ldb * 2;
    const unsigned ldsw = (unsigned)wid * 1024u;
    const int aoff = lds_byte(wr * 64 + fr, fq * 8), boff = lds_byte(wc * 32 + fr, fq * 8);
#define PG8_SA(b, h) (((b) * 2 + (h)) * HTB)
#define PG8_SB(b, h) ((4 + (b) * 2 + (h)) * HTB)
#define PG8_STAGE(bufoff, gbase, voff) do { _Pragma("unroll") for (int _i = 0; _i < 2; ++_i) \
        __builtin_amdgcn_global_load_lds((const unsigned*)((const char*)(gbase) + (voff)[_i]), (LAS unsigned*)(lds + (bufoff) + ldsw + _i * 8192), 16, 0, 0); } while (0)
#define PG8_LDA(dst, b, h) do { _Pragma("unroll") for (int m = 0; m < 4; ++m) _Pragma("unroll") for (int k = 0; k < 2; ++k) dst[m][k] = *(const LAS bf16x8*)(lds + PG8_SA(b, h) + aoff + m * 2048 + k * 1024); } while (0)
#define PG8_LDB(dst, b, h) do { _Pragma("unroll") for (int n = 0; n < 2; ++n) _Pragma("unroll") for (int k = 0; k < 2; ++k) dst[n][k] = *(const LAS bf16x8*)(lds + PG8_SB(b, h) + boff + n * 2048 + k * 1024); } while (0)
#define PG8_MMA(ai, bj, At, Bt) do { __builtin_amdgcn_s_setprio(1); _Pragma("unroll") for (int m = 0; m < 4; ++m) _Pragma("unroll") for (int n = 0; n < 2; ++n) _Pragma("unroll") for (int k = 0; k < 2; ++k) \
        acc[ai][bj][m][n] = __builtin_amdgcn_mfma_f32_16x16x32_bf16(Bt[n][k], At[m][k], acc[ai][bj][m][n], 0, 0, 0); __builtin_amdgcn_s_setprio(0); } while (0)
#define PG8_WAIT_V(n) asm volatile("s_waitcnt vmcnt(" #n ")" ::: "memory")
#define PG8_WAIT_L(n) asm volatile("s_waitcnt lgkmcnt(" #n ")" ::: "memory")
#define PG8_BAR __builtin_amdgcn_s_barrier()
#define PG8_SCHED __builtin_amdgcn_sched_barrier(0)
    Unit cur, nxt; int ui = 0;
    if (!S.next(0, cur)) return;
    f32x4 acc[2][2][4][2];
#pragma unroll
    for (int a = 0; a < 2; ++a)
#pragma unroll
        for (int b = 0; b < 2; ++b)
#pragma unroll
            for (int m = 0; m < 4; ++m)
#pragma unroll
                for (int n = 0; n < 2; ++n) acc[a][b][m][n] = (f32x4){0.f, 0.f, 0.f, 0.f};
    bf16x8 At[4][2], B0[2][2], B1[2][2];
    const char* cA = uptr(cur.A); const char* cB = uptr(cur.B);
    PG8_STAGE(PG8_SB(0, 0), cB, voffB); PG8_STAGE(PG8_SB(0, 1), cB + hstepB, voffB); PG8_STAGE(PG8_SA(0, 0), cA, voffA); PG8_STAGE(PG8_SA(0, 1), cA + hstepA, voffA);
    if (wr == 1) PG8_BAR;
    PG8_WAIT_V(2); PG8_BAR;
    PG8_STAGE(PG8_SB(1, 0), cB + kstep, voffB); PG8_STAGE(PG8_SA(1, 0), cA + kstep, voffA); PG8_STAGE(PG8_SB(1, 1), cB + hstepB + kstep, voffB);
    PG8_WAIT_V(6); PG8_BAR;
    for (;;) {
        const bool has_next = S.next(ui + 1, nxt);
        const char* nA = uptr(has_next ? nxt.A : cA); const char* nB = uptr(has_next ? nxt.B : cB);
        for (int t = 0; t < nt; t += 2) {
            const bool last = (t == nt - 2);
            const char* a1 = cA + (size_t)(t + 1) * kstep;
            const char* a2 = last ? nA : cA + (size_t)(t + 2) * kstep; const char* b2 = last ? nB : cB + (size_t)(t + 2) * kstep;
            const char* a3 = a2 + kstep; const char* b3 = b2 + kstep;
            PG8_LDB(B0, 0, 0); PG8_LDB(B1, 0, 1); PG8_SCHED; PG8_LDA(At, 0, 0); PG8_STAGE(PG8_SA(1, 1), a1 + hstepA, voffA);
            PG8_WAIT_V(8); PG8_WAIT_L(0); PG8_BAR; PG8_MMA(0, 0, At, B0); PG8_MMA(0, 1, At, B1); PG8_BAR; PG8_SCHED;
            PG8_LDA(At, 0, 1); PG8_STAGE(PG8_SB(0, 0), b2, voffB); PG8_STAGE(PG8_SB(0, 1), b2 + hstepB, voffB); PG8_STAGE(PG8_SA(0, 0), a2, voffA);
            PG8_WAIT_V(8); PG8_WAIT_L(0); PG8_BAR; PG8_MMA(1, 0, At, B0); PG8_MMA(1, 1, At, B1); PG8_BAR; PG8_SCHED;
            PG8_LDB(B0, 1, 0); PG8_LDB(B1, 1, 1); PG8_SCHED; PG8_LDA(At, 1, 0); PG8_STAGE(PG8_SA(0, 1), a2 + hstepA, voffA);
            PG8_WAIT_V(8); PG8_WAIT_L(0); PG8_BAR; PG8_MMA(0, 0, At, B0); PG8_MMA(0, 1, At, B1); PG8_BAR; PG8_SCHED;
            PG8_LDA(At, 1, 1); PG8_STAGE(PG8_SB(1, 0), b3, voffB); PG8_STAGE(PG8_SB(1, 1), b3 + hstepB, voffB); PG8_STAGE(PG8_SA(1, 0), a3, voffA);
            PG8_WAIT_V(8); PG8_WAIT_L(0); PG8_BAR; PG8_MMA(1, 0, At, B0); PG8_MMA(1, 1, At, B1); PG8_BAR; PG8_SCHED;
        }
        if (wr == 0) PG8_BAR;
        E(acc, cur, wr, wc, fr, fq);
#pragma unroll
        for (int a = 0; a < 2; ++a)
#pragma unroll
            for (int b = 0; b < 2; ++b)
#pragma unroll
                for (int m = 0; m < 4; ++m)
#pragma unroll
                    for (int n = 0; n < 2; ++n) acc[a][b][m][n] = (f32x4){0.f, 0.f, 0.f, 0.f};
        if (!has_next) break;
        cur = nxt; cA = nA; cB = nB; ++ui;
        if (wr == 1) PG8_BAR;
    }
    PG8_WAIT_V(0);
    PG8_BAR;
#undef PG8_SA
#undef PG8_SB
#undef PG8_STAGE
#undef PG8_LDA
#undef PG8_LDB
#undef PG8_MMA
#undef PG8_WAIT_V
#undef PG8_WAIT_L
#undef PG8_BAR
#undef PG8_SCHED
}
}

#define XB_TMO      128
#define XB_XCNT(j)  (256  + 64 * (j))
#define XB_XSUB(j)  (1280 + 64 * (j))
#define XB_XGEN(j)  (2304 + 64 * (j))
#define XB_TOP      3328
#define XB_TOPGEN   3392
#define XCD_BAR_WORDS 3456
#define XB_SPIN_CAP (1u << 22)
__device__ __forceinline__ unsigned xb_ld(unsigned* p)              { return __hip_atomic_load(p, __ATOMIC_RELAXED, __HIP_MEMORY_SCOPE_AGENT); }
__device__ __forceinline__ unsigned xb_add(unsigned* p, unsigned v) { return __hip_atomic_fetch_add(p, v, __ATOMIC_RELAXED, __HIP_MEMORY_SCOPE_AGENT); }
__device__ __forceinline__ unsigned xb_xcc_id() { return (unsigned)__builtin_amdgcn_s_getreg((3 << 11) | 20) & 0xFu; }
#define XB_SPIN(cond, bar) do { unsigned _sp = 0; while (cond) { __builtin_amdgcn_s_sleep(1); \
    if ((++_sp & 255u) == 0u) { if (xb_ld(&(bar)[XB_TMO])) break; if (_sp > XB_SPIN_CAP) { atomicAdd(&(bar)[XB_TMO], 1u); break; } } } } while (0)
struct XcdBarrier { unsigned* bar; unsigned x; volatile LAS unsigned* st; };
__device__ __forceinline__ XcdBarrier xcd_barrier_post(unsigned* bar, volatile LAS unsigned* st) {
    XcdBarrier b; b.bar = bar; b.x = xb_xcc_id(); b.st = st;
    if (threadIdx.x == 0) (void)xb_add(&bar[XB_XCNT(b.x)], 1u);
    return b;
}
__device__ __forceinline__ void xcd_barrier_complete(unsigned* bar, unsigned x, unsigned& nloc, unsigned& nx) {
    const unsigned G = gridDim.x * gridDim.y * gridDim.z;
    unsigned sum, cnt, mine, sp = 0u;
    for (;;) {
        sum = 0u; cnt = 0u; mine = 0u;
#pragma unroll
        for (unsigned j = 0; j < 16; ++j) { const unsigned c = xb_ld(&bar[XB_XCNT(j)]); sum += c; cnt += (c > 0u) ? 1u : 0u; mine = (j == x) ? c : mine; }
        if (sum == G) break;
        __builtin_amdgcn_s_sleep(1);
        if ((++sp & 255u) == 0u) { if (xb_ld(&bar[XB_TMO])) break; if (sp > XB_SPIN_CAP) { atomicAdd(&bar[XB_TMO], 1u); break; } }
    }
    nloc = mine > 0u ? mine : 1u; nx = cnt > 0u ? cnt : 1u;
}
__device__ __forceinline__ void xcd_barrier(const XcdBarrier& b) {
    asm volatile("s_waitcnt vmcnt(0)" ::: "memory");
    __syncthreads();
    if (threadIdx.x == 0) {
        unsigned* bar = b.bar;
        __builtin_amdgcn_s_waitcnt(0);
        unsigned nloc = b.st[0], nx = b.st[1];
        if (nloc == 0u) { xcd_barrier_complete(bar, b.x, nloc, nx); b.st[0] = nloc; b.st[1] = nx; }
        const unsigned old = xb_add(&bar[XB_XSUB(b.x)], 1u);
        const unsigned gen = old / nloc;
        if (old + 1u == (gen + 1u) * nloc) {
            __builtin_amdgcn_fence(__ATOMIC_RELEASE, "agent");
            asm volatile("s_waitcnt vmcnt(0)" ::: "memory");
            const unsigned og = xb_add(&bar[XB_TOP], 1u);
            const unsigned tg = og / nx;
            if (og + 1u == (tg + 1u) * nx) xb_add(&bar[XB_TOPGEN], 1u);
            else XB_SPIN(xb_ld(&bar[XB_TOPGEN]) == tg, bar);
            __builtin_amdgcn_fence(__ATOMIC_ACQUIRE, "agent");
            xb_add(&bar[XB_XGEN(b.x)], 1u);
            asm volatile("s_waitcnt vmcnt(0)" ::: "memory");
        } else {
            XB_SPIN(xb_ld(&bar[XB_XGEN(b.x)]) == gen, bar);
            __builtin_amdgcn_fence(__ATOMIC_ACQUIRE, "agent");
            asm volatile("s_waitcnt vmcnt(0)" ::: "memory");
        }
    }
    __syncthreads();
}

struct Frame {
    LAS unsigned char* lds;
    int tid, lane, wave, G, bid;
    const float* in[28];
    float* out; unsigned char* ws;
    __device__ __forceinline__ const float* xrow(int m) const { return m < NCTX ? in[0] + (size_t)m * DM : in[1] + (size_t)(m - NCTX) * DM; }
};
__device__ __forceinline__ int cond_of(int m) { return m < NCTX ? 0 : 1 + ((m - NCTX) >> 10); }

__device__ __forceinline__ void p0_transpose_item(const float* W, int N, int K, bf16_t* WT, int k0, int n0, int drow0, LAS float* scr, int lane) {
#pragma unroll 8
    for (int i = 0; i < 32; ++i) { const int kk = 2 * i + (lane >> 5); scr[kk * 33 + (lane & 31)] = W[(size_t)(k0 + kk) * N + n0 + (lane & 31)]; }
    asm volatile("s_waitcnt lgkmcnt(0)" ::: "memory");
    const int c = lane & 7;
#pragma unroll
    for (int j = 0; j < 4; ++j) { const int n = (lane >> 3) + 8 * j; const LAS float* s = scr + (8 * c) * 33 + n;
        u32x4 o; o.x = cvtpk(s[0 * 33], s[1 * 33]); o.y = cvtpk(s[2 * 33], s[3 * 33]); o.z = cvtpk(s[4 * 33], s[5 * 33]); o.w = cvtpk(s[6 * 33], s[7 * 33]);
        *(u32x4*)(WT + (size_t)(drow0 + n) * K + k0 + 8 * c) = o; }
    asm volatile("s_waitcnt lgkmcnt(0)" ::: "memory");
}
constexpr int I_IN = 16 * 161, I_GO = 8 * 32, I_NO = 8 * 32, I_OUT = 16 * 32, I_UP = 16 * 176, I_DN = 44 * 32;
constexpr int I_EARLY = I_IN + I_GO + I_NO + I_OUT, I_LATE = I_UP + I_DN;
__device__ __forceinline__ void p0_transposes(Frame& F, int first, int count, int worker, int nworkers) {
    LAS float* scr = (LAS float*)(F.lds + F.wave * 16384);
    for (int it = first + worker; it < first + count; it += nworkers) {
        int r = it;
        if (r < I_IN) { const int kb = r / 161, nb = r % 161;
            if (nb == 48) p0_transpose_item(F.in[11], DIN, 1024, (bf16_t*)(F.ws + WS_WZT), 64 * kb, 32 * nb, 0, scr, F.lane);
            else p0_transpose_item(F.in[11], DIN, 1024, (bf16_t*)(F.ws + WS_WIN), 64 * kb, 32 * nb, 32 * nb - (nb > 48 ? 32 : 0), scr, F.lane);
            continue; } r -= I_IN;
        if (r < I_GO) { p0_transpose_item(F.in[20], 1024, 512, (bf16_t*)(F.ws + WS_WGO), 64 * (r / 32), 32 * (r % 32), 32 * (r % 32), scr, F.lane); continue; } r -= I_GO;
        if (r < I_NO) { p0_transpose_item(F.in[21], 1024, 512, (bf16_t*)(F.ws + WS_WNO), 64 * (r / 32), 32 * (r % 32), 32 * (r % 32), scr, F.lane); continue; } r -= I_NO;
        if (r < I_OUT) { p0_transpose_item(F.in[22], 1024, 1024, (bf16_t*)(F.ws + WS_WOUT), 64 * (r / 32), 32 * (r % 32), 32 * (r % 32), scr, F.lane); continue; } r -= I_OUT;
        if (r < I_UP) { p0_transpose_item(F.in[24], NUP, 1024, (bf16_t*)(F.ws + WS_WUP), 64 * (r / 176), 32 * (r % 176), 32 * (r % 176), scr, F.lane); continue; } r -= I_UP;
        p0_transpose_item(F.in[27], 1024, DFF, (bf16_t*)(F.ws + WS_WDN), 64 * (r / 32), 32 * (r % 32), 32 * (r % 32), scr, F.lane);
    }
}
__device__ __forceinline__ void p0_prologue(Frame& F) {
    {
        LAS float* sc = (LAS float*)(F.lds);
        LAS float* red = (LAS float*)(F.lds + 12288);
        for (int i = F.tid; i < 3072; i += NTHR) { const int c = i >> 10, k = i & 1023; const float v = c == 0 ? F.in[7][k] : F.in[2][(c - 1) * 1024 + k]; sc[i] = siluf_(v); }
        __syncthreads();
        const float* wada = F.in[8]; const float* bada = F.in[9]; float* ada = (float*)(F.ws + WS_ADA);
        for (int cb = F.bid; cb < 256; cb += F.G) {
            if (F.tid < 384) {
                const int cq = F.tid % 6, kg = F.tid / 6;
                f32x4 a0 = {0.f, 0.f, 0.f, 0.f}, a1 = a0, a2 = a0;
#pragma unroll 4
                for (int kk = 0; kk < 16; ++kk) { const int k = 16 * kg + kk; const f32x4 w = *(const f32x4*)(wada + (size_t)k * 6144 + 24 * cb + 4 * cq);
                    a0 += w * sc[k]; a1 += w * sc[1024 + k]; a2 += w * sc[2048 + k]; }
#pragma unroll
                for (int e = 0; e < 4; ++e) { red[(0 * 64 + kg) * 24 + 4 * cq + e] = a0[e]; red[(1 * 64 + kg) * 24 + 4 * cq + e] = a1[e]; red[(2 * 64 + kg) * 24 + 4 * cq + e] = a2[e]; }
            }
            __syncthreads();
            if (F.tid < 72) { const int c = F.tid / 24, col = F.tid % 24; float s = 0.f;
                for (int kg = 0; kg < 64; ++kg) s += red[(c * 64 + kg) * 24 + col];
                ada[c * 6144 + 24 * cb + col] = s + bada[24 * cb + col]; }
            __syncthreads();
        }
    }
    p0_transposes(F, 0, F.G == 256 ? I_EARLY : I_EARLY + I_LATE, F.bid * NWAVES + F.wave, F.G * NWAVES);
}

template <bool FROM_OUT>
__device__ __forceinline__ void norm_rows(Frame& F, const float* g, int off_sh, int off_sc) {
    const int gw = F.bid * NWAVES + F.wave, NGW = F.G * NWAVES;
    const float* ada = (const float*)(F.ws + WS_ADA);
    bf16_t* H = (bf16_t*)(F.ws + WS_H);
    for (int mb = gw; mb < MTOK; mb += 3 * NGW) {
        f32x4 v[3][4];
#pragma unroll
        for (int r = 0; r < 3; ++r) { const int m = mb + r * NGW; if (m < MTOK) { const float* xr = FROM_OUT ? F.out + (size_t)m * DM : F.xrow(m);
#pragma unroll
            for (int j = 0; j < 4; ++j) v[r][j] = *(const f32x4*)(xr + 4 * F.lane + 256 * j); } }
#pragma unroll
        for (int r = 0; r < 3; ++r) { const int m = mb + r * NGW; if (m >= MTOK) break;
            const float* ad = ada + cond_of(m) * 6144;
            f32x4 gg[4], sc[4], sh[4];
#pragma unroll
            for (int j = 0; j < 4; ++j) { const int c = 4 * F.lane + 256 * j; gg[j] = *(const f32x4*)(g + c); sc[j] = *(const f32x4*)(ad + off_sc + c); sh[j] = *(const f32x4*)(ad + off_sh + c); }
            float s = 0.f;
#pragma unroll
            for (int j = 0; j < 4; ++j) s += (v[r][j].x * v[r][j].x + v[r][j].y * v[r][j].y) + (v[r][j].z * v[r][j].z + v[r][j].w * v[r][j].w);
            const float rinv = rsqrtf(wave_sum(s) * (1.f / DM) + EPS);
#pragma unroll
            for (int j = 0; j < 4; ++j) { const int c = 4 * F.lane + 256 * j;
                const f32x4 o = v[r][j] * rinv * gg[j] * (sc[j] + 1.f) + sh[j];
                u32x2 w; w.x = cvtpk(o[0], o[1]); w.y = cvtpk(o[2], o[3]);
                *(u32x2*)(H + (size_t)m * DM + c) = w; } }
    }
}

__device__ __forceinline__ void kvout_rows(Frame& F, int m0, int nrows) {
    const bf16_t* U = (const bf16_t*)(F.ws + WS_U);
    const float* gk = F.in[18];
    for (int i = F.wave; i < nrows; i += NWAVES) {
        const int m = m0 + i;
        float k[8], v[8];
        unpack8(*(const u32x4*)(U + (size_t)m * NU + UNK + 8 * F.lane), k);
        unpack8(*(const u32x4*)(U + (size_t)m * NU + UNV + 8 * F.lane), v);
        float s = 0.f;
#pragma unroll
        for (int e = 0; e < 8; ++e) s += k[e] * k[e];
        s += __shfl_xor(s, 1); s += __shfl_xor(s, 2); s += __shfl_xor(s, 4);
        const float rinv = rsqrtf(s * (1.f / 64.f) + EPS);
        const int d0 = (8 * F.lane) & 63;
        f32x4 o0, o1;
#pragma unroll
        for (int e = 0; e < 4; ++e) { o0[e] = k[e] * rinv * gk[d0 + e]; o1[e] = k[4 + e] * rinv * gk[d0 + 4 + e]; }
        float* ok = F.out + O_NK + (size_t)m * 512 + 8 * F.lane; float* ov = F.out + O_NV + (size_t)m * 512 + 8 * F.lane;
        *(f32x4*)ok = o0; *(f32x4*)(ok + 4) = o1;
        *(f32x4*)ov = (f32x4){v[0], v[1], v[2], v[3]}; *(f32x4*)(ov + 4) = (f32x4){v[4], v[5], v[6], v[7]};
    }
}


__device__ __forceinline__ float logsigf_(float x) { return fminf(x, 0.f) - __logf(1.f + __expf(-fabsf(x))); }
constexpr int VLS = 160;
constexpr int STS = 72;

__device__ __forceinline__ void gla_stage_v(Frame& F, const bf16_t* U, int m0, int h, LAS bf16_t* VL) {
#pragma unroll
    for (int i = 0; i < 2; ++i) { const int p = F.tid + i * NTHR, row = p >> 4, c16 = p & 15;
        const u32x4 v = *(const u32x4*)(U + (size_t)(m0 + row) * NU + UV + 128 * h + 8 * c16);
        *(LAS u32x4*)(VL + row * VLS + 8 * c16) = v; }
}

__device__ __forceinline__ void gla_pass1_item(Frame& F, int item) {
    const bf16_t* U = (const bf16_t*)(F.ws + WS_U); const float* Z = (const float*)(F.ws + WS_Z);
    bf16_t* QK = (bf16_t*)(F.ws + WS_QK) + (size_t)item * 4 * 4096; bf16_t* KV = (bf16_t*)(F.ws + WS_KV) + (size_t)item * 2 * 8192; float* DEC = (float*)(F.ws + WS_DEC) + (size_t)item * 128;
    const int gc = item >> 2, h = item & 3, m0 = gc * 64, tid = F.tid, d = tid & 63, w = F.wave, t0 = 8 * w;
    LAS float* ZL = (LAS float*)(F.lds);
    LAS float* SEG = (LAS float*)(F.lds + 8192);
    LAS bf16_t* KP = (LAS bf16_t*)(F.lds + 12288);
    LAS bf16_t* VL = (LAS bf16_t*)(F.lds + 28672);
    LAS bf16_t* QS = (LAS bf16_t*)(F.lds + 49152);
    { const int t = tid >> 3, c4 = tid & 7; *(LAS f32x4*)(ZL + t * 32 + 4 * c4) = *(const f32x4*)(Z + (size_t)(m0 + t) * 32 + 4 * c4);
      const bf16_t* up = U + (size_t)(m0 + t) * NU + 64 * h + 8 * c4;
      *(LAS u32x4*)(QS + t * 64 + 8 * c4) = *(const u32x4*)(up + UQ); *(LAS u32x4*)(QS + 4096 + t * 64 + 8 * c4) = *(const u32x4*)(up + UK); }
    gla_stage_v(F, U, m0, h, VL);
    float wf[16], wb[16];
#pragma unroll
    for (int j = 0; j < 16; ++j) { wf[j] = F.in[12][j * 256 + 64 * h + d]; wb[j] = F.in[14][j * 256 + 64 * h + d]; }
    const float bfv = F.in[13][64 * h + d], bbv = F.in[15][64 * h + d];
    __syncthreads();
    float q[8], k[8];
#pragma unroll
    for (int i = 0; i < 8; ++i) { q[i] = __uint_as_float((unsigned)QS[(t0 + i) * 64 + d] << 16) * 0.125f; k[i] = __uint_as_float((unsigned)QS[4096 + (t0 + i) * 64 + d] << 16); }
    float cf[8], cb[8];
#pragma unroll
    for (int i = 0; i < 8; ++i) { float af = bfv, ab = bbv;
#pragma unroll
        for (int j = 0; j < 16; ++j) { af += ZL[(t0 + i) * 32 + j] * wf[j]; ab += ZL[(t0 + i) * 32 + 16 + j] * wb[j]; }
        cf[i] = logsigf_(af) * (1.f / 16.f); cb[i] = logsigf_(ab) * (1.f / 16.f); }
#pragma unroll
    for (int i = 1; i < 8; ++i) cf[i] += cf[i - 1];
#pragma unroll
    for (int i = 6; i >= 0; --i) cb[i] += cb[i + 1];
    SEG[w * 64 + d] = cf[7]; SEG[(8 + w) * 64 + d] = cb[0];
    __syncthreads();
    float offf = 0.f, totf = 0.f, offb = 0.f, totb = 0.f;
#pragma unroll
    for (int sg = 0; sg < 8; ++sg) { const float a = SEG[sg * 64 + d], b2 = SEG[(8 + sg) * 64 + d]; totf += a; totb += b2; offf += sg < w ? a : 0.f; offb += sg > w ? b2 : 0.f; }
#pragma unroll
    for (int i = 0; i < 8; ++i) { const int t = t0 + i;
        { const float c = offf + cf[i], e = __expf(c), ei = __expf(-c), el = __expf(totf - c);
          QS[0 * 4096 + t * 64 + d] = (bf16_t)(cvtpk(q[i] * e, 0.f) & 0xffffu); QS[1 * 4096 + t * 64 + d] = (bf16_t)(cvtpk(k[i] * ei, 0.f) & 0xffffu); KP[t * 64 + d] = (bf16_t)(cvtpk(k[i] * el, 0.f) & 0xffffu); }
        { const float c = offb + cb[i], e = __expf(c), ei = __expf(-c), el = __expf(totb - c);
          QS[2 * 4096 + t * 64 + d] = (bf16_t)(cvtpk(q[i] * e, 0.f) & 0xffffu); QS[3 * 4096 + t * 64 + d] = (bf16_t)(cvtpk(k[i] * ei, 0.f) & 0xffffu); KP[(64 + t) * 64 + d] = (bf16_t)(cvtpk(k[i] * el, 0.f) & 0xffffu); } }
    if (w == 0) { DEC[d] = __expf(totf); DEC[64 + d] = __expf(totb); }
    __syncthreads();
#pragma unroll
    for (int i = 0; i < 4; ++i) *(u32x4*)(QK + (size_t)(tid + i * NTHR) * 8) = *(const LAS u32x4*)(QS + (tid + i * NTHR) * 8);
    { const int l = F.lane, hh = l >> 5, g1 = (l >> 4) & 1, qq = (l & 15) >> 2, pp = l & 3, dvt = w & 3, dt = w >> 2;
#pragma unroll
      for (int dir = 0; dir < 2; ++dir) { f32x16 acc = {};
#pragma unroll
        for (int ks = 0; ks < 4; ++ks) { const int r0 = 16 * ks + 8 * hh + qq;
            const LAS bf16_t* va = VL + r0 * VLS + 32 * dvt + 16 * g1 + 4 * pp; const LAS bf16_t* kb = KP + (dir * 64 + r0) * 64 + 32 * dt + 16 * g1 + 4 * pp;
            const bf16x8 a = cat8(vtr(va), vtr(va + 4 * VLS)), b = cat8(vtr(kb), vtr(kb + 4 * 64));
            acc = __builtin_amdgcn_mfma_f32_32x32x16_bf16(a, b, acc, 0, 0, 0); }
        bf16_t* kvp = KV + (size_t)dir * 8192 + (32 * dt + (l & 31)) * 128 + 32 * dvt + 4 * hh;
#pragma unroll
        for (int rg = 0; rg < 4; ++rg) { u32x2 wv; wv.x = cvtpk(acc[4 * rg], acc[4 * rg + 1]); wv.y = cvtpk(acc[4 * rg + 2], acc[4 * rg + 3]); *(u32x2*)(kvp + 8 * rg) = wv; } } }
    __syncthreads();
}

__device__ __forceinline__ void gla_scan_chain(Frame& F, int chain) {
    const bf16_t* KVb = (const bf16_t*)(F.ws + WS_KV); const float* DECb = (const float*)(F.ws + WS_DEC); bf16_t* SSb = (bf16_t*)(F.ws + WS_SS);
    int seq, h, dir;
    if (chain < 16) { seq = 16 + (chain >> 3); h = (chain >> 1) & 3; dir = chain & 1; } else { const int c = chain - 16; seq = c >> 3; h = (c >> 1) & 3; dir = c & 1; }
    const bool ctx = seq < 16; const int N = ctx ? 4 : 16, gc0 = ctx ? seq * 4 : 64 + (seq - 16) * 16;
    const int d = F.lane, dv0 = 16 * F.wave;
    float S[16];
    if (ctx) {
#pragma unroll
        for (int e = 0; e < 16; ++e) S[e] = 0.f; }
    else { const float* s0 = (dir ? F.in[6] : F.in[5]) + (size_t)((seq - 16) * 4 + h) * 8192 + d * 128 + dv0;
#pragma unroll
        for (int e4 = 0; e4 < 4; ++e4) { const f32x4 v = *(const f32x4*)(s0 + 4 * e4); S[4 * e4] = v[0]; S[4 * e4 + 1] = v[1]; S[4 * e4 + 2] = v[2]; S[4 * e4 + 3] = v[3]; } }
    for (int n0 = 0; n0 < N; n0 += 4) {
        u32x4 kv[4][2]; float dc[4];
#pragma unroll
        for (int u = 0; u < 4; ++u) { const int n = n0 + u, gc = gc0 + (dir ? N - 1 - n : n), it = gc * 4 + h;
            const bf16_t* kp = KVb + ((size_t)it * 2 + dir) * 8192 + d * 128 + dv0; kv[u][0] = *(const u32x4*)kp; kv[u][1] = *(const u32x4*)(kp + 8); dc[u] = DECb[(size_t)it * 128 + dir * 64 + d]; }
#pragma unroll
        for (int u = 0; u < 4; ++u) { const int n = n0 + u, gc = gc0 + (dir ? N - 1 - n : n), it = gc * 4 + h;
            bf16_t* sp = SSb + ((size_t)it * 2 + dir) * 8192 + d * 128 + dv0;
            u32x4 w0, w1; w0.x = cvtpk(S[0], S[1]); w0.y = cvtpk(S[2], S[3]); w0.z = cvtpk(S[4], S[5]); w0.w = cvtpk(S[6], S[7]); w1.x = cvtpk(S[8], S[9]); w1.y = cvtpk(S[10], S[11]); w1.z = cvtpk(S[12], S[13]); w1.w = cvtpk(S[14], S[15]);
            *(u32x4*)sp = w0; *(u32x4*)(sp + 8) = w1;
            float kf[16]; { float t8[8]; unpack8(kv[u][0], t8);
#pragma unroll
                for (int e = 0; e < 8; ++e) kf[e] = t8[e];
                unpack8(kv[u][1], t8);
#pragma unroll
                for (int e = 0; e < 8; ++e) kf[8 + e] = t8[e]; }
#pragma unroll
            for (int e = 0; e < 16; ++e) S[e] = dc[u] * S[e] + kf[e]; }
    }
    if (ctx) { float* so = F.out + (dir ? O_SB : O_SF) + (size_t)(seq * 4 + h) * 8192 + d * 128 + dv0;
#pragma unroll
        for (int e4 = 0; e4 < 4; ++e4) *(f32x4*)(so + 4 * e4) = (f32x4){S[4 * e4], S[4 * e4 + 1], S[4 * e4 + 2], S[4 * e4 + 3]}; }
}

__device__ __forceinline__ void gla_pass2_item(Frame& F, int item) {
    const bf16_t* U = (const bf16_t*)(F.ws + WS_U); bf16_t* OG = (bf16_t*)(F.ws + WS_OG);
    const bf16_t* QKb = (const bf16_t*)(F.ws + WS_QK); const bf16_t* SSb = (const bf16_t*)(F.ws + WS_SS) + (size_t)item * 2 * 8192;
    const int gc = item >> 2, h = item & 3, m0 = gc * 64, tid = F.tid;
    LAS bf16_t* ST = (LAS bf16_t*)(F.lds);
    LAS bf16_t* VL = (LAS bf16_t*)(F.lds + 40960);
    LAS float* SS = (LAS float*)(F.lds + 61440);
#pragma unroll
    for (int i = 0; i < 4; ++i) { const int p = tid + i * NTHR, dir = p >> 10, row = (p & 1023) >> 4, c16 = p & 15;
        *(LAS u32x4*)(ST + (dir * 64 + row) * VLS + 8 * c16) = *(const u32x4*)(SSb + (size_t)dir * 8192 + row * 128 + 8 * c16); }
    gla_stage_v(F, U, m0, h, VL);
    __syncthreads();
    const int l = F.lane, hh = l >> 5, c31 = l & 31, g1 = (l >> 4) & 1, qq = (l & 15) >> 2, pp = l & 3, dvt = F.wave & 3, tt = F.wave >> 2;
    f32x16 o = {};
#pragma unroll
    for (int dir = 0; dir < 2; ++dir) {
        const bf16_t* Qg = QKb + ((size_t)item * 4 + 2 * dir) * 4096; const bf16_t* Kg = Qg + 4096;
        bf16x8 qf[4];
#pragma unroll
        for (int ks = 0; ks < 4; ++ks) qf[ks] = *(const bf16x8*)(Qg + (32 * tt + c31) * 64 + 16 * ks + 8 * hh);
#pragma unroll
        for (int st = 0; st < 2; ++st) {
            if (dir == 0 ? st > tt : st < tt) continue;
            f32x16 p = {};
#pragma unroll
            for (int ks = 0; ks < 4; ++ks) { const bf16x8 kf = *(const bf16x8*)(Kg + (32 * st + c31) * 64 + 16 * ks + 8 * hh); p = __builtin_amdgcn_mfma_f32_32x32x16_bf16(kf, qf[ks], p, 0, 0, 0); }
            if (st == tt) {
#pragma unroll
                for (int r = 0; r < 16; ++r) { const int sx = crow(r, hh); const bool keep = dir == 0 ? sx <= c31 : sx >= c31; p[r] = keep ? p[r] : 0.f; } }
#pragma unroll
            for (int s2 = 0; s2 < 2; ++s2) {
                u32x4 pw; pw.x = cvtpk(p[8 * s2 + 0], p[8 * s2 + 1]); pw.y = cvtpk(p[8 * s2 + 2], p[8 * s2 + 3]); pw.z = cvtpk(p[8 * s2 + 4], p[8 * s2 + 5]); pw.w = cvtpk(p[8 * s2 + 6], p[8 * s2 + 7]);
                const LAS bf16_t* va = VL + (32 * st + 16 * s2 + 4 * hh + qq) * VLS + 32 * dvt + 16 * g1 + 4 * pp;
                o = __builtin_amdgcn_mfma_f32_32x32x16_bf16(cat8(vtr(va), vtr(va + 8 * VLS)), __builtin_bit_cast(bf16x8, pw), o, 0, 0, 0); }
        }
#pragma unroll
        for (int ks = 0; ks < 4; ++ks) { const LAS bf16_t* sa = ST + (dir * 64 + 16 * ks + 8 * hh + qq) * VLS + 32 * dvt + 16 * g1 + 4 * pp;
            o = __builtin_amdgcn_mfma_f32_32x32x16_bf16(cat8(vtr(sa), vtr(sa + 4 * VLS)), qf[ks], o, 0, 0, 0); }
    }
    { float ss = 0.f;
#pragma unroll
      for (int r = 0; r < 16; ++r) ss += o[r] * o[r];
      ss += __shfl_xor(ss, 32);
      if (hh == 0) SS[dvt * 64 + 32 * tt + c31] = ss; }
    __syncthreads();
    { const int t = 32 * tt + c31; const float tot = SS[t] + SS[64 + t] + SS[128 + t] + SS[192 + t]; const float rinv = rsqrtf(tot * (1.f / 128.f) + EPS);
      const float* gg = F.in[16]; const size_t m = (size_t)(m0 + t);
#pragma unroll
      for (int rg = 0; rg < 4; ++rg) { const int dv0 = 32 * dvt + 8 * rg + 4 * hh; const f32x4 g4 = *(const f32x4*)(gg + dv0);
          const u32x2 gr = *(const u32x2*)(U + m * NU + UR + 128 * h + dv0); const float r0 = bflo(gr.x), r1 = bfhi(gr.x), r2 = bflo(gr.y), r3 = bfhi(gr.y);
          u32x2 wv; wv.x = cvtpk(o[4 * rg + 0] * rinv * g4[0] * siluf_(r0), o[4 * rg + 1] * rinv * g4[1] * siluf_(r1)); wv.y = cvtpk(o[4 * rg + 2] * rinv * g4[2] * siluf_(r2), o[4 * rg + 3] * rinv * g4[3] * siluf_(r3));
          *(u32x2*)(OG + m * 512 + 128 * h + dv0) = wv; } }
    __syncthreads();
}

constexpr float QSC = 0.125f * LOG2E;
struct AttnLocal { const LAS float* rpb; int dr0; int qc0; };

template <bool FROMU, bool LOCAL>
__device__ __forceinline__ void attn_wave(Frame& F, const bf16_t* U, int qtok0, int h, int kbase, const float* ckeys, const LAS bf16_t* VLw, const AttnLocal& L, f32x16 (&o)[2], float& m_out, float& l_out) {
    const int l = F.lane, hh = l >> 5, c31 = l & 31, g1 = (l >> 4) & 1, qq = (l & 15) >> 2, pp = l & 3;
    const float* gq = F.in[17]; const float* gk = F.in[18];
    bf16x8 qf[4];
    { float f[4][8]; float ss = 0.f; const bf16_t* qp = U + (size_t)(qtok0 + c31) * NU + UNQ + 64 * h + 8 * hh;
#pragma unroll
      for (int ks = 0; ks < 4; ++ks) { unpack8(*(const u32x4*)(qp + 16 * ks), f[ks]);
#pragma unroll
          for (int e = 0; e < 8; ++e) ss += f[ks][e] * f[ks][e]; }
      ss += __shfl_xor(ss, 32);
      const float rinv = rsqrtf(ss * (1.f / 64.f) + EPS) * QSC;
#pragma unroll
      for (int ks = 0; ks < 4; ++ks) {
#pragma unroll
          for (int e = 0; e < 8; ++e) { const int d = 16 * ks + 8 * hh + e; f[ks][e] *= rinv * gq[d] * (FROMU ? gk[d] : 1.f); }
          qf[ks] = __builtin_bit_cast(bf16x8, pack8(f[ks])); } }
    float m_run = -1e30f, l_run = 0.f;
    o[0] = f32x16{}; o[1] = f32x16{};
    const bf16_t* kpu = U + (size_t)(kbase + c31) * NU + UNK + 64 * h + 8 * hh;
    const float* kpc = FROMU ? nullptr : ckeys + ((size_t)(kbase + c31) * 8 + h) * 64 + 8 * hh;
    u32x4 rawu[4]; f32x4 rawc[8];
    if (FROMU) {
#pragma unroll
        for (int ks = 0; ks < 4; ++ks) rawu[ks] = *(const u32x4*)(kpu + 16 * ks); }
    else {
#pragma unroll
        for (int ks = 0; ks < 4; ++ks) { rawc[2 * ks] = *(const f32x4*)(kpc + 16 * ks); rawc[2 * ks + 1] = *(const f32x4*)(kpc + 16 * ks + 4); } }
#pragma unroll 1
    for (int T = 0; T < 8; ++T) {
        bf16x8 kf[4];
        if (FROMU) { float f[4][8]; float ss = 0.f;
#pragma unroll
            for (int ks = 0; ks < 4; ++ks) { unpack8(rawu[ks], f[ks]);
#pragma unroll
                for (int e = 0; e < 8; ++e) ss += f[ks][e] * f[ks][e]; }
            if (T < 7) { const bf16_t* kn = kpu + (size_t)(32 * (T + 1)) * NU;
#pragma unroll
                for (int ks = 0; ks < 4; ++ks) rawu[ks] = *(const u32x4*)(kn + 16 * ks); }
            ss += __shfl_xor(ss, 32);
            const float rinv = rsqrtf(ss * (1.f / 64.f) + EPS);
#pragma unroll
            for (int ks = 0; ks < 4; ++ks) {
#pragma unroll
                for (int e = 0; e < 8; ++e) f[ks][e] *= rinv;
                kf[ks] = __builtin_bit_cast(bf16x8, pack8(f[ks])); } }
        else {
#pragma unroll
            for (int ks = 0; ks < 4; ++ks) { const f32x4 a = rawc[2 * ks], b = rawc[2 * ks + 1];
                u32x4 w; w.x = cvtpk(a[0], a[1]); w.y = cvtpk(a[2], a[3]); w.z = cvtpk(b[0], b[1]); w.w = cvtpk(b[2], b[3]); kf[ks] = __builtin_bit_cast(bf16x8, w); }
            if (T < 7) { const float* kn = kpc + (size_t)(32 * (T + 1)) * 512;
#pragma unroll
                for (int ks = 0; ks < 4; ++ks) { rawc[2 * ks] = *(const f32x4*)(kn + 16 * ks); rawc[2 * ks + 1] = *(const f32x4*)(kn + 16 * ks + 4); } } }
        f32x16 acc = {};
#pragma unroll
        for (int ks = 0; ks < 4; ++ks) acc = __builtin_amdgcn_mfma_f32_32x32x16_bf16(kf[ks], qf[ks], acc, 0, 0, 0);
        if (LOCAL) { const int c = L.qc0 + c31, cs = min(max(c - 8, 0), 48); const LAS float* rp = L.rpb + (L.dr0 + (T >> 1)) * 32;
#pragma unroll
            for (int r = 0; r < 16; ++r) { const int kc = 32 * (T & 1) + crow(r, hh); const bool inw = kc >= cs && kc < cs + 16; const int dc = min(max(kc - c + 15, 0), 31);
                acc[r] = inw ? acc[r] + rp[dc] : -INFINITY; } }
        float mx = acc[0];
#pragma unroll
        for (int r = 1; r < 16; ++r) mx = fmaxf(mx, acc[r]);
        mx = fmaxf(mx, __shfl_xor(mx, 32));
        const float mnew = fmaxf(m_run, mx), fsc = __builtin_amdgcn_exp2f(m_run - mnew);
        m_run = mnew; l_run *= fsc;
#pragma unroll
        for (int r = 0; r < 16; ++r) { o[0][r] *= fsc; o[1][r] *= fsc; }
#pragma unroll
        for (int r = 0; r < 16; ++r) { const float p = __builtin_amdgcn_exp2f(acc[r] - mnew); acc[r] = p; l_run += p; }
#pragma unroll
        for (int s2 = 0; s2 < 2; ++s2) {
            u32x4 pw; pw.x = cvtpk(acc[8 * s2 + 0], acc[8 * s2 + 1]); pw.y = cvtpk(acc[8 * s2 + 2], acc[8 * s2 + 3]); pw.z = cvtpk(acc[8 * s2 + 4], acc[8 * s2 + 5]); pw.w = cvtpk(acc[8 * s2 + 6], acc[8 * s2 + 7]);
            const bf16x8 pb = __builtin_bit_cast(bf16x8, pw);
#pragma unroll
            for (int dt = 0; dt < 2; ++dt) { const LAS bf16_t* va = VLw + (32 * T + 16 * s2 + 4 * hh + qq) * 64 + 32 * dt + 16 * g1 + 4 * pp;
                o[dt] = __builtin_amdgcn_mfma_f32_32x32x16_bf16(cat8(vtr(va), vtr(va + 8 * 64)), pb, o[dt], 0, 0, 0); } }
    }
    l_run += __shfl_xor(l_run, 32);
    const float mx = m_run, ls = l_run;
    m_out = mx; l_out = ls;
}

__device__ __forceinline__ void attn_ctx_unit(Frame& F, int unit) {
    const bf16_t* U = (const bf16_t*)(F.ws + WS_U); bf16_t* ON = (bf16_t*)(F.ws + WS_ON);
    const int b = unit >> 3, h = unit & 7, tok0 = b * 256;
    LAS bf16_t* VL = (LAS bf16_t*)(F.lds);
#pragma unroll
    for (int i = 0; i < 4; ++i) { const int p = F.tid + i * NTHR, row = p >> 3, c8 = p & 7;
        *(LAS u32x4*)(VL + row * 64 + 8 * c8) = *(const u32x4*)(U + (size_t)(tok0 + row) * NU + UNV + 64 * h + 8 * c8); }
    __syncthreads();
    f32x16 o[2]; float mx, ls; AttnLocal L{nullptr, 0, 0};
    attn_wave<true, false>(F, U, tok0 + 32 * F.wave, h, tok0, nullptr, VL, L, o, mx, ls);
    { const int hh = F.lane >> 5, c31 = F.lane & 31; const float inv = 1.f / ls; bf16_t* op = ON + (size_t)(tok0 + 32 * F.wave + c31) * 512 + 64 * h;
#pragma unroll
      for (int dt = 0; dt < 2; ++dt)
#pragma unroll
          for (int rg = 0; rg < 4; ++rg) { u32x2 w; w.x = cvtpk(o[dt][4 * rg] * inv, o[dt][4 * rg + 1] * inv); w.y = cvtpk(o[dt][4 * rg + 2] * inv, o[dt][4 * rg + 3] * inv);
              *(u32x2*)(op + 32 * dt + 8 * rg + 4 * hh) = w; } }
    __syncthreads();
}

__device__ __forceinline__ void attn_lat_unit(Frame& F, int unit) {
    const bf16_t* U = (const bf16_t*)(F.ws + WS_U); bf16_t* ON = (bf16_t*)(F.ws + WS_ON);
    const int r = unit & 15, h = (unit >> 4) & 7, bl = unit >> 7;
    const int rs = min(max(r - 4, 0), 8), ltok0 = NCTX + bl * 1024 + rs * 64, qrow0 = NCTX + bl * 1024 + r * 64;
    LAS bf16_t* VL = (LAS bf16_t*)(F.lds);
    LAS float* RPB = (LAS float*)(F.lds + 131072);
    LAS float* ML = (LAS float*)(F.lds + 133120);
    LAS float* PO = (LAS float*)(F.lds);
    const float* cv = F.in[4] + (size_t)bl * 512 * 512;
#pragma unroll
    for (int i = 0; i < 8; ++i) { const int p = F.tid + i * NTHR, row = p >> 3, c8 = p & 7;
        *(LAS u32x4*)(VL + row * 64 + 8 * c8) = *(const u32x4*)(U + (size_t)(ltok0 + row) * NU + UNV + 64 * h + 8 * c8); }
#pragma unroll
    for (int i = 0; i < 8; ++i) { const int p = F.tid + i * NTHR, row = p >> 3, c8 = p & 7; const float* vp = cv + ((size_t)row * 8 + h) * 64 + 8 * c8;
        const f32x4 a = *(const f32x4*)vp, b2 = *(const f32x4*)(vp + 4);
        u32x4 w; w.x = cvtpk(a[0], a[1]); w.y = cvtpk(a[2], a[3]); w.z = cvtpk(b2[0], b2[1]); w.w = cvtpk(b2[2], b2[3]);
        *(LAS u32x4*)(VL + (512 + row) * 64 + 8 * c8) = w; }
    if (F.tid < 480) { const int dr = F.tid >> 5, dc = F.tid & 31; RPB[F.tid] = dc < 31 ? F.in[19][(h * 15 + dr) * 31 + dc] * LOG2E : 0.f; }
    __syncthreads();
    const int qg = F.wave >> 2, kb = F.wave & 3;
    f32x16 o[2]; float mx, ls;
    if (kb < 2) { AttnLocal L{RPB, rs + 4 * kb - r + 7, 32 * qg}; attn_wave<true, true>(F, U, qrow0 + 32 * qg, h, ltok0 + 256 * kb, nullptr, VL + 256 * kb * 64, L, o, mx, ls); }
    else { AttnLocal L{nullptr, 0, 0}; attn_wave<false, false>(F, U, qrow0 + 32 * qg, h, bl * 512 + 256 * (kb - 2), F.in[3], VL + (512 + 256 * (kb - 2)) * 64, L, o, mx, ls); }
    __syncthreads();
    { const int hh = F.lane >> 5, c31 = F.lane & 31;
#pragma unroll
      for (int dt = 0; dt < 2; ++dt)
#pragma unroll
          for (int rr = 0; rr < 16; ++rr) PO[(F.wave * 64 + 32 * dt + crow(rr, hh)) * 32 + c31] = o[dt][rr];
      if (hh == 0) { ML[F.wave * 64 + c31] = mx; ML[F.wave * 64 + 32 + c31] = ls; } }
    __syncthreads();
    { const int q = F.tid & 31, dv8 = (F.tid >> 5) & 7, qg2 = F.tid >> 8;
      float M = -INFINITY;
#pragma unroll
      for (int w = 0; w < 4; ++w) M = fmaxf(M, ML[(4 * qg2 + w) * 64 + q]);
      float Ls = 0.f, acc[8];
#pragma unroll
      for (int e = 0; e < 8; ++e) acc[e] = 0.f;
#pragma unroll
      for (int w = 0; w < 4; ++w) { const int ww = 4 * qg2 + w; const float wt = __builtin_amdgcn_exp2f(ML[ww * 64 + q] - M); Ls += wt * ML[ww * 64 + 32 + q];
#pragma unroll
          for (int e = 0; e < 8; ++e) acc[e] += wt * PO[(ww * 64 + 8 * dv8 + e) * 32 + q]; }
      const float inv = 1.f / Ls;
#pragma unroll
      for (int e = 0; e < 8; ++e) acc[e] *= inv;
      *(u32x4*)(ON + (size_t)(qrow0 + 32 * qg2 + q) * 512 + 64 * h + 8 * dv8) = pack8(acc); }
    __syncthreads();
}

__device__ __forceinline__ void resid_norm_rows(Frame& F) {
    const int gw = F.bid * NWAVES + F.wave, NGW = F.G * NWAVES;
    const float* ada = (const float*)(F.ws + WS_ADA); const float* g = F.in[23];
    const bf16_t* P0 = (const bf16_t*)(F.ws + WS_PART0); const bf16_t* P1 = (const bf16_t*)(F.ws + WS_PART1);
    bf16_t* H = (bf16_t*)(F.ws + WS_H);
    for (int mb = gw; mb < MTOK; mb += 2 * NGW) {
        f32x4 v[2][4]; u32x2 p0[2][4], p1[2][4];
#pragma unroll
        for (int r = 0; r < 2; ++r) { const int m = mb + r * NGW; if (m < MTOK) { const float* xr = F.xrow(m);
#pragma unroll
            for (int j = 0; j < 4; ++j) { const int c = 4 * F.lane + 256 * j; v[r][j] = *(const f32x4*)(xr + c); p0[r][j] = *(const u32x2*)(P0 + (size_t)m * DM + c); p1[r][j] = *(const u32x2*)(P1 + (size_t)m * DM + c); } } }
#pragma unroll
        for (int r = 0; r < 2; ++r) { const int m = mb + r * NGW; if (m >= MTOK) break;
            const float* ad = ada + cond_of(m) * 6144;
            f32x4 gg[4], sc[4], sh[4]; float s = 0.f;
#pragma unroll
            for (int j = 0; j < 4; ++j) { const int c = 4 * F.lane + 256 * j; const f32x4 gt = *(const f32x4*)(ad + 2048 + c); gg[j] = *(const f32x4*)(g + c); sc[j] = *(const f32x4*)(ad + 4096 + c); sh[j] = *(const f32x4*)(ad + 3072 + c);
                { const f32x4 ps = {bflo(p0[r][j].x) + bflo(p1[r][j].x), bfhi(p0[r][j].x) + bfhi(p1[r][j].x), bflo(p0[r][j].y) + bflo(p1[r][j].y), bfhi(p0[r][j].y) + bfhi(p1[r][j].y)}; v[r][j] = v[r][j] + gt * ps; }
                *(f32x4*)(F.out + (size_t)m * DM + c) = v[r][j];
                s += (v[r][j].x * v[r][j].x + v[r][j].y * v[r][j].y) + (v[r][j].z * v[r][j].z + v[r][j].w * v[r][j].w); }
            const float rinv = rsqrtf(wave_sum(s) * (1.f / DM) + EPS);
#pragma unroll
            for (int j = 0; j < 4; ++j) { const int c = 4 * F.lane + 256 * j;
                const f32x4 o = v[r][j] * rinv * gg[j] * (sc[j] + 1.f) + sh[j];
                u32x2 w; w.x = cvtpk(o[0], o[1]); w.y = cvtpk(o[2], o[3]);
                *(u32x2*)(H + (size_t)m * DM + c) = w; } }
    }
}
__device__ __forceinline__ void final_rows(Frame& F) {
    const float* ada = (const float*)(F.ws + WS_ADA);
    const bf16_t* P0 = (const bf16_t*)(F.ws + WS_PART0); const bf16_t* P1 = (const bf16_t*)(F.ws + WS_PART1);
    for (size_t i4 = (size_t)F.bid * NTHR + F.tid; i4 < (size_t)MTOK * DM / 4; i4 += (size_t)F.G * NTHR) {
        const int m = (int)(i4 >> 8), c = (int)(i4 & 255) * 4;
        const f32x4 gt = *(const f32x4*)(ada + cond_of(m) * 6144 + 5120 + c);
        const f32x4 x1 = *(const f32x4*)(F.out + i4 * 4); const u32x2 a = *(const u32x2*)(P0 + i4 * 4), b = *(const u32x2*)(P1 + i4 * 4);
        const f32x4 ps = {bflo(a.x) + bflo(b.x), bfhi(a.x) + bfhi(b.x), bflo(a.y) + bflo(b.y), bfhi(a.y) + bfhi(b.y)};
        *(f32x4*)(F.out + i4 * 4) = x1 + gt * ps;
    }
}

__device__ __forceinline__ void convgate_rows(Frame& F) {
    const bf16_t* U2 = (const bf16_t*)(F.ws + WS_U2); bf16_t* ACT = (bf16_t*)(F.ws + WS_ACT);
    const float* wc = F.in[25]; const float* bc = F.in[26];
    constexpr int NV8 = DFF / 8, RUN = 18, NRUN = (MTOK + RUN - 1) / RUN;
    for (int idx = F.bid * NTHR + F.tid; idx < NV8 * NRUN; idx += F.G * NTHR) {
        const int cg = idx % NV8, run = idx / NV8, c = cg * 8, m0 = run * RUN;
        float wa[3][8], wg[3][8], ba[8], bg[8];
#pragma unroll
        for (int j = 0; j < 3; ++j) { const f32x4 x0 = *(const f32x4*)(wc + j * NUP + c), x1 = *(const f32x4*)(wc + j * NUP + c + 4), y0 = *(const f32x4*)(wc + j * NUP + DFF + c), y1 = *(const f32x4*)(wc + j * NUP + DFF + c + 4);
#pragma unroll
            for (int e = 0; e < 4; ++e) { wa[j][e] = x0[e]; wa[j][4 + e] = x1[e]; wg[j][e] = y0[e]; wg[j][4 + e] = y1[e]; } }
        { const f32x4 x0 = *(const f32x4*)(bc + c), x1 = *(const f32x4*)(bc + c + 4), y0 = *(const f32x4*)(bc + DFF + c), y1 = *(const f32x4*)(bc + DFF + c + 4);
#pragma unroll
          for (int e = 0; e < 4; ++e) { ba[e] = x0[e]; ba[4 + e] = x1[e]; bg[e] = y0[e]; bg[4 + e] = y1[e]; } }
        const bf16_t* up = U2 + (size_t)m0 * NUP + c;
        auto ldrow = [&](int i, u32x4& a, u32x4& g) {
            const int m = m0 + i; const bool ok = m >= 0 && m < MTOK;
            a = ok ? *(const u32x4*)(up + (ptrdiff_t)i * NUP) : (u32x4){0u, 0u, 0u, 0u}; g = ok ? *(const u32x4*)(up + (ptrdiff_t)i * NUP + DFF) : (u32x4){0u, 0u, 0u, 0u}; };
        u32x4 ra[6], rg[6];
#pragma unroll
        for (int k = 0; k < 6; ++k) ldrow(k - 1, ra[k], rg[k]);
#pragma unroll
        for (int i = 0; i < RUN; ++i) {
            const int m = m0 + i;
            const bool first = m < NCTX ? (m & 255) == 0 : ((m - NCTX) & 1023) == 0, last = m < NCTX ? (m & 255) == 255 : ((m - NCTX) & 1023) == 1023;
            float pa[8], pg[8], ca[8], cg_[8], na[8], ng[8], o[8];
            unpack8(ra[i % 6], pa); unpack8(ra[(i + 1) % 6], ca); unpack8(ra[(i + 2) % 6], na); unpack8(rg[i % 6], pg); unpack8(rg[(i + 1) % 6], cg_); unpack8(rg[(i + 2) % 6], ng);
            if (i + 5 < RUN + 1) ldrow(i + 5, ra[i % 6], rg[i % 6]);
            const float fp = first ? 0.f : 1.f, fn = last ? 0.f : 1.f;
#pragma unroll
            for (int e = 0; e < 8; ++e) { const float a = ba[e] + fp * wa[0][e] * pa[e] + wa[1][e] * ca[e] + fn * wa[2][e] * na[e], g = bg[e] + fp * wg[0][e] * pg[e] + wg[1][e] * cg_[e] + fn * wg[2][e] * ng[e];
                o[e] = a * g * __builtin_amdgcn_rcpf(1.f + __expf(-g)); }
            if (m < MTOK) *(u32x4*)(ACT + (size_t)m * DFF + c) = pack8(o);
        }
    }
}

struct Args { const float* in[28]; float* out; unsigned char* ws; int ph_lo, ph_hi; };

__global__ void __launch_bounds__(NTHR, 2) fwd_kernel(Args args) {
    extern __shared__ __attribute__((aligned(16))) unsigned char lds_raw[];
    Frame F;
    F.lds = (LAS unsigned char*)lds_raw;
    F.tid = threadIdx.x; F.lane = F.tid & 63; F.wave = __builtin_amdgcn_readfirstlane(F.tid >> 6);
    F.G = gridDim.x; F.bid = blockIdx.x;
#pragma unroll
    for (int i = 0; i < 28; ++i) F.in[i] = args.in[i];
    F.out = args.out; F.ws = args.ws;
    const int lo = args.ph_lo, hi = args.ph_hi;
    const bool multi = (hi - lo) > 1;
    volatile LAS unsigned* MISC = (volatile LAS unsigned*)(F.lds + MISC_OFF);
    if (F.tid < 128) MISC[F.tid] = 0u;
    __syncthreads();
    XcdBarrier bar; bar.bar = (unsigned*)(F.ws + WS_CTL) + 4096; bar.x = 0; bar.st = MISC + 8;
    if (multi) bar = xcd_barrier_post((unsigned*)(F.ws + WS_CTL) + 4096, MISC + 8);
#define IN(k) (lo <= (k) && (k) < hi)
#define REP(k) for (int rep_ = 0; rep_ < (((REP_MASK) >> (k)) & 1u ? 2 : 1); ++rep_)
    int bar_idx = 0;
    if (PROBE_IDX && F.tid == 0) MISC[16] = (unsigned)__builtin_amdgcn_s_memrealtime();
#define LAP(id) do { if (PROBE_IDX < 0 && F.tid == 0) MISC[16 + (id)] = (unsigned)__builtin_amdgcn_s_memrealtime(); } while (0)
#define GRID_BAR() do { if (multi) xcd_barrier(bar); if (PROBE_IDX) { ++bar_idx; if (F.tid == 0 && bar_idx < 40) MISC[16 + bar_idx] = (unsigned)__builtin_amdgcn_s_memrealtime(); } } while (0)

    if (IN(0)) { p0_prologue(F); GRID_BAR(); }
    if (IN(1)) { norm_rows<false>(F, F.in[10], 0, 1024); GRID_BAR(); }
    if (IN(2)) {
        pg8::StaticOrder S; S.init(F.ws + WS_H, F.ws + WS_WIN, MTOK, NU + 256, DM, DM, F.G, F.bid);
        pg8::EpiBf16 E{(bf16_t*)(F.ws + WS_U), NU, nullptr, (bf16_t*)(F.ws + WS_GATE), 12, (float*)(F.ws + WS_Z), 20};
        LAP(30); pg8::gemm_phase(F.lds, DM, DM, DM, S, E);
        LAP(31);
        LAP(32); GRID_BAR(); LAP(33);
    }
    if (IN(3)) {
        LAP(40); if (F.G == 256) { gla_pass1_item(F, F.bid); LAP(41); if (F.bid < 128) gla_pass1_item(F, 256 + F.bid); else attn_ctx_unit(F, F.bid - 128); LAP(42); }
        else { for (int it = F.bid; it < 384; it += F.G) gla_pass1_item(F, it); for (int u = F.bid; u < 128; u += F.G) attn_ctx_unit(F, u); }
        for (int c = F.bid; c < 256; c += F.G) kvout_rows(F, 16 * c, 16);
        LAP(43); GRID_BAR(); LAP(44);
    }
    if (IN(4)) {
        for (int c = F.bid; c < 144; c += F.G) gla_scan_chain(F, c);
        LAP(45); for (int u = F.bid; u < 256; u += F.G) attn_lat_unit(F, u);
        LAP(46); GRID_BAR(); LAP(47);
    }
    if (IN(5)) { for (int it = F.bid; it < 384; it += F.G) { gla_pass2_item(F, it); LAP(48 + (it >= 256)); } GRID_BAR(); LAP(50); }
    if (IN(6)) {
        pg8::DualOrder S; S.init(F.ws + WS_OG, F.ws + WS_WGO, F.ws + WS_ON, F.ws + WS_WNO, MTOK, DM, 512, 512, F.G, F.bid);
        pg8::EpiGate E{(const bf16_t*)(F.ws + WS_GATE), (bf16_t*)(F.ws + WS_MIX), (bf16_t*)(F.ws + WS_MIXN)};
        pg8::gemm_phase(F.lds, 512, 512, 512, S, E);
        if (F.G == 256 && F.bid >= 192) p0_transposes(F, I_EARLY, I_LATE, (F.bid - 192) * NWAVES + F.wave, 64 * NWAVES);
        GRID_BAR();
    }
    if (IN(7)) {
        pg8::DualOrder S; S.init(F.ws + WS_MIX, F.ws + WS_WOUT, F.ws + WS_MIXN, F.ws + WS_WOUT, MTOK, DM, DM, DM, F.G, F.bid);
        pg8::EpiBf16 E{(bf16_t*)(F.ws + WS_PART0), DM, (bf16_t*)(F.ws + WS_PART1), nullptr, 1 << 30, nullptr, -1};
        pg8::gemm_phase(F.lds, DM, DM, DM, S, E);
        GRID_BAR();
    }
    if (IN(8)) { resid_norm_rows(F); GRID_BAR(); }
    if (IN(9)) {
        pg8::StaticOrder S; S.init(F.ws + WS_H, F.ws + WS_WUP, MTOK, NUP, DM, DM, F.G, F.bid);
        pg8::EpiBf16 E{(bf16_t*)(F.ws + WS_U2), NUP, nullptr, nullptr, 1 << 30, nullptr, -1};
        pg8::gemm_phase(F.lds, DM, DM, DM, S, E);
        GRID_BAR();
    }
    if (IN(10)) { convgate_rows(F); GRID_BAR(); }
    if (IN(11)) {
        pg8::DualOrder S; S.init(F.ws + WS_ACT, F.ws + WS_WDN, F.ws + WS_ACT + 1408 * 2, F.ws + WS_WDN + 1408 * 2, MTOK, DM, DFF, DFF, F.G, F.bid);
        pg8::EpiBf16 E{(bf16_t*)(F.ws + WS_PART0), DM, (bf16_t*)(F.ws + WS_PART1), nullptr, 1 << 30, nullptr, -1};
        pg8::gemm_phase(F.lds, 1408, DFF, DFF, S, E);
        GRID_BAR();
    }
    if (IN(12)) { final_rows(F); }
    if (PROBE_IDX > 0) { GRID_BAR(); if (F.bid == 0 && F.tid == 0) { const unsigned dt = MISC[16 + PROBE_IDX] - MISC[16 + PROBE_IDX - 1]; F.out[0] += (float)dt * 0.001f; } }
    if (PROBE_IDX < 0) { GRID_BAR(); if (F.bid == PROBE_BLOCK && F.tid == 0) { const unsigned dt = MISC[16 + PROBE_B] - MISC[16 + PROBE_A]; F.out[0] += (float)dt * 0.001f; } }
#undef IN
}

#ifndef FUSED_MASK
#define FUSED_MASK 0xFFFu
#endif
constexpr unsigned FUSED = FUSED_MASK;
constexpr size_t WS_ADEC = 168 * MiB, WS_OT = 181 * MiB, WS_BN = 72 * MiB;

extern "C" void kernel_launch(void* const* d_in, const int* in_sizes, int n_in, void* d_out, int out_size, void* d_ws, size_t ws_size, hipStream_t stream) {
    static int grid = 0;
    if (grid == 0) {
        if (n_in != 28 || ws_size < WS_END) { fprintf(stderr, "kernel_launch: unexpected n_in %d / ws %zu\n", n_in, ws_size); grid = -1; return; }
        int dev = 0, cus = 0, per_cu = 0;
        (void)hipGetDevice(&dev);
        (void)hipDeviceGetAttribute(&cus, hipDeviceAttributeMultiprocessorCount, dev);
        (void)hipFuncSetAttribute((const void*)fwd_kernel, hipFuncAttributeMaxDynamicSharedMemorySize, LDS_BYTES);
        (void)hipOccupancyMaxActiveBlocksPerMultiprocessor(&per_cu, (const void*)fwd_kernel, NTHR, LDS_BYTES);
        (void)hipGetLastError();
        if (per_cu < 1) { fprintf(stderr, "kernel_launch: occupancy query reports 0 workgroups per CU\n"); grid = -1; return; }
        grid = cus;
        if (grid > 256) grid = 256;
    }
    if (grid < 0) return;
    (void)hipMemsetAsync((char*)d_ws + WS_CTL, 0, CTL_BYTES, stream);
    Args a{};
    for (int i = 0; i < 28; ++i) a.in[i] = (const float*)d_in[i];
    a.out = (float*)d_out; a.ws = (unsigned char*)d_ws;
    if (ONE_LAUNCH) {
        a.ph_lo = 0; a.ph_hi = 13;
        void* kargs[] = {&a};
        hipError_t e = hipLaunchCooperativeKernel((const void*)fwd_kernel, dim3(grid), dim3(NTHR), kargs, LDS_BYTES, stream);
        if (e != hipSuccess) fprintf(stderr, "kernel_launch: cooperative launch failed: %s (grid %d)\n", hipGetErrorString(e), grid);
        return;
    }
    for (int p = 0; p < 13; ++p) { a.ph_lo = p; a.ph_hi = p + 1; hipLaunchKernelGGL(fwd_kernel, dim3(grid), dim3(NTHR), LDS_BYTES, stream, a); }
}
```

```cpp
#include <hip/hip_runtime.h>
#include <cstdio>
#include <cstdint>

#ifndef PROBE_IDX
#define PROBE_IDX 0
#endif
#ifndef PROBE_A
#define PROBE_A 0
#endif
#ifndef PROBE_B
#define PROBE_B 0
#endif
#ifndef PROBE_BLOCK
#define PROBE_BLOCK 0
#endif
#ifndef PROBE_SPLIT
#define PROBE_SPLIT 0
#endif
#ifndef HOST_REP
#define HOST_REP -1
#endif
#ifndef REP_MASK
#define REP_MASK 0u
#endif
#ifndef ONE_LAUNCH
#define ONE_LAUNCH 1
#endif

#define LAS __attribute__((address_space(3)))
#define GAS __attribute__((address_space(1)))
typedef unsigned short bf16_t;
typedef short bf16x8 __attribute__((ext_vector_type(8)));
typedef short s16x4 __attribute__((ext_vector_type(4)));
typedef float f32x2 __attribute__((ext_vector_type(2)));
typedef float f32x4 __attribute__((ext_vector_type(4)));
typedef float f32x16 __attribute__((ext_vector_type(16)));
typedef unsigned u32x2 __attribute__((ext_vector_type(2)));
typedef unsigned u32x4 __attribute__((ext_vector_type(4)));
typedef __bf16 bf16x2_t __attribute__((ext_vector_type(2)));

constexpr int DM = 1024, NCTX = 4096, NLAT = 2048, MTOK = 6144, DIN = 5152, NU = 5120, DFF = 2816, NUP = 5632;
constexpr int UQ = 0, UK = 256, UV = 512, UR = 1024, UNQ = 1536, UNK = 2048, UNV = 2560, UMG = 3072, UMN = 4096;
constexpr float EPS = 1e-6f;
constexpr float LOG2E = 1.4426950408889634f;
constexpr size_t O_YP = 0, O_YS = 4194304, O_NK = 6291456, O_NV = 8388608, O_SF = 10485760, O_SB = 11010048;
constexpr size_t MiB = 1u << 20;
constexpr size_t WS_CTL = 0, CTL_BYTES = 1 * MiB;
constexpr size_t WS_ADA = 1 * MiB;
constexpr size_t WS_WGO = 2 * MiB;
constexpr size_t WS_WIN = 3 * MiB;
constexpr size_t WS_WZT = 13 * MiB;
constexpr size_t WS_WNO = 14 * MiB;
constexpr size_t WS_WOUT = 15 * MiB;
constexpr size_t WS_WUP = 17 * MiB;
constexpr size_t WS_WDN = 28 * MiB;
constexpr size_t WS_H = 34 * MiB;
constexpr size_t WS_Z = 46 * MiB;
constexpr size_t WS_OG = 47 * MiB;
constexpr size_t WS_ON = 53 * MiB;
constexpr size_t WS_DEC = 59 * MiB;
constexpr size_t WS_QK = 60 * MiB;
constexpr size_t WS_KV = 72 * MiB;
constexpr size_t WS_SS = 84 * MiB;
constexpr size_t WS_MIX = 96 * MiB;
constexpr size_t WS_U = 108 * MiB;
constexpr size_t WS_U2 = 168 * MiB;
constexpr size_t WS_ACT = 108 * MiB;
constexpr size_t WS_PART0 = 205 * MiB, WS_PART1 = 181 * MiB;
constexpr size_t WS_MIXN = 72 * MiB;
constexpr size_t WS_BG = 205 * MiB;
constexpr size_t WS_GATE = 229 * MiB;
constexpr size_t WS_END = 253 * MiB;

constexpr int NWAVES = 8, NTHR = 512;
constexpr int LDS_BYTES = 147456;
constexpr int RING_BYTES = 131072;
constexpr int MISC_OFF = RING_BYTES + 12288;

__device__ __forceinline__ unsigned cvtpk(float lo, float hi) { f32x2 v = {lo, hi}; bf16x2_t b = __builtin_convertvector(v, bf16x2_t); return __builtin_bit_cast(unsigned, b); }
__device__ __forceinline__ float bflo(unsigned u) { return __uint_as_float(u << 16); }
__device__ __forceinline__ float bfhi(unsigned u) { return __uint_as_float(u & 0xffff0000u); }
__device__ __forceinline__ float wave_sum(float v) {
#pragma unroll
    for (int o = 1; o < 64; o <<= 1) v += __shfl_xor(v, o);
    return v;
}
__device__ __forceinline__ float sigmoidf_(float x) { return __builtin_amdgcn_rcpf(1.f + __builtin_amdgcn_exp2f(-LOG2E * x)); }
__device__ __forceinline__ float siluf_(float x) { return x * __builtin_amdgcn_rcpf(1.f + __builtin_amdgcn_exp2f(-LOG2E * x)); }
__device__ __forceinline__ int lane_id() { return (int)__builtin_amdgcn_mbcnt_hi(~0u, __builtin_amdgcn_mbcnt_lo(~0u, 0u)); }
__device__ __forceinline__ int crow(int r, int hi) { return (r & 3) + 8 * (r >> 2) + 4 * hi; }
__device__ __forceinline__ s16x4 vtr(const LAS void* p) { typedef short v4i16_t __attribute__((ext_vector_type(4))); return __builtin_bit_cast(s16x4, __builtin_amdgcn_ds_read_tr16_b64_v4i16((LAS v4i16_t*)p)); }
__device__ __forceinline__ bf16x8 cat8(s16x4 lo, s16x4 hi) { return (bf16x8){lo[0], lo[1], lo[2], lo[3], hi[0], hi[1], hi[2], hi[3]}; }
__device__ __forceinline__ void unpack8(u32x4 v, float (&f)[8]) { f[0] = bflo(v.x); f[1] = bfhi(v.x); f[2] = bflo(v.y); f[3] = bfhi(v.y); f[4] = bflo(v.z); f[5] = bfhi(v.z); f[6] = bflo(v.w); f[7] = bfhi(v.w); }
__device__ __forceinline__ u32x4 pack8(const float (&f)[8]) { u32x4 v; v.x = cvtpk(f[0], f[1]); v.y = cvtpk(f[2], f[3]); v.z = cvtpk(f[4], f[5]); v.w = cvtpk(f[6], f[7]); return v; }

namespace pg8 {
constexpr int BM = 256, BK = 64, HALF = 128, HTB = HALF * BK * 2, STAGE_BYTES = 8 * HTB, NXCD = 8, WGM = 8;
__host__ __device__ __forceinline__ int lds_byte(int r, int c) { const int st = (r >> 4) * 2 + (c >> 5), rr = r & 15, cc = c & 31, ob = rr * 64 + cc * 2; return st * 1024 + (ob ^ (((ob >> 9) & 1) << 5)); }
__host__ __device__ __forceinline__ void stage_rc(int b, int& R, int& C) { const int st = b / 1024, sb = b % 1024, swz = sb ^ (((sb >> 9) & 1) << 5); R = (st >> 1) * 16 + swz / 64; C = (st & 1) * 32 + (swz % 64) / 2; }
__host__ __device__ __forceinline__ int perm32(int rho) { const int n = rho >> 4, i = rho & 15; return 8 * (i >> 2) + 4 * n + (i & 3); }

struct Unit { int pm, pn; const char* A; const char* B; int aux; };
__device__ __forceinline__ const char* uptr(const char* p) { const unsigned long long v = (unsigned long long)p; const unsigned lo = __builtin_amdgcn_readfirstlane((unsigned)v), hi = __builtin_amdgcn_readfirstlane((unsigned)(v >> 32)); return (const char*)(((unsigned long long)hi << 32) | lo); }

struct StaticOrder {
    int nM, nN, nwg, G, c; const char* Ab; const char* Bb; size_t tstepA, tstepB;
    __device__ void init(const void* A, const void* Bt, int M, int N, int lda, int ldb, int G_, int c_) { nM = M / BM; nN = N / BM; nwg = nM * nN; G = G_; c = c_; Ab = (const char*)A; Bb = (const char*)Bt; tstepA = (size_t)BM * lda * 2; tstepB = (size_t)BM * ldb * 2; }
    __device__ bool next(int i, Unit& u) const {
        const long L = (long)i * G + c; if (L >= nwg) return false;
        int wgid = (int)L; { const int q = nwg / NXCD, r = nwg % NXCD, xcd = wgid % NXCD, off = wgid / NXCD; wgid = (xcd < r ? xcd * (q + 1) : r * (q + 1) + (xcd - r) * q) + off; }
        const int nig = WGM * nN, gid = wgid / nig, fm = gid * WGM, gsz = (nM - fm) < WGM ? (nM - fm) : WGM;
        u.pm = fm + ((wgid % nig) % gsz); u.pn = (wgid % nig) / gsz; u.A = Ab + (size_t)u.pm * tstepA; u.B = Bb + (size_t)u.pn * tstepB; u.aux = 0; return true;
    }
};
struct UpOrder {
    int c; const char* Ab; const char* Bb; size_t tstepA, tstepB;
    __device__ void init(const void* A, const void* Bt, int lda, int ldb, int c_) { c = c_; Ab = (const char*)A; Bb = (const char*)Bt; tstepA = (size_t)BM * lda * 2; tstepB = (size_t)BM * ldb * 2; }
    __device__ bool next(int i, Unit& u) const {
        const int x = c & 7, off = (c >> 3) + 32 * i; if (off >= 66) return false;
        if (off < 22) { u.pm = 16 + x; u.pn = off; } else { const int o2 = off - 22; u.pm = 2 * x + o2 / 22; u.pn = o2 % 22; }
        u.A = Ab + (size_t)u.pm * tstepA; u.B = Bb + (size_t)u.pn * tstepB; u.aux = 0; return true;
    }
};
struct DualOrder {
    int nM, nN, nwg, G, c; const char *A0, *B0, *A1, *B1; size_t tstepA, tstepB;
    __device__ void init(const void* a0, const void* b0, const void* a1, const void* b1, int M, int N, int lda, int ldb, int G_, int c_) { nM = M / BM; nN = N / BM; nwg = nM * nN; G = G_; c = c_;
        A0 = (const char*)a0; B0 = (const char*)b0; A1 = (const char*)a1; B1 = (const char*)b1; tstepA = (size_t)BM * lda * 2; tstepB = (size_t)BM * ldb * 2; }
    __device__ bool next(int i, Unit& u) const {
        int t, aux;
        if (G == 256 && nM == 24 && nN == 4) {
            if (i > 0) return false;
            const int x = c & 7, j = c >> 3; if (j >= 24) return false;
            u.pm = 3 * x + (j >> 3); u.pn = (j & 7) >> 1; aux = j & 1;
        } else {
            const long L = (long)i * G + c; if (L >= 2 * nwg) return false;
            t = (int)(L >> 1); aux = (int)(L & 1); u.pm = t / nN; u.pn = t % nN;
        }
        u.aux = aux;
        u.A = (aux ? A1 : A0) + (size_t)u.pm * tstepA; u.B = (aux ? B1 : B0) + (size_t)u.pn * tstepB; return true;
    }
};

struct EpiBf16 {
    static constexpr bool PERM = true;
    bf16_t* O; int ldc;
    bf16_t* O1; bf16_t* G; int gate_pn0;
    float* Zo; int z_pn;
    __device__ __forceinline__ void operator()(const f32x4 (&acc)[2][2][4][2], const Unit& u, int wr, int wc, int fr, int fq) const {
        if (u.pn == z_pn) {
            if (wc == 0) { float* zp = Zo + (size_t)(u.pm * BM + wr * 64 + fr) * 32 + 8 * fq;
#pragma unroll
                for (int ai = 0; ai < 2; ++ai)
#pragma unroll
                    for (int m = 0; m < 4; ++m) { *(f32x4*)(zp + (ai * HALF + m * 16) * 32) = acc[ai][0][m][0]; *(f32x4*)(zp + (ai * HALF + m * 16) * 32 + 4) = acc[ai][0][m][1]; } }
            return;
        }
        if (u.pn >= gate_pn0) {
            bf16_t* gp = G + ((size_t)(u.pm * 8 + (u.pn - gate_pn0)) << 16) + ((wr * 4 + wc) * 64 + fq * 16 + fr) * 8;
#pragma unroll
            for (int ai = 0; ai < 2; ++ai)
#pragma unroll
                for (int m = 0; m < 4; ++m)
#pragma unroll
                    for (int bj = 0; bj < 2; ++bj) { const f32x4 v0 = acc[ai][bj][m][0], v1 = acc[ai][bj][m][1];
                        u32x4 w; w.x = cvtpk(sigmoidf_(v0[0]), sigmoidf_(v0[1])); w.y = cvtpk(sigmoidf_(v0[2]), sigmoidf_(v0[3])); w.z = cvtpk(sigmoidf_(v1[0]), sigmoidf_(v1[1])); w.w = cvtpk(sigmoidf_(v1[2]), sigmoidf_(v1[3]));
                        *(u32x4*)(gp + ((ai * 4 + m) * 2 + bj) * 4096) = w; }
            return;
        }
        bf16_t* Ob = u.aux ? O1 : O;
        const int row0 = u.pm * BM + wr * 64 + fr, col0 = u.pn * BM + wc * 32 + 8 * fq;
#pragma unroll
        for (int ai = 0; ai < 2; ++ai)
#pragma unroll
            for (int m = 0; m < 4; ++m) { bf16_t* rowp = Ob + (size_t)(row0 + ai * HALF + m * 16) * ldc + col0;
#pragma unroll
                for (int bj = 0; bj < 2; ++bj) { const f32x4 v0 = acc[ai][bj][m][0], v1 = acc[ai][bj][m][1];
                    u32x4 w; w.x = cvtpk(v0[0], v0[1]); w.y = cvtpk(v0[2], v0[3]); w.z = cvtpk(v1[0], v1[1]); w.w = cvtpk(v1[2], v1[3]);
                    *(u32x4*)(rowp + bj * HALF) = w; } }
    }
};
struct EpiPart {
    static constexpr bool PERM = false;
    float* P0; float* P1; int ldc;
    __device__ __forceinline__ void operator()(const f32x4 (&acc)[2][2][4][2], const Unit& u, int wr, int wc, int fr, int fq) const {
        float* P = u.aux ? P1 : P0; const int row0 = u.pm * BM + wr * 64 + fr, col0 = u.pn * BM + wc * 32 + 4 * fq;
#pragma unroll
        for (int ai = 0; ai < 2; ++ai)
#pragma unroll
            for (int m = 0; m < 4; ++m) { float* rowp = P + (size_t)(row0 + ai * HALF + m * 16) * ldc + col0;
#pragma unroll
                for (int bj = 0; bj < 2; ++bj)
#pragma unroll
                    for (int n = 0; n < 2; ++n) *(f32x4*)(rowp + bj * HALF + n * 16) = acc[ai][bj][m][n]; }
    }
};
struct EpiGate {
    static constexpr bool PERM = true;
    const bf16_t* G; bf16_t* O0; bf16_t* O1;
    __device__ __forceinline__ void operator()(const f32x4 (&acc)[2][2][4][2], const Unit& u, int wr, int wc, int fr, int fq) const {
        const int row0 = u.pm * BM + wr * 64 + fr, col0 = u.pn * BM + wc * 32 + 8 * fq;
        const bf16_t* gp = G + ((size_t)(u.pm * 8 + u.aux * 4 + u.pn) << 16) + ((wr * 4 + wc) * 64 + fq * 16 + fr) * 8;
        bf16_t* Ob = u.aux ? O1 : O0;
#pragma unroll
        for (int ai = 0; ai < 2; ++ai)
#pragma unroll
            for (int m = 0; m < 4; ++m) { bf16_t* rowp = Ob + (size_t)(row0 + ai * HALF + m * 16) * DM + col0;
#pragma unroll
                for (int bj = 0; bj < 2; ++bj) { const u32x4 nn = *(const u32x4*)(gp + ((ai * 4 + m) * 2 + bj) * 4096); const unsigned nw[4] = {nn.x, nn.y, nn.z, nn.w};
                    u32x4 w;
                    w.x = cvtpk(acc[ai][bj][m][0][0] * bflo(nw[0]), acc[ai][bj][m][0][1] * bfhi(nw[0])); w.y = cvtpk(acc[ai][bj][m][0][2] * bflo(nw[1]), acc[ai][bj][m][0][3] * bfhi(nw[1]));
                    w.z = cvtpk(acc[ai][bj][m][1][0] * bflo(nw[2]), acc[ai][bj][m][1][1] * bfhi(nw[2])); w.w = cvtpk(acc[ai][bj][m][1][2] * bflo(nw[3]), acc[ai][bj][m][1][3] * bfhi(nw[3]));
                    *(u32x4*)(rowp + bj * HALF) = w; } }
    }
};

struct EpiConv {
    static constexpr bool PERM = true;
    bf16_t* U2; bf16_t* ACT; const float* wcv; const float* bcv; LAS float* edge;
    unsigned* cnt;
    __device__ __forceinline__ void operator()(const f32x4 (&acc)[2][2][4][2], const Unit& u, int wr, int wc, int fr, int fq) const {
        const int row0 = u.pm * BM + wr * 64 + fr, col0 = u.pn * BM + wc * 32 + 8 * fq;
        if (u.pm >= 16) {
#pragma unroll
            for (int ai = 0; ai < 2; ++ai)
#pragma unroll
                for (int m = 0; m < 4; ++m) { bf16_t* rowp = U2 + (size_t)(row0 + ai * HALF + m * 16) * NUP + col0;
#pragma unroll
                    for (int bj = 0; bj < 2; ++bj) { const f32x4 v0 = acc[ai][bj][m][0], v1 = acc[ai][bj][m][1];
                        const unsigned long long lo = (unsigned long long)cvtpk(v0[0], v0[1]) | ((unsigned long long)cvtpk(v0[2], v0[3]) << 32), hi = (unsigned long long)cvtpk(v1[0], v1[1]) | ((unsigned long long)cvtpk(v1[2], v1[3]) << 32);
                        __hip_atomic_store((unsigned long long*)(rowp + bj * HALF), lo, __ATOMIC_RELAXED, __HIP_MEMORY_SCOPE_AGENT);
                        __hip_atomic_store((unsigned long long*)(rowp + bj * HALF + 4), hi, __ATOMIC_RELAXED, __HIP_MEMORY_SCOPE_AGENT); } }
            asm volatile("s_waitcnt vmcnt(0)" ::: "memory");
            if (fr == 0 && fq == 0) __hip_atomic_fetch_add(cnt, 1u, __ATOMIC_RELAXED, __HIP_MEMORY_SCOPE_AGENT);
            return;
        }
        LAS float* W4 = edge + 2048;
        { int t_ = (wr * 4 + wc) * 64 + fq * 16 + fr; asm volatile("" : "+v"(t_)); if (t_ < 256) { const int cw = (t_ >> 7) * DFF + u.pn * HALF + (t_ & 127); *(LAS f32x4*)(W4 + 4 * t_) = (f32x4){wcv[cw], wcv[NUP + cw], wcv[2 * NUP + cw], bcv[cw]}; } }
#pragma unroll
        for (int ai = 0; ai < 2; ++ai) { const int seg = 2 * ai + wr;
            if (fr == 0 || fr == 15) { LAS float* ep = edge + ((wc * 4 + seg) * 2 + (fr == 15 ? 1 : 0)) * 64 + 8 * fq;
#pragma unroll
                for (int bj = 0; bj < 2; ++bj) { *(LAS f32x4*)(ep + bj * 32) = fr == 15 ? acc[ai][bj][3][0] : acc[ai][bj][0][0]; *(LAS f32x4*)(ep + bj * 32 + 4) = fr == 15 ? acc[ai][bj][3][1] : acc[ai][bj][0][1]; } } }
        asm volatile("s_waitcnt vmcnt(0) lgkmcnt(0)" ::: "memory"); __builtin_amdgcn_s_barrier(); asm volatile("" ::: "memory");
        const int ch0 = u.pn * HALF + wc * 32 + 8 * fq;
#define DPPF(oldv, srcv, ctrl) __builtin_bit_cast(float, __builtin_amdgcn_update_dpp(__builtin_bit_cast(int, (float)(oldv)), __builtin_bit_cast(int, (float)(srcv)), (ctrl), 0xf, 0xf, false))
#define CONV_EL(AI, M, BJ, N, E, DST) { const f32x4 w_ = *(const LAS f32x4*)(W4 + 4 * ((BJ) * 128 + wc * 32 + 8 * fq + 4 * (N) + (E))); const int slot_ = (BJ) * 32 + 8 * fq + 4 * (N) + (E); \
            const float upo_ = (M) > 0 ? DPPF(0.f, acc[AI][BJ][(M) > 0 ? (M) - 1 : 0][N][E], 0x121) : (seg_ > 0 ? edge[((wc * 4 + seg_ - 1) * 2 + 1) * 64 + slot_] : 0.f); \
            const float dno_ = (M) < 3 ? DPPF(0.f, acc[AI][BJ][(M) < 3 ? (M) + 1 : 3][N][E], 0x12F) : (seg_ < 3 ? edge[((wc * 4 + seg_ + 1) * 2 + 0) * 64 + slot_] : 0.f); \
            const float cur_ = acc[AI][BJ][M][N][E]; const float up_ = DPPF(upo_, cur_, 0x111), dn_ = DPPF(dno_, cur_, 0x101); \
            DST = w_[3] + w_[0] * up_ + w_[1] * cur_ + w_[2] * dn_; }
#define CONV_PAIR(AI, M, N, E, DST) { float a__, g__; CONV_EL(AI, M, 0, N, E, a__) CONV_EL(AI, M, 1, N, E, g__) DST = a__ * siluf_(g__); }
#define CONV_GROUP(AI, M) { const int seg_ = 2 * (AI) + wr; float o0_, o1_; u32x4 w; \
            CONV_PAIR(AI, M, 0, 0, o0_) CONV_PAIR(AI, M, 0, 1, o1_) w.x = cvtpk(o0_, o1_); asm volatile("" ::: "memory"); CONV_PAIR(AI, M, 0, 2, o0_) CONV_PAIR(AI, M, 0, 3, o1_) w.y = cvtpk(o0_, o1_); asm volatile("" ::: "memory"); \
            CONV_PAIR(AI, M, 1, 0, o0_) CONV_PAIR(AI, M, 1, 1, o1_) w.z = cvtpk(o0_, o1_); asm volatile("" ::: "memory"); CONV_PAIR(AI, M, 1, 2, o0_) CONV_PAIR(AI, M, 1, 3, o1_) w.w = cvtpk(o0_, o1_); \
            *(u32x4*)(ACT + (size_t)(row0 + (AI) * HALF + (M) * 16) * DFF + ch0) = w; asm volatile("" ::: "memory"); }
        CONV_GROUP(0, 0) CONV_GROUP(0, 1) CONV_GROUP(0, 2) CONV_GROUP(0, 3) CONV_GROUP(1, 0) CONV_GROUP(1, 1) CONV_GROUP(1, 2) CONV_GROUP(1, 3)
#undef CONV_GROUP
#undef CONV_PAIR
#undef CONV_EL
#undef DPPF
    }
};

template <class Epi, class Sched>
__device__ __forceinline__ void gemm_phase(LAS unsigned char* lds, const int wid, const int K, const int lda, const int ldb, const Sched& S, const Epi& E) {
    const int nt = K / BK;
    int wr, wc, fr, fq; unsigned voffA[2], voffB[2], ldsw; int aoff, boff;
#define PG8_LANE_SETUP() do { int lane = lane_id(); asm volatile("" : "+v"(lane)); const int tid = wid * 64 + lane; wr = wid >> 2; wc = wid & 3; fr = lane & 15; fq = lane >> 4; \
        _Pragma("unroll") for (int i = 0; i < 2; ++i) { int R, C; stage_rc(tid * 16 + i * 8192, R, C); const int Rb = Epi::PERM ? ((R & ~31) + perm32(R & 31)) : R; \
            voffA[i] = (unsigned)(R * lda + C) * 2u; voffB[i] = (unsigned)(Rb * ldb + C) * 2u; } \
        ldsw = (unsigned)wid * 1024u; aoff = lds_byte(wr * 64 + fr, fq * 8); boff = lds_byte(wc * 32 + fr, fq * 8); } while (0)
    PG8_LANE_SETUP();
    const size_t kstep = (size_t)(BK * 2);
    const size_t hstepA = (size_t)HALF * lda * 2, hstepB = (size_t)HALF * ldb * 2;
#define PG8_SA(b, h) (((b) * 2 + (h)) * HTB)
#define PG8_SB(b, h) ((4 + (b) * 2 + (h)) * HTB)
#define PG8_STAGE(bufoff, gbase, voff) do { _Pragma("unroll") for (int _i = 0; _i < 2; ++_i) \
        __builtin_amdgcn_global_load_lds((const unsigned*)((const char*)(gbase) + (voff)[_i]), (LAS unsigned*)(lds + (bufoff) + ldsw + _i * 8192), 16, 0, 0); } while (0)
#define PG8_LDA(dst, b, h) do { _Pragma("unroll") for (int m = 0; m < 4; ++m) _Pragma("unroll") for (int k = 0; k < 2; ++k) dst[m][k] = *(const LAS bf16x8*)(lds + PG8_SA(b, h) + aoff + m * 2048 + k * 1024); } while (0)
#define PG8_LDB(dst, b, h) do { _Pragma("unroll") for (int n = 0; n < 2; ++n) _Pragma("unroll") for (int k = 0; k < 2; ++k) dst[n][k] = *(const LAS bf16x8*)(lds + PG8_SB(b, h) + boff + n * 2048 + k * 1024); } while (0)
#define PG8_MMA(ai, bj, At, Bt) do { __builtin_amdgcn_s_setprio(1); _Pragma("unroll") for (int m = 0; m < 4; ++m) _Pragma("unroll") for (int n = 0; n < 2; ++n) _Pragma("unroll") for (int k = 0; k < 2; ++k) \
        acc[ai][bj][m][n] = __builtin_amdgcn_mfma_f32_16x16x32_bf16(Bt[n][k], At[m][k], acc[ai][bj][m][n], 0, 0, 0); __builtin_amdgcn_s_setprio(0); } while (0)
#define PG8_WAIT_V(n) asm volatile("s_waitcnt vmcnt(" #n ")" ::: "memory")
#define PG8_WAIT_L(n) asm volatile("s_waitcnt lgkmcnt(" #n ")" ::: "memory")
#define PG8_BAR __builtin_amdgcn_s_barrier()
#define PG8_SCHED __builtin_amdgcn_sched_barrier(0)
    Unit cur, nxt; int ui = 0;
    if (!S.next(0, cur)) return;
    f32x4 acc[2][2][4][2];
#pragma unroll
    for (int a = 0; a < 2; ++a)
#pragma unroll
        for (int b = 0; b < 2; ++b)
#pragma unroll
            for (int m = 0; m < 4; ++m)
#pragma unroll
                for (int n = 0; n < 2; ++n) acc[a][b][m][n] = (f32x4){0.f, 0.f, 0.f, 0.f};
    bf16x8 At[4][2], B0[2][2], B1[2][2];
    const char* cA = uptr(cur.A); const char* cB = uptr(cur.B);
    PG8_STAGE(PG8_SB(0, 0), cB, voffB); PG8_STAGE(PG8_SB(0, 1), cB + hstepB, voffB); PG8_STAGE(PG8_SA(0, 0), cA, voffA); PG8_STAGE(PG8_SA(0, 1), cA + hstepA, voffA);
    if (wr == 1) PG8_BAR;
    PG8_WAIT_V(2); PG8_BAR;
    PG8_STAGE(PG8_SB(1, 0), cB + kstep, voffB); PG8_STAGE(PG8_SA(1, 0), cA + kstep, voffA); PG8_STAGE(PG8_SB(1, 1), cB + hstepB + kstep, voffB);
    PG8_WAIT_V(6); PG8_BAR;
    for (;;) {
        if (ui > 0) PG8_LANE_SETUP();
        const bool has_next = S.next(ui + 1, nxt);
        const char* nA = uptr(has_next ? nxt.A : cA); const char* nB = uptr(has_next ? nxt.B : cB);
        for (int t = 0; t < nt; t += 2) {
            const bool last = (t == nt - 2);
            const char* a1 = cA + (size_t)(t + 1) * kstep;
            const char* a2 = last ? nA : cA + (size_t)(t + 2) * kstep; const char* b2 = last ? nB : cB + (size_t)(t + 2) * kstep;
            const char* a3 = a2 + kstep; const char* b3 = b2 + kstep;
            PG8_LDB(B0, 0, 0); PG8_LDB(B1, 0, 1); PG8_SCHED; PG8_LDA(At, 0, 0); PG8_STAGE(PG8_SA(1, 1), a1 + hstepA, voffA);
            PG8_WAIT_V(8); PG8_WAIT_L(0); PG8_BAR; PG8_MMA(0, 0, At, B0); PG8_MMA(0, 1, At, B1); PG8_BAR; PG8_SCHED;
            PG8_LDA(At, 0, 1); PG8_STAGE(PG8_SB(0, 0), b2, voffB); PG8_STAGE(PG8_SB(0, 1), b2 + hstepB, voffB); PG8_STAGE(PG8_SA(0, 0), a2, voffA);
            PG8_WAIT_V(8); PG8_WAIT_L(0); PG8_BAR; PG8_MMA(1, 0, At, B0); PG8_MMA(1, 1, At, B1); PG8_BAR; PG8_SCHED;
            PG8_LDB(B0, 1, 0); PG8_LDB(B1, 1, 1); PG8_SCHED; PG8_LDA(At, 1, 0); PG8_STAGE(PG8_SA(0, 1), a2 + hstepA, voffA);
            PG8_WAIT_V(8); PG8_WAIT_L(0); PG8_BAR; PG8_MMA(0, 0, At, B0); PG8_MMA(0, 1, At, B1); PG8_BAR; PG8_SCHED;
            PG8_LDA(At, 1, 1); PG8_STAGE(PG8_SB(1, 0), b3, voffB); PG8_STAGE(PG8_SB(1, 1), b3 + hstepB, voffB); PG8_STAGE(PG8_SA(1, 0), a3, voffA);
            PG8_WAIT_V(8); PG8_WAIT_L(0); PG8_BAR; PG8_MMA(1, 0, At, B0); PG8_MMA(1, 1, At, B1); PG8_BAR; PG8_SCHED;
        }
        if (wr == 0) PG8_BAR;
        E(acc, cur, wr, wc, fr, fq);
#pragma unroll
        for (int a = 0; a < 2; ++a)
#pragma unroll
            for (int b = 0; b < 2; ++b)
#pragma unroll
                for (int m = 0; m < 4; ++m)
#pragma unroll
                    for (int n = 0; n < 2; ++n) acc[a][b][m][n] = (f32x4){0.f, 0.f, 0.f, 0.f};
        if (!has_next) break;
        cur = nxt; cA = nA; cB = nB; ++ui;
        if (wr == 1) PG8_BAR;
    }
    PG8_WAIT_V(0);
    PG8_BAR;
#undef PG8_LANE_SETUP
#undef PG8_SA
#undef PG8_SB
#undef PG8_STAGE
#undef PG8_LDA
#undef PG8_LDB
#undef PG8_MMA
#undef PG8_WAIT_V
#undef PG8_WAIT_L
#undef PG8_BAR
#undef PG8_SCHED
}
}

#define XB_TMO      128
#define XB_XCNT(j)  (256  + 64 * (j))
#define XB_XSUB(j)  (1280 + 64 * (j))
#define XB_XGEN(j)  (2304 + 64 * (j))
#define XB_TOP      3328
#define XB_TOPGEN   3392
#define XCD_BAR_WORDS 3456
#define XB_SPIN_CAP (1u << 22)
__device__ __forceinline__ unsigned xb_ld(unsigned* p)              { return __hip_atomic_load(p, __ATOMIC_RELAXED, __HIP_MEMORY_SCOPE_AGENT); }
__device__ __forceinline__ unsigned xb_add(unsigned* p, unsigned v) { return __hip_atomic_fetch_add(p, v, __ATOMIC_RELAXED, __HIP_MEMORY_SCOPE_AGENT); }
__device__ __forceinline__ unsigned xb_xcc_id() { return (unsigned)__builtin_amdgcn_s_getreg((3 << 11) | 20) & 0xFu; }
#define XB_SPIN(cond, bar) do { unsigned _sp = 0; while (cond) { __builtin_amdgcn_s_sleep(1); \
    if ((++_sp & 255u) == 0u) { if (xb_ld(&(bar)[XB_TMO])) break; if (_sp > XB_SPIN_CAP) { atomicAdd(&(bar)[XB_TMO], 1u); break; } } } } while (0)
struct XcdBarrier { unsigned* bar; unsigned x; volatile LAS unsigned* st; };
__device__ __forceinline__ XcdBarrier xcd_barrier_post(unsigned* bar, volatile LAS unsigned* st) {
    XcdBarrier b; b.bar = bar; b.x = xb_xcc_id(); b.st = st;
    if (threadIdx.x == 0) (void)xb_add(&bar[XB_XCNT(b.x)], 1u);
    return b;
}
__device__ __forceinline__ void xcd_barrier_complete(unsigned* bar, unsigned x, unsigned& nloc, unsigned& nx) {
    const unsigned G = gridDim.x * gridDim.y * gridDim.z;
    unsigned sum, cnt, mine, sp = 0u;
    for (;;) {
        sum = 0u; cnt = 0u; mine = 0u;
#pragma unroll
        for (unsigned j = 0; j < 16; ++j) { const unsigned c = xb_ld(&bar[XB_XCNT(j)]); sum += c; cnt += (c > 0u) ? 1u : 0u; mine = (j == x) ? c : mine; }
        if (sum == G) break;
        __builtin_amdgcn_s_sleep(1);
        if ((++sp & 255u) == 0u) { if (xb_ld(&bar[XB_TMO])) break; if (sp > XB_SPIN_CAP) { atomicAdd(&bar[XB_TMO], 1u); break; } }
    }
    nloc = mine > 0u ? mine : 1u; nx = cnt > 0u ? cnt : 1u;
}
__device__ __forceinline__ void xcd_barrier(const XcdBarrier& b) {
    asm volatile("s_waitcnt vmcnt(0)" ::: "memory");
    __syncthreads();
    if (threadIdx.x == 0) {
        unsigned* bar = b.bar;
        __builtin_amdgcn_s_waitcnt(0);
        unsigned nloc = b.st[0], nx = b.st[1];
        if (nloc == 0u) { xcd_barrier_complete(bar, b.x, nloc, nx); b.st[0] = nloc; b.st[1] = nx; }
        const unsigned old = xb_add(&bar[XB_XSUB(b.x)], 1u);
        const unsigned gen = old / nloc;
        if (old + 1u == (gen + 1u) * nloc) {
            __builtin_amdgcn_fence(__ATOMIC_RELEASE, "agent");
            asm volatile("s_waitcnt vmcnt(0)" ::: "memory");
            const unsigned og = xb_add(&bar[XB_TOP], 1u);
            const unsigned tg = og / nx;
            if (og + 1u == (tg + 1u) * nx) xb_add(&bar[XB_TOPGEN], 1u);
            else XB_SPIN(xb_ld(&bar[XB_TOPGEN]) == tg, bar);
            __builtin_amdgcn_fence(__ATOMIC_ACQUIRE, "agent");
            xb_add(&bar[XB_XGEN(b.x)], 1u);
            asm volatile("s_waitcnt vmcnt(0)" ::: "memory");
        } else {
            XB_SPIN(xb_ld(&bar[XB_XGEN(b.x)]) == gen, bar);
            __builtin_amdgcn_fence(__ATOMIC_ACQUIRE, "agent");
            asm volatile("s_waitcnt vmcnt(0)" ::: "memory");
        }
    }
    __syncthreads();
}

struct Frame {
    LAS unsigned char* lds;
    int tid, lane, wave, G, bid;
    const float* in[28];
    float* out; unsigned char* ws;
    __device__ __forceinline__ const float* xrow(int m) const { return m < NCTX ? in[0] + (size_t)m * DM : in[1] + (size_t)(m - NCTX) * DM; }
};
__device__ __forceinline__ int cond_of(int m) { return m < NCTX ? 0 : 1 + ((m - NCTX) >> 10); }

__device__ __forceinline__ void p0_transpose_item(const float* W, int N, int K, bf16_t* WT, int k0, int n0, int drow0, LAS float* scr, int lane) {
#pragma unroll 8
    for (int i = 0; i < 32; ++i) { const int kk = 2 * i + (lane >> 5); scr[kk * 33 + (lane & 31)] = W[(size_t)(k0 + kk) * N + n0 + (lane & 31)]; }
    asm volatile("s_waitcnt lgkmcnt(0)" ::: "memory");
    const int c = lane & 7;
#pragma unroll
    for (int j = 0; j < 4; ++j) { const int n = (lane >> 3) + 8 * j; const LAS float* s = scr + (8 * c) * 33 + n;
        u32x4 o; o.x = cvtpk(s[0 * 33], s[1 * 33]); o.y = cvtpk(s[2 * 33], s[3 * 33]); o.z = cvtpk(s[4 * 33], s[5 * 33]); o.w = cvtpk(s[6 * 33], s[7 * 33]);
        *(u32x4*)(WT + (size_t)(drow0 + n) * K + k0 + 8 * c) = o; }
    asm volatile("s_waitcnt lgkmcnt(0)" ::: "memory");
}
constexpr int I_IN = 16 * 161, I_GO = 8 * 32, I_NO = 8 * 32, I_OUT = 16 * 32, I_UP = 16 * 176, I_DN = 44 * 32;
constexpr int I_EARLY = I_IN + I_GO + I_NO + I_OUT, I_LATE = I_UP + I_DN;
__device__ __forceinline__ void p0_transposes(Frame& F, int first, int count, int worker, int nworkers) {
    LAS float* scr = (LAS float*)(F.lds + F.wave * 16384);
    for (int it = first + worker; it < first + count; it += nworkers) {
        int r = it;
        if (r < I_IN) { const int kb = r / 161, nb = r % 161;
            if (nb == 48) p0_transpose_item(F.in[11], DIN, 1024, (bf16_t*)(F.ws + WS_WZT), 64 * kb, 32 * nb, 0, scr, F.lane);
            else p0_transpose_item(F.in[11], DIN, 1024, (bf16_t*)(F.ws + WS_WIN), 64 * kb, 32 * nb, 32 * nb - (nb > 48 ? 32 : 0), scr, F.lane);
            continue; } r -= I_IN;
        if (r < I_GO) { p0_transpose_item(F.in[20], 1024, 512, (bf16_t*)(F.ws + WS_WGO), 64 * (r / 32), 32 * (r % 32), 32 * (r % 32), scr, F.lane); continue; } r -= I_GO;
        if (r < I_NO) { p0_transpose_item(F.in[21], 1024, 512, (bf16_t*)(F.ws + WS_WNO), 64 * (r / 32), 32 * (r % 32), 32 * (r % 32), scr, F.lane); continue; } r -= I_NO;
        if (r < I_OUT) { p0_transpose_item(F.in[22], 1024, 1024, (bf16_t*)(F.ws + WS_WOUT), 64 * (r / 32), 32 * (r % 32), 32 * (r % 32), scr, F.lane); continue; } r -= I_OUT;
        if (r < I_UP) { const int n0 = 32 * (r % 176), c0 = n0 % DFF; p0_transpose_item(F.in[24], NUP, 1024, (bf16_t*)(F.ws + WS_WUP), 64 * (r / 176), n0, 256 * (c0 / 128) + (c0 % 128) + (n0 >= DFF ? 128 : 0), scr, F.lane); continue; } r -= I_UP;
        p0_transpose_item(F.in[27], 1024, DFF, (bf16_t*)(F.ws + WS_WDN), 64 * (r / 32), 32 * (r % 32), 32 * (r % 32), scr, F.lane);
    }
}
__device__ __forceinline__ void p0_prologue(Frame& F) {
    {
        LAS float* sc = (LAS float*)(F.lds);
        LAS float* red = (LAS float*)(F.lds + 12288);
        for (int i = F.tid; i < 3072; i += NTHR) { const int c = i >> 10, k = i & 1023; const float v = c == 0 ? F.in[7][k] : F.in[2][(c - 1) * 1024 + k]; sc[i] = siluf_(v); }
        __syncthreads();
        const float* wada = F.in[8]; const float* bada = F.in[9]; float* ada = (float*)(F.ws + WS_ADA);
        for (int cb = F.bid; cb < 256; cb += F.G) {
            if (F.tid < 384) {
                const int cq = F.tid % 6, kg = F.tid / 6;
                f32x4 a0 = {0.f, 0.f, 0.f, 0.f}, a1 = a0, a2 = a0;
#pragma unroll 4
                for (int kk = 0; kk < 16; ++kk) { const int k = 16 * kg + kk; const f32x4 w = *(const f32x4*)(wada + (size_t)k * 6144 + 24 * cb + 4 * cq);
                    a0 += w * sc[k]; a1 += w * sc[1024 + k]; a2 += w * sc[2048 + k]; }
#pragma unroll
                for (int e = 0; e < 4; ++e) { red[(0 * 64 + kg) * 24 + 4 * cq + e] = a0[e]; red[(1 * 64 + kg) * 24 + 4 * cq + e] = a1[e]; red[(2 * 64 + kg) * 24 + 4 * cq + e] = a2[e]; }
            }
            __syncthreads();
            if (F.tid < 72) { const int c = F.tid / 24, col = F.tid % 24; float s = 0.f;
                for (int kg = 0; kg < 64; ++kg) s += red[(c * 64 + kg) * 24 + col];
                ada[c * 6144 + 24 * cb + col] = s + bada[24 * cb + col]; }
            __syncthreads();
        }
    }
    p0_transposes(F, 0, F.G == 256 ? I_EARLY : I_EARLY + I_LATE, F.bid * NWAVES + F.wave, F.G * NWAVES);
}

template <bool FROM_OUT>
__device__ __forceinline__ void norm_rows(Frame& F, const float* g, int off_sh, int off_sc) {
    const int gw = F.bid * NWAVES + F.wave, NGW = F.G * NWAVES;
    const float* ada = (const float*)(F.ws + WS_ADA);
    bf16_t* H = (bf16_t*)(F.ws + WS_H);
    for (int mb = gw; mb < MTOK; mb += 3 * NGW) {
        f32x4 v[3][4];
#pragma unroll
        for (int r = 0; r < 3; ++r) { const int m = mb + r * NGW; if (m < MTOK) { const float* xr = FROM_OUT ? F.out + (size_t)m * DM : F.xrow(m);
#pragma unroll
            for (int j = 0; j < 4; ++j) v[r][j] = *(const f32x4*)(xr + 4 * F.lane + 256 * j); } }
#pragma unroll
        for (int r = 0; r < 3; ++r) { const int m = mb + r * NGW; if (m >= MTOK) break;
            const float* ad = ada + cond_of(m) * 6144;
            f32x4 gg[4], sc[4], sh[4];
#pragma unroll
            for (int j = 0; j < 4; ++j) { const int c = 4 * F.lane + 256 * j; gg[j] = *(const f32x4*)(g + c); sc[j] = *(const f32x4*)(ad + off_sc + c); sh[j] = *(const f32x4*)(ad + off_sh + c); }
            float s = 0.f;
#pragma unroll
            for (int j = 0; j < 4; ++j) s += (v[r][j].x * v[r][j].x + v[r][j].y * v[r][j].y) + (v[r][j].z * v[r][j].z + v[r][j].w * v[r][j].w);
            const float rinv = rsqrtf(wave_sum(s) * (1.f / DM) + EPS);
#pragma unroll
            for (int j = 0; j < 4; ++j) { const int c = 4 * F.lane + 256 * j;
                const f32x4 o = v[r][j] * rinv * gg[j] * (sc[j] + 1.f) + sh[j];
                u32x2 w; w.x = cvtpk(o[0], o[1]); w.y = cvtpk(o[2], o[3]);
                *(u32x2*)(H + (size_t)m * DM + c) = w; } }
    }
}

__device__ __forceinline__ void kvout_rows(Frame& F, int m0, int nrows) {
    const bf16_t* U = (const bf16_t*)(F.ws + WS_U);
    const float* gk = F.in[18];
    for (int i = F.wave; i < nrows; i += NWAVES) {
        const int m = m0 + i;
        float k[8], v[8];
        unpack8(*(const u32x4*)(U + (size_t)m * NU + UNK + 8 * F.lane), k);
        unpack8(*(const u32x4*)(U + (size_t)m * NU + UNV + 8 * F.lane), v);
        float s = 0.f;
#pragma unroll
        for (int e = 0; e < 8; ++e) s += k[e] * k[e];
        s += __shfl_xor(s, 1); s += __shfl_xor(s, 2); s += __shfl_xor(s, 4);
        const float rinv = rsqrtf(s * (1.f / 64.f) + EPS);
        const int d0 = (8 * F.lane) & 63;
        f32x4 o0, o1;
#pragma unroll
        for (int e = 0; e < 4; ++e) { o0[e] = k[e] * rinv * gk[d0 + e]; o1[e] = k[4 + e] * rinv * gk[d0 + 4 + e]; }
        float* ok = F.out + O_NK + (size_t)m * 512 + 8 * F.lane; float* ov = F.out + O_NV + (size_t)m * 512 + 8 * F.lane;
        *(f32x4*)ok = o0; *(f32x4*)(ok + 4) = o1;
        *(f32x4*)ov = (f32x4){v[0], v[1], v[2], v[3]}; *(f32x4*)(ov + 4) = (f32x4){v[4], v[5], v[6], v[7]};
    }
}


__device__ __forceinline__ void st_wt16(Frame& F, const void* p, u32x4 v) {
    const __amdgpu_buffer_rsrc_t rsrc = __builtin_amdgcn_make_buffer_rsrc((void*)F.ws, (short)0, (int)WS_END, 0x00020000);
    __builtin_amdgcn_raw_buffer_store_b128(v, rsrc, (unsigned)((const unsigned char*)p - F.ws), 0, 16); }
__device__ __forceinline__ void st_wt8(void* p, u32x2 v) { __hip_atomic_store((unsigned long long*)p, (unsigned long long)v.x | ((unsigned long long)v.y << 32), __ATOMIC_RELAXED, __HIP_MEMORY_SCOPE_AGENT); }
__device__ __forceinline__ void st_wt4(float* p, float v) { __hip_atomic_store(p, v, __ATOMIC_RELAXED, __HIP_MEMORY_SCOPE_AGENT); }
__device__ __forceinline__ void signal_done(Frame& F, unsigned* cnt) {
    asm volatile("s_waitcnt vmcnt(0)" ::: "memory"); __syncthreads();
    if (F.tid == 0) __hip_atomic_fetch_add(cnt, 1u, __ATOMIC_RELAXED, __HIP_MEMORY_SCOPE_AGENT);
}
__device__ __forceinline__ void wait_count(Frame& F, unsigned* cnt, unsigned want) {
    if (F.tid == 0) { unsigned sp = 0; while (__hip_atomic_load(cnt, __ATOMIC_RELAXED, __HIP_MEMORY_SCOPE_AGENT) < want) { __builtin_amdgcn_s_sleep(4); if (++sp > (1u << 21)) break; }
        __builtin_amdgcn_fence(__ATOMIC_ACQUIRE, "agent"); asm volatile("s_waitcnt vmcnt(0)" ::: "memory"); }
    __syncthreads();
}
__device__ __forceinline__ int chain_ctr(int gc, int h) { const int seq = gc < 64 ? (gc >> 2) : 16 + ((gc - 64) >> 4); return seq * 4 + h; }

__device__ __forceinline__ float logsigf_(float x) { return fminf(x, 0.f) - __logf(1.f + __expf(-fabsf(x))); }
constexpr int VLS = 160;
constexpr int STS = 72;

__device__ __forceinline__ void gla_stage_v(Frame& F, const bf16_t* U, int m0, int h, LAS bf16_t* VL) {
#pragma unroll
    for (int i = 0; i < 2; ++i) { const int p = F.tid + i * NTHR, row = p >> 4, c16 = p & 15;
        const u32x4 v = *(const u32x4*)(U + (size_t)(m0 + row) * NU + UV + 128 * h + 8 * c16);
        *(LAS u32x4*)(VL + row * VLS + 8 * c16) = v; }
}

__device__ __forceinline__ void gla_pass1_item(Frame& F, int item) {
    const bf16_t* U = (const bf16_t*)(F.ws + WS_U); const float* Z = (const float*)(F.ws + WS_Z);
    bf16_t* QK = (bf16_t*)(F.ws + WS_QK) + (size_t)item * 4 * 4096; bf16_t* KV = (bf16_t*)(F.ws + WS_KV) + (size_t)item * 2 * 8192; float* DEC = (float*)(F.ws + WS_DEC) + (size_t)item * 128;
    const int gc = item >> 2, h = item & 3, m0 = gc * 64, tid = F.tid, d = tid & 63, w = F.wave, t0 = 8 * w;
    LAS float* ZL = (LAS float*)(F.lds);
    LAS float* SEG = (LAS float*)(F.lds + 8192);
    LAS bf16_t* KP = (LAS bf16_t*)(F.lds + 12288);
    LAS bf16_t* VL = (LAS bf16_t*)(F.lds + 28672);
    LAS bf16_t* QS = (LAS bf16_t*)(F.lds + 49152);
    LAS bf16_t* KVL = (LAS bf16_t*)(F.lds + 81920);
    { const int t = tid >> 3, c4 = tid & 7; *(LAS f32x4*)(ZL + t * 32 + 4 * c4) = *(const f32x4*)(Z + (size_t)(m0 + t) * 32 + 4 * c4);
      const bf16_t* up = U + (size_t)(m0 + t) * NU + 64 * h + 8 * c4;
      *(LAS u32x4*)(QS + t * 64 + 8 * c4) = *(const u32x4*)(up + UQ); *(LAS u32x4*)(QS + 4096 + t * 64 + 8 * c4) = *(const u32x4*)(up + UK); }
    gla_stage_v(F, U, m0, h, VL);
    float wf[16], wb[16];
#pragma unroll
    for (int j = 0; j < 16; ++j) { wf[j] = F.in[12][j * 256 + 64 * h + d]; wb[j] = F.in[14][j * 256 + 64 * h + d]; }
    const float bfv = F.in[13][64 * h + d], bbv = F.in[15][64 * h + d];
    __syncthreads();
    float q[8], k[8];
#pragma unroll
    for (int i = 0; i < 8; ++i) { q[i] = __uint_as_float((unsigned)QS[(t0 + i) * 64 + d] << 16) * 0.125f; k[i] = __uint_as_float((unsigned)QS[4096 + (t0 + i) * 64 + d] << 16); }
    float cf[8], cb[8];
#pragma unroll
    for (int i = 0; i < 8; ++i) { float af = bfv, ab = bbv;
#pragma unroll
        for (int j = 0; j < 16; ++j) { af += ZL[(t0 + i) * 32 + j] * wf[j]; ab += ZL[(t0 + i) * 32 + 16 + j] * wb[j]; }
        cf[i] = logsigf_(af) * (1.f / 16.f); cb[i] = logsigf_(ab) * (1.f / 16.f); }
#pragma unroll
    for (int i = 1; i < 8; ++i) cf[i] += cf[i - 1];
#pragma unroll
    for (int i = 6; i >= 0; --i) cb[i] += cb[i + 1];
    SEG[w * 64 + d] = cf[7]; SEG[(8 + w) * 64 + d] = cb[0];
    __syncthreads();
    float offf = 0.f, totf = 0.f, offb = 0.f, totb = 0.f;
#pragma unroll
    for (int sg = 0; sg < 8; ++sg) { const float a = SEG[sg * 64 + d], b2 = SEG[(8 + sg) * 64 + d]; totf += a; totb += b2; offf += sg < w ? a : 0.f; offb += sg > w ? b2 : 0.f; }
#pragma unroll
    for (int i = 0; i < 8; ++i) { const int t = t0 + i;
        { const float c = offf + cf[i], e = __expf(c), ei = __expf(-c), el = __expf(totf - c);
          QS[0 * 4096 + t * 64 + d] = (bf16_t)(cvtpk(q[i] * e, 0.f) & 0xffffu); QS[1 * 4096 + t * 64 + d] = (bf16_t)(cvtpk(k[i] * ei, 0.f) & 0xffffu); KP[t * 64 + d] = (bf16_t)(cvtpk(k[i] * el, 0.f) & 0xffffu); }
        { const float c = offb + cb[i], e = __expf(c), ei = __expf(-c), el = __expf(totb - c);
          QS[2 * 4096 + t * 64 + d] = (bf16_t)(cvtpk(q[i] * e, 0.f) & 0xffffu); QS[3 * 4096 + t * 64 + d] = (bf16_t)(cvtpk(k[i] * ei, 0.f) & 0xffffu); KP[(64 + t) * 64 + d] = (bf16_t)(cvtpk(k[i] * el, 0.f) & 0xffffu); } }
    if (w == 0) { st_wt4(DEC + d, __expf(totf)); st_wt4(DEC + 64 + d, __expf(totb)); }
    __syncthreads();
#pragma unroll
    for (int i = 0; i < 4; ++i) st_wt16(F, QK + (size_t)(tid + i * NTHR) * 8, *(const LAS u32x4*)(QS + (tid + i * NTHR) * 8));
    { const int l = F.lane, hh = l >> 5, g1 = (l >> 4) & 1, qq = (l & 15) >> 2, pp = l & 3, dvt = w & 3, dt = w >> 2;
#pragma unroll
      for (int dir = 0; dir < 2; ++dir) { f32x16 acc = {};
#pragma unroll
        for (int ks = 0; ks < 4; ++ks) { const int r0 = 16 * ks + 8 * hh + qq;
            const LAS bf16_t* va = VL + r0 * VLS + 32 * dvt + 16 * g1 + 4 * pp; const LAS bf16_t* kb = KP + (dir * 64 + r0) * 64 + 32 * dt + 16 * g1 + 4 * pp;
            const bf16x8 a = cat8(vtr(va), vtr(va + 4 * VLS)), b = cat8(vtr(kb), vtr(kb + 4 * 64));
            acc = __builtin_amdgcn_mfma_f32_32x32x16_bf16(a, b, acc, 0, 0, 0); }
        LAS bf16_t* kvl = KVL + dir * 8192 + (32 * dt + (l & 31)) * 128 + 32 * dvt + 4 * hh;
#pragma unroll
        for (int rg = 0; rg < 4; ++rg) { u32x2 wv; wv.x = cvtpk(acc[4 * rg], acc[4 * rg + 1]); wv.y = cvtpk(acc[4 * rg + 2], acc[4 * rg + 3]); *(LAS u32x2*)(kvl + 8 * rg) = wv; } } }
    __syncthreads();
#pragma unroll
    for (int i = 0; i < 4; ++i) st_wt16(F, KV + (size_t)(tid + i * NTHR) * 8, *(const LAS u32x4*)(KVL + (tid + i * NTHR) * 8));
    signal_done(F, (unsigned*)(F.ws + WS_CTL) + 9216 + chain_ctr(gc, h));
}

__device__ __forceinline__ void gla_scan_chain(Frame& F, int chain) {
    const bf16_t* KVb = (const bf16_t*)(F.ws + WS_KV); const float* DECb = (const float*)(F.ws + WS_DEC); bf16_t* SSb = (bf16_t*)(F.ws + WS_SS);
    int seq, h, dir;
    if (chain < 16) { seq = 16 + (chain >> 3); h = (chain >> 1) & 3; dir = chain & 1; } else { const int c = chain - 16; seq = c >> 3; h = (c >> 1) & 3; dir = c & 1; }
    const bool ctx = seq < 16; const int N = ctx ? 4 : 16, gc0 = ctx ? seq * 4 : 64 + (seq - 16) * 16;
    wait_count(F, (unsigned*)(F.ws + WS_CTL) + 9216 + seq * 4 + h, (unsigned)N);
    const int d = 8 * F.wave + (F.lane >> 3), dv0 = 16 * (F.lane & 7);
    float S[16];
    if (ctx) {
#pragma unroll
        for (int e = 0; e < 16; ++e) S[e] = 0.f; }
    else { const float* s0 = (dir ? F.in[6] : F.in[5]) + (size_t)((seq - 16) * 4 + h) * 8192 + d * 128 + dv0;
#pragma unroll
        for (int e4 = 0; e4 < 4; ++e4) { const f32x4 v = *(const f32x4*)(s0 + 4 * e4); S[4 * e4] = v[0]; S[4 * e4 + 1] = v[1]; S[4 * e4 + 2] = v[2]; S[4 * e4 + 3] = v[3]; } }
    u32x4 kv[16][2]; float dc[16];
#pragma unroll
    for (int n = 0; n < 16; ++n) if (n < N) { const int gc = gc0 + (dir ? N - 1 - n : n), it = gc * 4 + h;
        const bf16_t* kp = KVb + ((size_t)it * 2 + dir) * 8192 + d * 128 + dv0; kv[n][0] = *(const u32x4*)kp; kv[n][1] = *(const u32x4*)(kp + 8); dc[n] = DECb[(size_t)it * 128 + dir * 64 + d]; }
#pragma unroll
    for (int n = 0; n < 16; ++n) if (n < N) { const int gc = gc0 + (dir ? N - 1 - n : n), it = gc * 4 + h;
        bf16_t* sp = SSb + ((size_t)it * 2 + dir) * 8192 + d * 128 + dv0;
        u32x4 w0, w1; w0.x = cvtpk(S[0], S[1]); w0.y = cvtpk(S[2], S[3]); w0.z = cvtpk(S[4], S[5]); w0.w = cvtpk(S[6], S[7]); w1.x = cvtpk(S[8], S[9]); w1.y = cvtpk(S[10], S[11]); w1.z = cvtpk(S[12], S[13]); w1.w = cvtpk(S[14], S[15]);
        st_wt16(F, sp, w0); st_wt16(F, sp + 8, w1);
        float kf[16]; { float t8[8]; unpack8(kv[n][0], t8);
#pragma unroll
            for (int e = 0; e < 8; ++e) kf[e] = t8[e];
            unpack8(kv[n][1], t8);
#pragma unroll
            for (int e = 0; e < 8; ++e) kf[8 + e] = t8[e]; }
#pragma unroll
        for (int e = 0; e < 16; ++e) S[e] = dc[n] * S[e] + kf[e]; }
    if (ctx) { float* so = F.out + (dir ? O_SB : O_SF) + (size_t)(seq * 4 + h) * 8192 + d * 128 + dv0;
#pragma unroll
        for (int e4 = 0; e4 < 4; ++e4) *(f32x4*)(so + 4 * e4) = (f32x4){S[4 * e4], S[4 * e4 + 1], S[4 * e4 + 2], S[4 * e4 + 3]}; }
    signal_done(F, (unsigned*)(F.ws + WS_CTL) + 9472 + seq * 4 + h);
}

__device__ __forceinline__ void gla_pass2_item(Frame& F, int item) {
    const bf16_t* U = (const bf16_t*)(F.ws + WS_U); bf16_t* OG = (bf16_t*)(F.ws + WS_OG);
    const bf16_t* QKb = (const bf16_t*)(F.ws + WS_QK); const bf16_t* SSb = (const bf16_t*)(F.ws + WS_SS) + (size_t)item * 2 * 8192;
    const int gc = item >> 2, h = item & 3, m0 = gc * 64, tid = F.tid;
    wait_count(F, (unsigned*)(F.ws + WS_CTL) + 9472 + chain_ctr(gc, h), 2u);
    LAS bf16_t* ST = (LAS bf16_t*)(F.lds);
    LAS bf16_t* VL = (LAS bf16_t*)(F.lds + 40960);
    LAS float* SS = (LAS float*)(F.lds + 61440);
#pragma unroll
    for (int i = 0; i < 4; ++i) { const int p = tid + i * NTHR, dir = p >> 10, row = (p & 1023) >> 4, c16 = p & 15;
        *(LAS u32x4*)(ST + (dir * 64 + row) * VLS + 8 * c16) = *(const u32x4*)(SSb + (size_t)dir * 8192 + row * 128 + 8 * c16); }
    gla_stage_v(F, U, m0, h, VL);
    __syncthreads();
    const int l = F.lane, hh = l >> 5, c31 = l & 31, g1 = (l >> 4) & 1, qq = (l & 15) >> 2, pp = l & 3, dvt = F.wave & 3, tt = F.wave >> 2;
    f32x16 o = {};
#pragma unroll
    for (int dir = 0; dir < 2; ++dir) {
        const bf16_t* Qg = QKb + ((size_t)item * 4 + 2 * dir) * 4096; const bf16_t* Kg = Qg + 4096;
        bf16x8 qf[4];
#pragma unroll
        for (int ks = 0; ks < 4; ++ks) qf[ks] = *(const bf16x8*)(Qg + (32 * tt + c31) * 64 + 16 * ks + 8 * hh);
#pragma unroll
        for (int st = 0; st < 2; ++st) {
            if (dir == 0 ? st > tt : st < tt) continue;
            f32x16 p = {};
#pragma unroll
            for (int ks = 0; ks < 4; ++ks) { const bf16x8 kf = *(const bf16x8*)(Kg + (32 * st + c31) * 64 + 16 * ks + 8 * hh); p = __builtin_amdgcn_mfma_f32_32x32x16_bf16(kf, qf[ks], p, 0, 0, 0); }
            if (st == tt) {
#pragma unroll
                for (int r = 0; r < 16; ++r) { const int sx = crow(r, hh); const bool keep = dir == 0 ? sx <= c31 : sx >= c31; p[r] = keep ? p[r] : 0.f; } }
#pragma unroll
            for (int s2 = 0; s2 < 2; ++s2) {
                u32x4 pw; pw.x = cvtpk(p[8 * s2 + 0], p[8 * s2 + 1]); pw.y = cvtpk(p[8 * s2 + 2], p[8 * s2 + 3]); pw.z = cvtpk(p[8 * s2 + 4], p[8 * s2 + 5]); pw.w = cvtpk(p[8 * s2 + 6], p[8 * s2 + 7]);
                const LAS bf16_t* va = VL + (32 * st + 16 * s2 + 4 * hh + qq) * VLS + 32 * dvt + 16 * g1 + 4 * pp;
                o = __builtin_amdgcn_mfma_f32_32x32x16_bf16(cat8(vtr(va), vtr(va + 8 * VLS)), __builtin_bit_cast(bf16x8, pw), o, 0, 0, 0); }
        }
#pragma unroll
        for (int ks = 0; ks < 4; ++ks) { const LAS bf16_t* sa = ST + (dir * 64 + 16 * ks + 8 * hh + qq) * VLS + 32 * dvt + 16 * g1 + 4 * pp;
            o = __builtin_amdgcn_mfma_f32_32x32x16_bf16(cat8(vtr(sa), vtr(sa + 4 * VLS)), qf[ks], o, 0, 0, 0); }
    }
    { float ss = 0.f;
#pragma unroll
      for (int r = 0; r < 16; ++r) ss += o[r] * o[r];
      ss += __shfl_xor(ss, 32);
      if (hh == 0) SS[dvt * 64 + 32 * tt + c31] = ss; }
    __syncthreads();
    { const int t = 32 * tt + c31; const float tot = SS[t] + SS[64 + t] + SS[128 + t] + SS[192 + t]; const float rinv = rsqrtf(tot * (1.f / 128.f) + EPS);
      const float* gg = F.in[16]; const size_t m = (size_t)(m0 + t);
#pragma unroll
      for (int rg = 0; rg < 4; ++rg) { const int dv0 = 32 * dvt + 8 * rg + 4 * hh; const f32x4 g4 = *(const f32x4*)(gg + dv0);
          const u32x2 gr = *(const u32x2*)(U + m * NU + UR + 128 * h + dv0); const float r0 = bflo(gr.x), r1 = bfhi(gr.x), r2 = bflo(gr.y), r3 = bfhi(gr.y);
          u32x2 wv; wv.x = cvtpk(o[4 * rg + 0] * rinv * g4[0] * siluf_(r0), o[4 * rg + 1] * rinv * g4[1] * siluf_(r1)); wv.y = cvtpk(o[4 * rg + 2] * rinv * g4[2] * siluf_(r2), o[4 * rg + 3] * rinv * g4[3] * siluf_(r3));
          *(u32x2*)(OG + m * 512 + 128 * h + dv0) = wv; } }
    __syncthreads();
}

constexpr float QSC = 0.125f * LOG2E;
struct AttnLocal { const LAS float* rpb; int dr0; int qc0; };

template <bool FROMU, bool LOCAL>
__device__ __forceinline__ void attn_wave(Frame& F, const bf16_t* U, int qtok0, int h, int kbase, const float* ckeys, const LAS bf16_t* VLw, const AttnLocal& L, f32x16 (&o)[2], float& m_out, float& l_out) {
    const int l = F.lane, hh = l >> 5, c31 = l & 31, g1 = (l >> 4) & 1, qq = (l & 15) >> 2, pp = l & 3;
    const float* gq = F.in[17]; const float* gk = F.in[18];
    bf16x8 qf[4];
    { float f[4][8]; float ss = 0.f; const bf16_t* qp = U + (size_t)(qtok0 + c31) * NU + UNQ + 64 * h + 8 * hh;
#pragma unroll
      for (int ks = 0; ks < 4; ++ks) { unpack8(*(const u32x4*)(qp + 16 * ks), f[ks]);
#pragma unroll
          for (int e = 0; e < 8; ++e) ss += f[ks][e] * f[ks][e]; }
      ss += __shfl_xor(ss, 32);
      const float rinv = rsqrtf(ss * (1.f / 64.f) + EPS) * QSC;
#pragma unroll
      for (int ks = 0; ks < 4; ++ks) {
#pragma unroll
          for (int e = 0; e < 8; ++e) { const int d = 16 * ks + 8 * hh + e; f[ks][e] *= rinv * gq[d] * (FROMU ? gk[d] : 1.f); }
          qf[ks] = __builtin_bit_cast(bf16x8, pack8(f[ks])); } }
    float m_run = -1e30f, l_run = 0.f;
    o[0] = f32x16{}; o[1] = f32x16{};
    const bf16_t* kpu = U + (size_t)(kbase + c31) * NU + UNK + 64 * h + 8 * hh;
    const float* kpc = FROMU ? nullptr : ckeys + ((size_t)(kbase + c31) * 8 + h) * 64 + 8 * hh;
    u32x4 rawu[4]; f32x4 rawc[8];
    if (FROMU) {
#pragma unroll
        for (int ks = 0; ks < 4; ++ks) rawu[ks] = *(const u32x4*)(kpu + 16 * ks); }
    else {
#pragma unroll
        for (int ks = 0; ks < 4; ++ks) { rawc[2 * ks] = *(const f32x4*)(kpc + 16 * ks); rawc[2 * ks + 1] = *(const f32x4*)(kpc + 16 * ks + 4); } }
#pragma unroll 1
    for (int T = 0; T < 8; ++T) {
        bf16x8 kf[4];
        if (FROMU) { float f[4][8]; float ss = 0.f;
#pragma unroll
            for (int ks = 0; ks < 4; ++ks) { unpack8(rawu[ks], f[ks]);
#pragma unroll
                for (int e = 0; e < 8; ++e) ss += f[ks][e] * f[ks][e]; }
            if (T < 7) { const bf16_t* kn = kpu + (size_t)(32 * (T + 1)) * NU;
#pragma unroll
                for (int ks = 0; ks < 4; ++ks) rawu[ks] = *(const u32x4*)(kn + 16 * ks); }
            ss += __shfl_xor(ss, 32);
            const float rinv = rsqrtf(ss * (1.f / 64.f) + EPS);
#pragma unroll
            for (int ks = 0; ks < 4; ++ks) {
#pragma unroll
                for (int e = 0; e < 8; ++e) f[ks][e] *= rinv;
                kf[ks] = __builtin_bit_cast(bf16x8, pack8(f[ks])); } }
        else {
#pragma unroll
            for (int ks = 0; ks < 4; ++ks) { const f32x4 a = rawc[2 * ks], b = rawc[2 * ks + 1];
                u32x4 w; w.x = cvtpk(a[0], a[1]); w.y = cvtpk(a[2], a[3]); w.z = cvtpk(b[0], b[1]); w.w = cvtpk(b[2], b[3]); kf[ks] = __builtin_bit_cast(bf16x8, w); }
            if (T < 7) { const float* kn = kpc + (size_t)(32 * (T + 1)) * 512;
#pragma unroll
                for (int ks = 0; ks < 4; ++ks) { rawc[2 * ks] = *(const f32x4*)(kn + 16 * ks); rawc[2 * ks + 1] = *(const f32x4*)(kn + 16 * ks + 4); } } }
        f32x16 acc = {};
#pragma unroll
        for (int ks = 0; ks < 4; ++ks) acc = __builtin_amdgcn_mfma_f32_32x32x16_bf16(kf[ks], qf[ks], acc, 0, 0, 0);
        if (LOCAL) { const int c = L.qc0 + c31, cs = min(max(c - 8, 0), 48); const LAS float* rp = L.rpb + (L.dr0 + (T >> 1)) * 32;
#pragma unroll
            for (int r = 0; r < 16; ++r) { const int kc = 32 * (T & 1) + crow(r, hh); const bool inw = kc >= cs && kc < cs + 16; const int dc = min(max(kc - c + 15, 0), 31);
                acc[r] = inw ? acc[r] + rp[dc] : -INFINITY; } }
        float mx = acc[0];
#pragma unroll
        for (int r = 1; r < 16; ++r) mx = fmaxf(mx, acc[r]);
        mx = fmaxf(mx, __shfl_xor(mx, 32));
        const float mnew = fmaxf(m_run, mx), fsc = __builtin_amdgcn_exp2f(m_run - mnew);
        m_run = mnew; l_run *= fsc;
#pragma unroll
        for (int r = 0; r < 16; ++r) { o[0][r] *= fsc; o[1][r] *= fsc; }
#pragma unroll
        for (int r = 0; r < 16; ++r) { const float p = __builtin_amdgcn_exp2f(acc[r] - mnew); acc[r] = p; l_run += p; }
#pragma unroll
        for (int s2 = 0; s2 < 2; ++s2) {
            u32x4 pw; pw.x = cvtpk(acc[8 * s2 + 0], acc[8 * s2 + 1]); pw.y = cvtpk(acc[8 * s2 + 2], acc[8 * s2 + 3]); pw.z = cvtpk(acc[8 * s2 + 4], acc[8 * s2 + 5]); pw.w = cvtpk(acc[8 * s2 + 6], acc[8 * s2 + 7]);
            const bf16x8 pb = __builtin_bit_cast(bf16x8, pw);
#pragma unroll
            for (int dt = 0; dt < 2; ++dt) { const LAS bf16_t* va = VLw + (32 * T + 16 * s2 + 4 * hh + qq) * 64 + 32 * dt + 16 * g1 + 4 * pp;
                o[dt] = __builtin_amdgcn_mfma_f32_32x32x16_bf16(cat8(vtr(va), vtr(va + 8 * 64)), pb, o[dt], 0, 0, 0); } }
    }
    l_run += __shfl_xor(l_run, 32);
    const float mx = m_run, ls = l_run;
    m_out = mx; l_out = ls;
}

__device__ __forceinline__ void attn_ctx_unit(Frame& F, int unit) {
    const bf16_t* U = (const bf16_t*)(F.ws + WS_U); bf16_t* ON = (bf16_t*)(F.ws + WS_ON);
    const int b = unit >> 3, h = unit & 7, tok0 = b * 256;
    LAS bf16_t* VL = (LAS bf16_t*)(F.lds);
#pragma unroll
    for (int i = 0; i < 4; ++i) { const int p = F.tid + i * NTHR, row = p >> 3, c8 = p & 7;
        *(LAS u32x4*)(VL + row * 64 + 8 * c8) = *(const u32x4*)(U + (size_t)(tok0 + row) * NU + UNV + 64 * h + 8 * c8); }
    __syncthreads();
    f32x16 o[2]; float mx, ls; AttnLocal L{nullptr, 0, 0};
    attn_wave<true, false>(F, U, tok0 + 32 * F.wave, h, tok0, nullptr, VL, L, o, mx, ls);
    { const int hh = F.lane >> 5, c31 = F.lane & 31; const float inv = 1.f / ls; bf16_t* op = ON + (size_t)(tok0 + 32 * F.wave + c31) * 512 + 64 * h;
#pragma unroll
      for (int dt = 0; dt < 2; ++dt)
#pragma unroll
          for (int rg = 0; rg < 4; ++rg) { u32x2 w; w.x = cvtpk(o[dt][4 * rg] * inv, o[dt][4 * rg + 1] * inv); w.y = cvtpk(o[dt][4 * rg + 2] * inv, o[dt][4 * rg + 3] * inv);
              *(u32x2*)(op + 32 * dt + 8 * rg + 4 * hh) = w; } }
    __syncthreads();
}

__device__ __forceinline__ void attn_lat_unit(Frame& F, int unit) {
    const bf16_t* U = (const bf16_t*)(F.ws + WS_U); bf16_t* ON = (bf16_t*)(F.ws + WS_ON);
    const int r = unit & 15, h = (unit >> 4) & 7, bl = unit >> 7;
    const int rs = min(max(r - 4, 0), 8), ltok0 = NCTX + bl * 1024 + rs * 64, qrow0 = NCTX + bl * 1024 + r * 64;
    LAS bf16_t* VL = (LAS bf16_t*)(F.lds);
    LAS float* RPB = (LAS float*)(F.lds + 131072);
    LAS float* ML = (LAS float*)(F.lds + 133120);
    LAS float* PO = (LAS float*)(F.lds);
    const float* cv = F.in[4] + (size_t)bl * 512 * 512;
#pragma unroll
    for (int i = 0; i < 8; ++i) { const int p = F.tid + i * NTHR, row = p >> 3, c8 = p & 7;
        *(LAS u32x4*)(VL + row * 64 + 8 * c8) = *(const u32x4*)(U + (size_t)(ltok0 + row) * NU + UNV + 64 * h + 8 * c8); }
#pragma unroll
    for (int i = 0; i < 8; ++i) { const int p = F.tid + i * NTHR, row = p >> 3, c8 = p & 7; const float* vp = cv + ((size_t)row * 8 + h) * 64 + 8 * c8;
        const f32x4 a = *(const f32x4*)vp, b2 = *(const f32x4*)(vp + 4);
        u32x4 w; w.x = cvtpk(a[0], a[1]); w.y = cvtpk(a[2], a[3]); w.z = cvtpk(b2[0], b2[1]); w.w = cvtpk(b2[2], b2[3]);
        *(LAS u32x4*)(VL + (512 + row) * 64 + 8 * c8) = w; }
    if (F.tid < 480) { const int dr = F.tid >> 5, dc = F.tid & 31; RPB[F.tid] = dc < 31 ? F.in[19][(h * 15 + dr) * 31 + dc] * LOG2E : 0.f; }
    __syncthreads();
    const int qg = F.wave >> 2, kb = F.wave & 3;
    f32x16 o[2]; float mx, ls;
    if (kb < 2) { AttnLocal L{RPB, rs + 4 * kb - r + 7, 32 * qg}; attn_wave<true, true>(F, U, qrow0 + 32 * qg, h, ltok0 + 256 * kb, nullptr, VL + 256 * kb * 64, L, o, mx, ls); }
    else { AttnLocal L{nullptr, 0, 0}; attn_wave<false, false>(F, U, qrow0 + 32 * qg, h, bl * 512 + 256 * (kb - 2), F.in[3], VL + (512 + 256 * (kb - 2)) * 64, L, o, mx, ls); }
    __syncthreads();
    { const int hh = F.lane >> 5, c31 = F.lane & 31;
#pragma unroll
      for (int dt = 0; dt < 2; ++dt)
#pragma unroll
          for (int rr = 0; rr < 16; ++rr) PO[(F.wave * 64 + 32 * dt + crow(rr, hh)) * 32 + c31] = o[dt][rr];
      if (hh == 0) { ML[F.wave * 64 + c31] = mx; ML[F.wave * 64 + 32 + c31] = ls; } }
    __syncthreads();
    { const int q = F.tid & 31, dv8 = (F.tid >> 5) & 7, qg2 = F.tid >> 8;
      float M = -INFINITY;
#pragma unroll
      for (int w = 0; w < 4; ++w) M = fmaxf(M, ML[(4 * qg2 + w) * 64 + q]);
      float Ls = 0.f, acc[8];
#pragma unroll
      for (int e = 0; e < 8; ++e) acc[e] = 0.f;
#pragma unroll
      for (int w = 0; w < 4; ++w) { const int ww = 4 * qg2 + w; const float wt = __builtin_amdgcn_exp2f(ML[ww * 64 + q] - M); Ls += wt * ML[ww * 64 + 32 + q];
#pragma unroll
          for (int e = 0; e < 8; ++e) acc[e] += wt * PO[(ww * 64 + 8 * dv8 + e) * 32 + q]; }
      const float inv = 1.f / Ls;
#pragma unroll
      for (int e = 0; e < 8; ++e) acc[e] *= inv;
      *(u32x4*)(ON + (size_t)(qrow0 + 32 * qg2 + q) * 512 + 64 * h + 8 * dv8) = pack8(acc); }
    __syncthreads();
}

__device__ __forceinline__ void resid_norm_rows(Frame& F) {
    const int gw = F.bid * NWAVES + F.wave, NGW = F.G * NWAVES;
    const float* ada = (const float*)(F.ws + WS_ADA); const float* g = F.in[23];
    const bf16_t* P0 = (const bf16_t*)(F.ws + WS_PART0); const bf16_t* P1 = (const bf16_t*)(F.ws + WS_PART1);
    bf16_t* H = (bf16_t*)(F.ws + WS_H);
    for (int mb = gw; mb < MTOK; mb += 2 * NGW) {
        f32x4 v[2][4]; u32x2 p0[2][4], p1[2][4];
#pragma unroll
        for (int r = 0; r < 2; ++r) { const int m = mb + r * NGW; if (m < MTOK) { const float* xr = F.xrow(m);
#pragma unroll
            for (int j = 0; j < 4; ++j) { const int c = 4 * F.lane + 256 * j; v[r][j] = *(const f32x4*)(xr + c); p0[r][j] = *(const u32x2*)(P0 + (size_t)m * DM + c); p1[r][j] = *(const u32x2*)(P1 + (size_t)m * DM + c); } } }
#pragma unroll
        for (int r = 0; r < 2; ++r) { const int m = mb + r * NGW; if (m >= MTOK) break;
            const float* ad = ada + cond_of(m) * 6144;
            f32x4 gg[4], sc[4], sh[4]; float s = 0.f;
#pragma unroll
            for (int j = 0; j < 4; ++j) { const int c = 4 * F.lane + 256 * j; const f32x4 gt = *(const f32x4*)(ad + 2048 + c); gg[j] = *(const f32x4*)(g + c); sc[j] = *(const f32x4*)(ad + 4096 + c); sh[j] = *(const f32x4*)(ad + 3072 + c);
                { const f32x4 ps = {bflo(p0[r][j].x) + bflo(p1[r][j].x), bfhi(p0[r][j].x) + bfhi(p1[r][j].x), bflo(p0[r][j].y) + bflo(p1[r][j].y), bfhi(p0[r][j].y) + bfhi(p1[r][j].y)}; v[r][j] = v[r][j] + gt * ps; }
                *(f32x4*)(F.out + (size_t)m * DM + c) = v[r][j];
                s += (v[r][j].x * v[r][j].x + v[r][j].y * v[r][j].y) + (v[r][j].z * v[r][j].z + v[r][j].w * v[r][j].w); }
            const float rinv = rsqrtf(wave_sum(s) * (1.f / DM) + EPS);
#pragma unroll
            for (int j = 0; j < 4; ++j) { const int c = 4 * F.lane + 256 * j;
                const f32x4 o = v[r][j] * rinv * gg[j] * (sc[j] + 1.f) + sh[j];
                u32x2 w; w.x = cvtpk(o[0], o[1]); w.y = cvtpk(o[2], o[3]);
                *(u32x2*)(H + (size_t)m * DM + c) = w; } }
    }
}
__device__ __forceinline__ void final_rows(Frame& F) {
    const float* ada = (const float*)(F.ws + WS_ADA);
    const bf16_t* P0 = (const bf16_t*)(F.ws + WS_PART0); const bf16_t* P1 = (const bf16_t*)(F.ws + WS_PART1);
    for (size_t i4 = (size_t)F.bid * NTHR + F.tid; i4 < (size_t)MTOK * DM / 4; i4 += (size_t)F.G * NTHR) {
        const int m = (int)(i4 >> 8), c = (int)(i4 & 255) * 4;
        const f32x4 gt = *(const f32x4*)(ada + cond_of(m) * 6144 + 5120 + c);
        const f32x4 x1 = *(const f32x4*)(F.out + i4 * 4); const u32x2 a = *(const u32x2*)(P0 + i4 * 4), b = *(const u32x2*)(P1 + i4 * 4);
        const f32x4 ps = {bflo(a.x) + bflo(b.x), bfhi(a.x) + bfhi(b.x), bflo(a.y) + bflo(b.y), bfhi(a.y) + bfhi(b.y)};
        *(f32x4*)(F.out + i4 * 4) = x1 + gt * ps;
    }
}

__device__ __forceinline__ void convgate_rows(Frame& F, int wb, int nwb) {
    const bf16_t* U2 = (const bf16_t*)(F.ws + WS_U2); bf16_t* ACT = (bf16_t*)(F.ws + WS_ACT);
    const float* wc = F.in[25]; const float* bc = F.in[26];
    constexpr int NV8 = DFF / 8, RUN = 6, NRUN = (NLAT + RUN - 1) / RUN;
    for (int idx = wb * NTHR + F.tid; idx < NV8 * NRUN; idx += nwb * NTHR) {
        const int cg = idx % NV8, run = idx / NV8, c = cg * 8, m0 = NCTX + run * RUN;
        const int ca_ = 256 * (c >> 7) + (c & 127);
        float wa[3][8], wg[3][8], ba[8], bg[8];
#pragma unroll
        for (int j = 0; j < 3; ++j) { const f32x4 x0 = *(const f32x4*)(wc + j * NUP + c), x1 = *(const f32x4*)(wc + j * NUP + c + 4), y0 = *(const f32x4*)(wc + j * NUP + DFF + c), y1 = *(const f32x4*)(wc + j * NUP + DFF + c + 4);
#pragma unroll
            for (int e = 0; e < 4; ++e) { wa[j][e] = x0[e]; wa[j][4 + e] = x1[e]; wg[j][e] = y0[e]; wg[j][4 + e] = y1[e]; } }
        { const f32x4 x0 = *(const f32x4*)(bc + c), x1 = *(const f32x4*)(bc + c + 4), y0 = *(const f32x4*)(bc + DFF + c), y1 = *(const f32x4*)(bc + DFF + c + 4);
#pragma unroll
          for (int e = 0; e < 4; ++e) { ba[e] = x0[e]; ba[4 + e] = x1[e]; bg[e] = y0[e]; bg[4 + e] = y1[e]; } }
        const bf16_t* up = U2 + (size_t)m0 * NUP + ca_;
        u32x4 ra[RUN + 2], rg[RUN + 2];
#pragma unroll
        for (int k = 0; k < RUN + 2; ++k) { const int m = m0 + k - 1; const bool ok = m >= NCTX && m < MTOK;
            ra[k] = ok ? *(const u32x4*)(up + (ptrdiff_t)(k - 1) * NUP) : (u32x4){0u, 0u, 0u, 0u}; rg[k] = ok ? *(const u32x4*)(up + (ptrdiff_t)(k - 1) * NUP + 128) : (u32x4){0u, 0u, 0u, 0u}; }
#pragma unroll
        for (int i = 0; i < RUN; ++i) {
            const int m = m0 + i; if (m >= MTOK) break;
            const bool first = ((m - NCTX) & 1023) == 0, last = ((m - NCTX) & 1023) == 1023;
            float pa[8], pg[8], ca[8], cg_[8], na[8], ng[8], o[8];
            unpack8(ra[i], pa); unpack8(ra[i + 1], ca); unpack8(ra[i + 2], na); unpack8(rg[i], pg); unpack8(rg[i + 1], cg_); unpack8(rg[i + 2], ng);
            const float fp = first ? 0.f : 1.f, fn = last ? 0.f : 1.f;
#pragma unroll
            for (int e = 0; e < 8; ++e) { const float a = ba[e] + fp * wa[0][e] * pa[e] + wa[1][e] * ca[e] + fn * wa[2][e] * na[e], g = bg[e] + fp * wg[0][e] * pg[e] + wg[1][e] * cg_[e] + fn * wg[2][e] * ng[e];
                o[e] = a * siluf_(g); }
            *(u32x4*)(ACT + (size_t)m * DFF + c) = pack8(o);
        }
    }
}

struct Args { const float* in[28]; float* out; unsigned char* ws; int ph_lo, ph_hi; };

__global__ void __launch_bounds__(NTHR, 2) fwd_kernel(Args args) {
    extern __shared__ __attribute__((aligned(16))) unsigned char lds_raw[];
    Frame F;
    F.lds = (LAS unsigned char*)lds_raw;
    F.tid = threadIdx.x; F.lane = F.tid & 63; F.wave = __builtin_amdgcn_readfirstlane(F.tid >> 6);
    F.G = gridDim.x; F.bid = blockIdx.x;
#pragma unroll
    for (int i = 0; i < 28; ++i) F.in[i] = args.in[i];
    F.out = args.out; F.ws = args.ws;
    const int lo = args.ph_lo, hi = args.ph_hi;
    const bool multi = (hi - lo) > 1;
    volatile LAS unsigned* MISC = (volatile LAS unsigned*)(F.lds + MISC_OFF);
    if (F.tid < 128) MISC[F.tid] = 0u;
    __syncthreads();
    XcdBarrier bar; bar.bar = (unsigned*)(F.ws + WS_CTL) + 4096; bar.x = 0; bar.st = MISC + 8;
    if (multi) bar = xcd_barrier_post((unsigned*)(F.ws + WS_CTL) + 4096, MISC + 8);
#define IN(k) (lo <= (k) && (k) < hi)
#define REP(k) for (int rep_ = 0; rep_ < (((REP_MASK) >> (k)) & 1u ? 2 : 1); ++rep_)
    int bar_idx = 0;
    if (PROBE_IDX && F.tid == 0) MISC[16] = (unsigned)__builtin_amdgcn_s_memrealtime();
#define LAP(id) do { if (PROBE_IDX < 0 && F.tid == 0) MISC[16 + (id)] = (unsigned)__builtin_amdgcn_s_memrealtime(); } while (0)
#define GRID_BAR() do { if (multi) xcd_barrier(bar); if (PROBE_IDX) { ++bar_idx; if (F.tid == 0 && bar_idx < 40) MISC[16 + bar_idx] = (unsigned)__builtin_amdgcn_s_memrealtime(); } } while (0)

    if (IN(0)) { p0_prologue(F); GRID_BAR(); }
    if (IN(1)) { norm_rows<false>(F, F.in[10], 0, 1024); GRID_BAR(); }
    if (IN(2)) {
        pg8::StaticOrder S; S.init(F.ws + WS_H, F.ws + WS_WIN, MTOK, NU + 256, DM, DM, F.G, F.bid);
        pg8::EpiBf16 E{(bf16_t*)(F.ws + WS_U), NU, nullptr, (bf16_t*)(F.ws + WS_GATE), 12, (float*)(F.ws + WS_Z), 20};
        LAP(30); pg8::gemm_phase(F.lds, F.wave, DM, DM, DM, S, E);
        LAP(31);
        LAP(32); GRID_BAR(); LAP(33);
    }
    if (IN(3)) {
        if (F.G == 256) {
            LAP(50); if (F.bid < 128) { gla_pass1_item(F, 256 + F.bid); gla_pass1_item(F, F.bid); } else { gla_pass1_item(F, F.bid); attn_ctx_unit(F, F.bid - 128); }
            kvout_rows(F, 16 * F.bid, 16);
            LAP(51); if (F.bid < 144) gla_scan_chain(F, F.bid);
            LAP(52); attn_lat_unit(F, F.bid);
            LAP(53); gla_pass2_item(F, F.bid); if (F.bid < 128) gla_pass2_item(F, 256 + F.bid); LAP(54);
        } else {
            for (int it = F.bid; it < 384; it += F.G) gla_pass1_item(F, it);
            for (int u = F.bid; u < 128; u += F.G) attn_ctx_unit(F, u);
            for (int c = F.bid; c < 256; c += F.G) kvout_rows(F, 16 * c, 16);
            for (int u = F.bid; u < 256; u += F.G) attn_lat_unit(F, u);
        }
        GRID_BAR(); LAP(55);
    }
    if (IN(4) && F.G != 256) { for (int c = F.bid; c < 144; c += F.G) gla_scan_chain(F, c); GRID_BAR(); }
    if (IN(5) && F.G != 256) { for (int it = F.bid; it < 384; it += F.G) gla_pass2_item(F, it); GRID_BAR(); }
    if (IN(6)) {
        pg8::DualOrder S; S.init(F.ws + WS_OG, F.ws + WS_WGO, F.ws + WS_ON, F.ws + WS_WNO, MTOK, DM, 512, 512, F.G, F.bid);
        pg8::EpiGate E{(const bf16_t*)(F.ws + WS_GATE), (bf16_t*)(F.ws + WS_MIX), (bf16_t*)(F.ws + WS_MIXN)};
        pg8::gemm_phase(F.lds, F.wave, 512, 512, 512, S, E);
        if (F.G == 256 && F.bid >= 192) p0_transposes(F, I_EARLY, I_LATE, (F.bid - 192) * NWAVES + F.wave, 64 * NWAVES);
        GRID_BAR();
    }
    if (IN(7)) {
        pg8::DualOrder S; S.init(F.ws + WS_MIX, F.ws + WS_WOUT, F.ws + WS_MIXN, F.ws + WS_WOUT, MTOK, DM, DM, DM, F.G, F.bid);
        pg8::EpiBf16 E{(bf16_t*)(F.ws + WS_PART0), DM, (bf16_t*)(F.ws + WS_PART1), nullptr, 1 << 30, nullptr, -1};
        pg8::gemm_phase(F.lds, F.wave, DM, DM, DM, S, E);
        GRID_BAR();
    }
    if (IN(8)) { resid_norm_rows(F); GRID_BAR(); }
    if (IN(9)) {
        unsigned* cnt = (unsigned*)(F.ws + WS_CTL) + 8192;
        if (F.G == 256) {
            pg8::UpOrder S; S.init(F.ws + WS_H, F.ws + WS_WUP, DM, DM, F.bid);
            pg8::EpiConv E{(bf16_t*)(F.ws + WS_U2), (bf16_t*)(F.ws + WS_ACT), F.in[25], F.in[26], (LAS float*)(F.lds + RING_BYTES), cnt};
            { int l_ = lane_id(); asm volatile("" : "+v"(l_)); F.lane = l_; F.tid = F.wave * 64 + l_; }
            pg8::gemm_phase(F.lds, F.wave, DM, DM, DM, S, E);
            { int l_ = lane_id(); asm volatile("" : "+v"(l_)); F.lane = l_; F.tid = F.wave * 64 + l_; }
            if ((F.bid >> 3) >= 2) {
                if (F.tid == 0) { unsigned sp = 0; while (__hip_atomic_load(cnt, __ATOMIC_RELAXED, __HIP_MEMORY_SCOPE_AGENT) < 176u * 8u) { __builtin_amdgcn_s_sleep(8); if (++sp > (1u << 20)) break; }
                    __builtin_amdgcn_fence(__ATOMIC_ACQUIRE, "agent"); asm volatile("s_waitcnt vmcnt(0)" ::: "memory"); }
                __syncthreads();
                convgate_rows(F, F.bid - 16, 240);
            }
        } else {
            pg8::StaticOrder S; S.init(F.ws + WS_H, F.ws + WS_WUP, MTOK, NUP, DM, DM, F.G, F.bid);
            pg8::EpiConv E{(bf16_t*)(F.ws + WS_U2), (bf16_t*)(F.ws + WS_ACT), F.in[25], F.in[26], (LAS float*)(F.lds + RING_BYTES), cnt};
            pg8::gemm_phase(F.lds, F.wave, DM, DM, DM, S, E);
        }
        GRID_BAR();
    }
    if (IN(10) && F.G != 256) { convgate_rows(F, F.bid, F.G); GRID_BAR(); }
    if (IN(11)) {
        pg8::DualOrder S; S.init(F.ws + WS_ACT, F.ws + WS_WDN, F.ws + WS_ACT + 1408 * 2, F.ws + WS_WDN + 1408 * 2, MTOK, DM, DFF, DFF, F.G, F.bid);
        pg8::EpiBf16 E{(bf16_t*)(F.ws + WS_PART0), DM, (bf16_t*)(F.ws + WS_PART1), nullptr, 1 << 30, nullptr, -1};
        pg8::gemm_phase(F.lds, F.wave, 1408, DFF, DFF, S, E);
        GRID_BAR();
    }
    if (IN(12)) { final_rows(F); }
    if (PROBE_IDX > 0) { GRID_BAR(); if (F.bid == 0 && F.tid == 0) { const unsigned dt = MISC[16 + PROBE_IDX] - MISC[16 + PROBE_IDX - 1]; F.out[0] += (float)dt * 0.001f; } }
    if (PROBE_IDX < 0) { GRID_BAR(); if (F.bid == PROBE_BLOCK && F.tid == 0) { const unsigned dt = MISC[16 + PROBE_B] - MISC[16 + PROBE_A]; F.out[0] += (float)dt * 0.001f; } }
#undef IN
}

#ifndef FUSED_MASK
#define FUSED_MASK 0xFFFu
#endif
constexpr unsigned FUSED = FUSED_MASK;
constexpr size_t WS_ADEC = 168 * MiB, WS_OT = 181 * MiB, WS_BN = 72 * MiB;

extern "C" void kernel_launch(void* const* d_in, const int* in_sizes, int n_in, void* d_out, int out_size, void* d_ws, size_t ws_size, hipStream_t stream) {
    static int grid = 0;
    if (grid == 0) {
        if (n_in != 28 || ws_size < WS_END) { fprintf(stderr, "kernel_launch: unexpected n_in %d / ws %zu\n", n_in, ws_size); grid = -1; return; }
        int dev = 0, cus = 0, per_cu = 0;
        (void)hipGetDevice(&dev);
        (void)hipDeviceGetAttribute(&cus, hipDeviceAttributeMultiprocessorCount, dev);
        (void)hipFuncSetAttribute((const void*)fwd_kernel, hipFuncAttributeMaxDynamicSharedMemorySize, LDS_BYTES);
        (void)hipOccupancyMaxActiveBlocksPerMultiprocessor(&per_cu, (const void*)fwd_kernel, NTHR, LDS_BYTES);
        (void)hipGetLastError();
        if (per_cu < 1) { fprintf(stderr, "kernel_launch: occupancy query reports 0 workgroups per CU\n"); grid = -1; return; }
        grid = cus;
        if (grid > 256) grid = 256;
    }
    if (grid < 0) return;
    (void)hipMemsetAsync((char*)d_ws + WS_CTL, 0, CTL_BYTES, stream);
    Args a{};
    for (int i = 0; i < 28; ++i) a.in[i] = (const float*)d_in[i];
    a.out = (float*)d_out; a.ws = (unsigned char*)d_ws;
    if (ONE_LAUNCH) {
        a.ph_lo = 0; a.ph_hi = 13;
        void* kargs[] = {&a};
        hipError_t e = hipLaunchCooperativeKernel((const void*)fwd_kernel, dim3(grid), dim3(NTHR), kargs, LDS_BYTES, stream);
        if (e != hipSuccess) fprintf(stderr, "kernel_launch: cooperative launch failed: %s (grid %d)\n", hipGetErrorString(e), grid);
        return;
    }
    for (int p = 0; p < 13; ++p) { a.ph_lo = p; a.ph_hi = p + 1; hipLaunchKernelGGL(fwd_kernel, dim3(grid), dim3(NTHR), LDS_BYTES, stream, a); }
}
```

```cpp
#include <hip/hip_runtime.h>
#include <cstdio>
#include <cstdint>

#ifndef PROBE_IDX
#define PROBE_IDX 0
#endif
#ifndef PROBE_A
#define PROBE_A 0
#endif
#ifndef PROBE_B
#define PROBE_B 0
#endif
#ifndef PROBE_BLOCK
#define PROBE_BLOCK 0
#endif
#ifndef PROBE_SPLIT
#define PROBE_SPLIT 0
#endif
#ifndef HOST_REP
#define HOST_REP -1
#endif
#ifndef REP_MASK
#define REP_MASK 0u
#endif
#ifndef ONE_LAUNCH
#define ONE_LAUNCH 1
#endif

#define LAS __attribute__((address_space(3)))
#define GAS __attribute__((address_space(1)))
typedef unsigned short bf16_t;
typedef short bf16x8 __attribute__((ext_vector_type(8)));
typedef short s16x4 __attribute__((ext_vector_type(4)));
typedef float f32x2 __attribute__((ext_vector_type(2)));
typedef float f32x4 __attribute__((ext_vector_type(4)));
typedef float f32x16 __attribute__((ext_vector_type(16)));
typedef unsigned u32x2 __attribute__((ext_vector_type(2)));
typedef unsigned u32x4 __attribute__((ext_vector_type(4)));
typedef __bf16 bf16x2_t __attribute__((ext_vector_type(2)));

constexpr int DM = 1024, NCTX = 4096, NLAT = 2048, MTOK = 6144, DIN = 5152, NU = 5120, DFF = 2816, NUP = 5632;
constexpr int UQ = 0, UK = 256, UV = 512, UR = 1024, UNQ = 1536, UNK = 2048, UNV = 2560, UMG = 3072, UMN = 4096;
constexpr float EPS = 1e-6f;
constexpr float LOG2E = 1.4426950408889634f;
constexpr size_t O_YP = 0, O_YS = 4194304, O_NK = 6291456, O_NV = 8388608, O_SF = 10485760, O_SB = 11010048;
constexpr size_t MiB = 1u << 20;
constexpr size_t WS_CTL = 0, CTL_BYTES = 64 * 1024;
constexpr size_t WS_ADA = 1 * MiB;
constexpr size_t WS_WGO = 2 * MiB;
constexpr size_t WS_WIN = 3 * MiB;
constexpr size_t WS_WZT = 13 * MiB;
constexpr size_t WS_WNO = 14 * MiB;
constexpr size_t WS_WOUT = 15 * MiB;
constexpr size_t WS_WUP = 17 * MiB;
constexpr size_t WS_WDN = 28 * MiB;
constexpr size_t WS_H = 34 * MiB;
constexpr size_t WS_Z = 46 * MiB;
constexpr size_t WS_OG = 47 * MiB;
constexpr size_t WS_ON = 53 * MiB;
constexpr size_t WS_DEC = 59 * MiB;
constexpr size_t WS_QK = 60 * MiB;
constexpr size_t WS_KV = 72 * MiB;
constexpr size_t WS_SS = 84 * MiB;
constexpr size_t WS_MIX = 96 * MiB;
constexpr size_t WS_U = 108 * MiB;
constexpr size_t WS_U2 = 168 * MiB;
constexpr size_t WS_ACT = 108 * MiB;
constexpr size_t WS_PART0 = 205 * MiB, WS_PART1 = 181 * MiB;
constexpr size_t WS_EDGE = 46 * MiB;
constexpr size_t WS_MIXN = 72 * MiB;
constexpr size_t WS_BG = 205 * MiB;
constexpr size_t WS_GATE = 229 * MiB;
constexpr size_t WS_CKB = 253 * MiB, WS_CVB = 254 * MiB;
constexpr size_t WS_END = 255 * MiB;

constexpr int NWAVES = 8, NTHR = 512;
constexpr int LDS_BYTES = 147456;
constexpr int RING_BYTES = 131072;
constexpr int MISC_OFF = RING_BYTES + 12288;

__device__ __forceinline__ unsigned cvtpk(float lo, float hi) { f32x2 v = {lo, hi}; bf16x2_t b = __builtin_convertvector(v, bf16x2_t); return __builtin_bit_cast(unsigned, b); }
__device__ __forceinline__ float bflo(unsigned u) { return __uint_as_float(u << 16); }
__device__ __forceinline__ float bfhi(unsigned u) { return __uint_as_float(u & 0xffff0000u); }
__device__ __forceinline__ float wave_sum(float v) {
#pragma unroll
    for (int o = 1; o < 64; o <<= 1) v += __shfl_xor(v, o);
    return v;
}
__device__ __forceinline__ float sigmoidf_(float x) { return __builtin_amdgcn_rcpf(1.f + __builtin_amdgcn_exp2f(-LOG2E * x)); }
__device__ __forceinline__ float siluf_(float x) { return x * __builtin_amdgcn_rcpf(1.f + __builtin_amdgcn_exp2f(-LOG2E * x)); }
__device__ __forceinline__ int lane_id() { return (int)__builtin_amdgcn_mbcnt_hi(~0u, __builtin_amdgcn_mbcnt_lo(~0u, 0u)); }
__device__ __forceinline__ int crow(int r, int hi) { return (r & 3) + 8 * (r >> 2) + 4 * hi; }
__device__ __forceinline__ s16x4 vtr(const LAS void* p) { typedef short v4i16_t __attribute__((ext_vector_type(4))); return __builtin_bit_cast(s16x4, __builtin_amdgcn_ds_read_tr16_b64_v4i16((LAS v4i16_t*)p)); }
__device__ __forceinline__ bf16x8 cat8(s16x4 lo, s16x4 hi) { return (bf16x8){lo[0], lo[1], lo[2], lo[3], hi[0], hi[1], hi[2], hi[3]}; }
__device__ __forceinline__ void unpack8(u32x4 v, float (&f)[8]) { f[0] = bflo(v.x); f[1] = bfhi(v.x); f[2] = bflo(v.y); f[3] = bfhi(v.y); f[4] = bflo(v.z); f[5] = bfhi(v.z); f[6] = bflo(v.w); f[7] = bfhi(v.w); }
__device__ __forceinline__ u32x4 pack8(const float (&f)[8]) { u32x4 v; v.x = cvtpk(f[0], f[1]); v.y = cvtpk(f[2], f[3]); v.z = cvtpk(f[4], f[5]); v.w = cvtpk(f[6], f[7]); return v; }

struct XcdBarrier { unsigned* bar; unsigned x; volatile LAS unsigned* st; };
__device__ __forceinline__ void xcd_barrier(const XcdBarrier& b);
__device__ __forceinline__ void xcd_barrier_early(const XcdBarrier& b);
namespace pg8 {
constexpr int BM = 256, BK = 64, HALF = 128, HTB = HALF * BK * 2, STAGE_BYTES = 8 * HTB, NXCD = 8, WGM = 8;
__host__ __device__ __forceinline__ int lds_byte(int r, int c) { const int st = (r >> 4) * 2 + (c >> 5), rr = r & 15, cc = c & 31, ob = rr * 64 + cc * 2; return st * 1024 + (ob ^ (((ob >> 9) & 1) << 5)); }
__host__ __device__ __forceinline__ void stage_rc(int b, int& R, int& C) { const int st = b / 1024, sb = b % 1024, swz = sb ^ (((sb >> 9) & 1) << 5); R = (st >> 1) * 16 + swz / 64; C = (st & 1) * 32 + (swz % 64) / 2; }
__host__ __device__ __forceinline__ int perm32(int rho) { const int n = rho >> 4, i = rho & 15; return 8 * (i >> 2) + 4 * n + (i & 3); }

struct Unit { int pm, pn; const char* A; const char* B; int aux; int kt; int chain; unsigned* wait; };
__device__ __forceinline__ const char* uptr(const char* p) { const unsigned long long v = (unsigned long long)p; const unsigned lo = __builtin_amdgcn_readfirstlane((unsigned)v), hi = __builtin_amdgcn_readfirstlane((unsigned)(v >> 32)); return (const char*)(((unsigned long long)hi << 32) | lo); }

struct StaticOrder {
    static constexpr bool VAR_K = false, HOOK = false;
    int nM, nN, nwg, G, c; const char* Ab; const char* Bb; size_t tstepA, tstepB;
    __device__ void init(const void* A, const void* Bt, int M, int N, int lda, int ldb, int G_, int c_) { nM = M / BM; nN = N / BM; nwg = nM * nN; G = G_; c = c_; Ab = (const char*)A; Bb = (const char*)Bt; tstepA = (size_t)BM * lda * 2; tstepB = (size_t)BM * ldb * 2; }
    __device__ bool next(int i, Unit& u) const {
        const long L = (long)i * G + c; if (L >= nwg) return false;
        int wgid = (int)L; { const int q = nwg / NXCD, r = nwg % NXCD, xcd = wgid % NXCD, off = wgid / NXCD; wgid = (xcd < r ? xcd * (q + 1) : r * (q + 1) + (xcd - r) * q) + off; }
        const int nig = WGM * nN, gid = wgid / nig, fm = gid * WGM, gsz = (nM - fm) < WGM ? (nM - fm) : WGM;
        u.pm = fm + ((wgid % nig) % gsz); u.pn = (wgid % nig) / gsz; u.A = Ab + (size_t)u.pm * tstepA; u.B = Bb + (size_t)u.pn * tstepB; u.aux = 0; return true;
    }
};
struct UpOrder {
    static constexpr bool VAR_K = false, HOOK = true;
    int c; const char* Ab; const char* Bb; size_t tstepA, tstepB; XcdBarrier gbar; bool use_bar;
    __device__ __forceinline__ void before_unit(int i) const { if (i == 2 && use_bar) xcd_barrier_early(gbar); }
    __device__ void init(const void* A, const void* Bt, int lda, int ldb, int c_, const XcdBarrier& gb, bool ub) { c = c_; gbar = gb; use_bar = ub; Ab = (const char*)A; Bb = (const char*)Bt; tstepA = (size_t)BM * lda * 2; tstepB = (size_t)BM * ldb * 2; }
    __device__ bool next(int i, Unit& u) const {
        const int x = c & 7, off = (c >> 3) + 32 * i; if (off >= 66) return false;
        if (off < 22) { u.pm = 16 + x; u.pn = off; } else { const int o2 = off - 22; u.pm = 2 * x + (o2 & 1); u.pn = o2 >> 1; }
        u.A = Ab + (size_t)u.pm * tstepA; u.B = Bb + (size_t)u.pn * tstepB; u.aux = 0; return true;
    }
};
struct InOrder {
    static constexpr bool VAR_K = false, HOOK = false;
    int c; const char* Ab; const char* Bb; size_t tstepA, tstepB;
    __device__ void init(const void* A, const void* Bt, int lda, int ldb, int c_) { c = c_; Ab = (const char*)A; Bb = (const char*)Bt; tstepA = (size_t)BM * lda * 2; tstepB = (size_t)BM * ldb * 2; }
    __device__ bool next(int i, Unit& u) const {
        const int x = c & 7, off = (c >> 3) + 32 * i; if (off >= 63) return false;
        u.pm = 3 * x + off % 3; u.pn = off / 3; u.A = Ab + (size_t)u.pm * tstepA; u.B = Bb + (size_t)u.pn * tstepB; u.aux = 0; return true;
    }
};
struct DualOrder {
    static constexpr bool VAR_K = false, HOOK = false;
    int nM, nN, nwg, G, c; const char *A0, *B0, *A1, *B1; size_t tstepA, tstepB;
    __device__ void init(const void* a0, const void* b0, const void* a1, const void* b1, int M, int N, int lda, int ldb, int G_, int c_) { nM = M / BM; nN = N / BM; nwg = nM * nN; G = G_; c = c_;
        A0 = (const char*)a0; B0 = (const char*)b0; A1 = (const char*)a1; B1 = (const char*)b1; tstepA = (size_t)BM * lda * 2; tstepB = (size_t)BM * ldb * 2; }
    __device__ bool next(int i, Unit& u) const {
        int t, aux;
        if (G == 256 && nM == 24 && nN == 4) {
            if (i > 0) return false;
            const int x = c & 7, j = c >> 3; if (j >= 24) return false;
            u.pm = 3 * x + (j >> 3); u.pn = (j & 7) >> 1; aux = j & 1;
        } else {
            const long L = (long)i * G + c; if (L >= 2 * nwg) return false;
            t = (int)(L >> 1); aux = (int)(L & 1); u.pm = t / nN; u.pn = t % nN;
        }
        u.aux = aux;
        u.A = (aux ? A1 : A0) + (size_t)u.pm * tstepA; u.B = (aux ? B1 : B0) + (size_t)u.pn * tstepB; return true;
    }
};

struct DownOrder {
    static constexpr bool VAR_K = true, HOOK = false;
    int c; const char* Ab; const char* Bb; size_t tstepA, tstepB; unsigned* cnt3;
    __device__ void init(const void* A, const void* Bt, int lda, int ldb, int c_, unsigned* c3) { c = c_; Ab = (const char*)A; Bb = (const char*)Bt; tstepA = (size_t)BM * lda * 2; tstepB = (size_t)BM * ldb * 2; cnt3 = c3; }
    __device__ bool next(int i, Unit& u) const {
        const int s = c - 16; if (s < 0 || s >= 192 || i > 1) return false;
        const int x = s & 7, j = s >> 3; u.pm = 3 * x + (j >> 3); u.pn = (j & 7) >> 1; u.aux = j & 1;
        const bool split = u.aux && u.pm < 16; if (i == 1 && !split) return false;
        const int koff = i == 1 ? 2688 : (u.aux ? 1408 : 0); u.kt = split ? (i == 1 ? 2 : 20) : 22; u.chain = split && i == 0; u.wait = u.chain ? cnt3 + u.pm : nullptr;
        u.A = Ab + (size_t)u.pm * tstepA + koff * 2; u.B = Bb + (size_t)u.pn * tstepB + koff * 2; return true;
    }
};

struct EpiBf16 {
    static constexpr bool PERM = true, PERM_A = false;
    bf16_t* O; int ldc;
    bf16_t* O1; bf16_t* G; int gate_pn0;
    float* Zo; int z_pn;
    int qk_pn0; const float* gq; const float* gk; float* outk; float* outv;
    __device__ __forceinline__ void operator()(const f32x4 (&acc)[2][2][4][2], const Unit& u, int wr, int wc, int fr, int fq) const {
        if (u.pn == z_pn) {
            if (wc == 0) { float* zp = Zo + (size_t)(u.pm * BM + wr * 64 + fr) * 32 + 8 * fq;
#pragma unroll
                for (int ai = 0; ai < 2; ++ai)
#pragma unroll
                    for (int m = 0; m < 4; ++m) { *(f32x4*)(zp + (ai * HALF + m * 16) * 32) = acc[ai][0][m][0]; *(f32x4*)(zp + (ai * HALF + m * 16) * 32 + 4) = acc[ai][0][m][1]; } }
            return;
        }
        if (u.pn >= gate_pn0) {
            bf16_t* gp = G + ((size_t)(u.pm * 8 + (u.pn - gate_pn0)) << 16) + ((wr * 4 + wc) * 64 + fq * 16 + fr) * 8;
            const __amdgpu_buffer_rsrc_t rsrcGt = __builtin_amdgcn_make_buffer_rsrc((void*)G, (short)0, (int)(1u << 30), 0x00020000);
#pragma unroll
            for (int ai = 0; ai < 2; ++ai)
#pragma unroll
                for (int m = 0; m < 4; ++m)
#pragma unroll
                    for (int bj = 0; bj < 2; ++bj) { const f32x4 v0 = acc[ai][bj][m][0], v1 = acc[ai][bj][m][1];
                        u32x4 w; w.x = cvtpk(sigmoidf_(v0[0]), sigmoidf_(v0[1])); w.y = cvtpk(sigmoidf_(v0[2]), sigmoidf_(v0[3])); w.z = cvtpk(sigmoidf_(v1[0]), sigmoidf_(v1[1])); w.w = cvtpk(sigmoidf_(v1[2]), sigmoidf_(v1[3]));
                        __builtin_amdgcn_raw_buffer_store_b128(w, rsrcGt, (unsigned)((const char*)(gp + ((ai * 4 + m) * 2 + bj) * 4096) - (const char*)G), 0, 16); }
            return;
        }
        if (qk_pn0 >= 0 && u.pn >= qk_pn0 && u.pn < qk_pn0 + 4) {
            const bool isk = u.pn >= qk_pn0 + 2; const int head = 4 * (u.pn & 1) + wc; const float* g = isk ? gk : gq; const float sc = isk ? 1.f : 0.125f * LOG2E;
            f32x4 gv[2][2];
#pragma unroll
            for (int bj = 0; bj < 2; ++bj)
#pragma unroll
                for (int n = 0; n < 2; ++n) gv[bj][n] = *(const f32x4*)(g + 32 * bj + 8 * fq + 4 * n) * sc;
            const int rowb = u.pm * BM + wr * 64 + fr, colb = (isk ? UNK : UNQ) + 64 * head + 8 * fq;
            const __amdgpu_buffer_rsrc_t rsrcQ = __builtin_amdgcn_make_buffer_rsrc((void*)O, (short)0, (int)(1u << 30), 0x00020000);
#pragma unroll
            for (int ai = 0; ai < 2; ++ai)
#pragma unroll
                for (int m = 0; m < 4; ++m) { float ss = 0.f;
#pragma unroll
                    for (int bj = 0; bj < 2; ++bj)
#pragma unroll
                        for (int n = 0; n < 2; ++n) { const f32x4 v = acc[ai][bj][m][n]; ss += (v[0] * v[0] + v[1] * v[1]) + (v[2] * v[2] + v[3] * v[3]); }
                    { auto r16 = __builtin_amdgcn_permlane16_swap(__float_as_uint(ss), __float_as_uint(ss), false, false); ss = __uint_as_float(r16[0]) + __uint_as_float(r16[1]);
                      auto r32 = __builtin_amdgcn_permlane32_swap(__float_as_uint(ss), __float_as_uint(ss), false, false); ss = __uint_as_float(r32[0]) + __uint_as_float(r32[1]); }
                    const float rinv = __builtin_amdgcn_rsqf(ss * (1.f / 64.f) + EPS); const int row = rowb + ai * HALF + m * 16;
#pragma unroll
                    for (int bj = 0; bj < 2; ++bj) { const f32x4 v0 = acc[ai][bj][m][0] * rinv * gv[bj][0], v1 = acc[ai][bj][m][1] * rinv * gv[bj][1];
                        u32x4 w; w.x = cvtpk(v0[0], v0[1]); w.y = cvtpk(v0[2], v0[3]); w.z = cvtpk(v1[0], v1[1]); w.w = cvtpk(v1[2], v1[3]);
                        __builtin_amdgcn_raw_buffer_store_b128(w, rsrcQ, (unsigned)(((size_t)row * ldc + colb + 32 * bj) * 2), 0, 16);
                        if (isk && row < NCTX) { float* ok = outk + (size_t)row * 512 + 64 * head + 32 * bj + 8 * fq; *(f32x4*)ok = v0; *(f32x4*)(ok + 4) = v1; } } }
            return;
        }
        bf16_t* Ob = u.aux ? O1 : O;
        const __amdgpu_buffer_rsrc_t rsrc = __builtin_amdgcn_make_buffer_rsrc((void*)Ob, (short)0, (int)(1u << 30), 0x00020000);
        const int row0 = u.pm * BM + wr * 64 + fr, col0 = u.pn * BM + wc * 32 + 8 * fq;
        if (qk_pn0 >= 0 && u.pn >= qk_pn0 + 4 && u.pn < qk_pn0 + 6 && u.pm < 16) {
#pragma unroll
            for (int ai = 0; ai < 2; ++ai)
#pragma unroll
                for (int m = 0; m < 4; ++m) { float* ov = outv + (size_t)(row0 + ai * HALF + m * 16) * 512 + (u.pn - qk_pn0 - 4) * BM + wc * 32 + 8 * fq;
#pragma unroll
                    for (int bj = 0; bj < 2; ++bj) { *(f32x4*)(ov + bj * HALF) = acc[ai][bj][m][0]; *(f32x4*)(ov + bj * HALF + 4) = acc[ai][bj][m][1]; } }
        }

#pragma unroll
        for (int ai = 0; ai < 2; ++ai)
#pragma unroll
            for (int m = 0; m < 4; ++m) { bf16_t* rowp = Ob + (size_t)(row0 + ai * HALF + m * 16) * ldc + col0;
#pragma unroll
                for (int bj = 0; bj < 2; ++bj) { const f32x4 v0 = acc[ai][bj][m][0], v1 = acc[ai][bj][m][1];
                    u32x4 w; w.x = cvtpk(v0[0], v0[1]); w.y = cvtpk(v0[2], v0[3]); w.z = cvtpk(v1[0], v1[1]); w.w = cvtpk(v1[2], v1[3]);
                    __builtin_amdgcn_raw_buffer_store_b128(w, rsrc, (unsigned)((const char*)(rowp + bj * HALF) - (const char*)Ob), 0, 16); } }
    }
};
struct EpiPart {
    static constexpr bool PERM = false;
    float* P0; float* P1; int ldc;
    __device__ __forceinline__ void operator()(const f32x4 (&acc)[2][2][4][2], const Unit& u, int wr, int wc, int fr, int fq) const {
        float* P = u.aux ? P1 : P0; const int row0 = u.pm * BM + wr * 64 + fr, col0 = u.pn * BM + wc * 32 + 4 * fq;
#pragma unroll
        for (int ai = 0; ai < 2; ++ai)
#pragma unroll
            for (int m = 0; m < 4; ++m) { float* rowp = P + (size_t)(row0 + ai * HALF + m * 16) * ldc + col0;
#pragma unroll
                for (int bj = 0; bj < 2; ++bj)
#pragma unroll
                    for (int n = 0; n < 2; ++n) *(f32x4*)(rowp + bj * HALF + n * 16) = acc[ai][bj][m][n]; }
    }
};
struct EpiGate {
    static constexpr bool PERM = true, PERM_A = false;
    const bf16_t* G; bf16_t* O0; bf16_t* O1; unsigned* flag; bool heavy;
    __device__ __forceinline__ void operator()(const f32x4 (&acc)[2][2][4][2], const Unit& u, int wr, int wc, int fr, int fq) const {
        const int row0 = u.pm * BM + wr * 64 + fr, col0 = u.pn * BM + wc * 32 + 8 * fq;
        const bf16_t* gp = G + ((size_t)(u.pm * 8 + u.aux * 4 + u.pn) << 16) + ((wr * 4 + wc) * 64 + fq * 16 + fr) * 8;
        bf16_t* Ob = u.aux ? O1 : O0;
        const __amdgpu_buffer_rsrc_t rsrcG = __builtin_amdgcn_make_buffer_rsrc((void*)Ob, (short)0, (int)(1u << 30), 0x00020000);
#pragma unroll
        for (int ai = 0; ai < 2; ++ai)
#pragma unroll
            for (int m = 0; m < 4; ++m) { bf16_t* rowp = Ob + (size_t)(row0 + ai * HALF + m * 16) * DM + col0;
#pragma unroll
                for (int bj = 0; bj < 2; ++bj) { const u32x4 nn = *(const u32x4*)(gp + ((ai * 4 + m) * 2 + bj) * 4096); const unsigned nw[4] = {nn.x, nn.y, nn.z, nn.w};
                    u32x4 w;
                    w.x = cvtpk(acc[ai][bj][m][0][0] * bflo(nw[0]), acc[ai][bj][m][0][1] * bfhi(nw[0])); w.y = cvtpk(acc[ai][bj][m][0][2] * bflo(nw[1]), acc[ai][bj][m][0][3] * bfhi(nw[1]));
                    w.z = cvtpk(acc[ai][bj][m][1][0] * bflo(nw[2]), acc[ai][bj][m][1][1] * bfhi(nw[2])); w.w = cvtpk(acc[ai][bj][m][1][2] * bflo(nw[3]), acc[ai][bj][m][1][3] * bfhi(nw[3]));
                    __builtin_amdgcn_raw_buffer_store_b128(w, rsrcG, (unsigned)((const char*)(rowp + bj * HALF) - (const char*)Ob), 0, 16); } }
        if (flag) { asm volatile("s_waitcnt vmcnt(0)" ::: "memory"); __builtin_amdgcn_s_barrier(); asm volatile("" ::: "memory");
            if (wr == 0 && wc == 0 && fr == 0 && fq == 0) { if (heavy) { __builtin_amdgcn_fence(__ATOMIC_RELEASE, "agent"); asm volatile("s_waitcnt vmcnt(0)" ::: "memory"); } __hip_atomic_fetch_add(flag + u.pm * 2 + u.aux, 1u, __ATOMIC_RELAXED, __HIP_MEMORY_SCOPE_AGENT); } }
    }
};

struct EpiConv {
    static constexpr bool PERM = true, PERM_A = true;
    bf16_t* ACT; const float* wcv; const float* bcv; LAS float* edge;
    float* EG; unsigned* flag;
    unsigned* cnt3;
    __device__ __forceinline__ void operator()(const f32x4 (&acc)[2][2][4][2], const Unit& u, int wr, int wc, int fr, int fq) const {
        const int row0 = u.pm * BM + wr * 64 + 4 * fr;
        LAS float* halo = edge + 3584;
        { int t0_ = (wr * 4 + wc) * 64 + fq * 16 + fr; asm volatile("" : "+v"(t0_)); const char* pc_ = (const char*)__builtin_amdgcn_s_getpc() + (size_t)t0_ * 64; __builtin_amdgcn_global_load_lds((const unsigned*)pc_, (LAS unsigned*)(edge + 3328), 4, 0, 0); }
        LAS float* W4 = edge + 2048;
        { int t_ = (wr * 4 + wc) * 64 + fq * 16 + fr; asm volatile("" : "+v"(t_)); halo[t_] = 0.f; if (t_ < 256) { const int cw = (t_ >> 7) * DFF + u.pn * HALF + (t_ & 127); *(LAS f32x4*)(W4 + 4 * t_) = (f32x4){wcv[cw], wcv[NUP + cw], wcv[2 * NUP + cw], bcv[cw]}; } }
#pragma unroll
        for (int ai = 0; ai < 2; ++ai) { const int seg = 2 * ai + wr;
            if (fr == 0 || fr == 15) { LAS float* ep = edge + ((wc * 4 + seg) * 2 + (fr == 15 ? 1 : 0)) * 64 + 8 * fq;
#pragma unroll
                for (int bj = 0; bj < 2; ++bj) { *(LAS f32x4*)(ep + bj * 32) = fr == 15 ? acc[ai][bj][3][0] : acc[ai][bj][0][0]; *(LAS f32x4*)(ep + bj * 32 + 4) = fr == 15 ? acc[ai][bj][3][1] : acc[ai][bj][0][1]; } } }
        asm volatile("s_waitcnt vmcnt(0) lgkmcnt(0)" ::: "memory"); __builtin_amdgcn_s_barrier(); asm volatile("" ::: "memory");
        if (u.pm >= 16) {
            const int pl = u.pm - 16, tl = pl * 22 + u.pn; const bool hasUp = (pl & 3) != 0, hasDn = (pl & 3) != 3;
            int t2 = (wr * 4 + wc) * 64 + fq * 16 + fr; asm volatile("" : "+v"(t2));
            const int which = t2 >> 8, e256 = t2 & 255;
            __hip_atomic_store(EG + ((size_t)tl * 2 + which) * 256 + e256, edge[(((e256 >> 6) * 4 + (which ? 3 : 0)) * 2 + which) * 64 + (e256 & 63)], __ATOMIC_RELAXED, __HIP_MEMORY_SCOPE_AGENT);
            asm volatile("s_waitcnt vmcnt(0)" ::: "memory"); __builtin_amdgcn_s_barrier(); asm volatile("" ::: "memory");
            if (t2 == 0) { __hip_atomic_fetch_add(flag + tl, 1u, __ATOMIC_RELAXED, __HIP_MEMORY_SCOPE_AGENT);
                unsigned sp = 0;
                if (hasUp) while (__hip_atomic_load(flag + tl - 22, __ATOMIC_RELAXED, __HIP_MEMORY_SCOPE_AGENT) == 0u) { __builtin_amdgcn_s_sleep(1); if (++sp > (1u << 22)) break; }
                if (hasDn) while (__hip_atomic_load(flag + tl + 22, __ATOMIC_RELAXED, __HIP_MEMORY_SCOPE_AGENT) == 0u) { __builtin_amdgcn_s_sleep(1); if (++sp > (1u << 22)) break; }
                }
            __builtin_amdgcn_s_barrier(); asm volatile("" ::: "memory");
            { const char* pc_ = (const char*)__builtin_amdgcn_s_getpc() + (size_t)t2 * 64; __builtin_amdgcn_global_load_lds((const unsigned*)pc_, (LAS unsigned*)(edge + 3328), 4, 0, 0); }
            if (which ? hasDn : hasUp) halo[t2] = __hip_atomic_load(EG + ((size_t)(tl + (which ? 22 : -22)) * 2 + (which ? 0 : 1)) * 256 + e256, __ATOMIC_RELAXED, __HIP_MEMORY_SCOPE_AGENT);
            asm volatile("s_waitcnt vmcnt(0) lgkmcnt(0)" ::: "memory"); __builtin_amdgcn_s_barrier(); asm volatile("" ::: "memory");
        }
        const int ch0 = u.pn * HALF + wc * 32 + 8 * fq;
        const __amdgpu_buffer_rsrc_t rsrcA = __builtin_amdgcn_make_buffer_rsrc((void*)ACT, (short)0, (int)(1u << 30), 0x00020000);
#define DPPF(oldv, srcv, ctrl) __builtin_bit_cast(float, __builtin_amdgcn_update_dpp(__builtin_bit_cast(int, (float)(oldv)), __builtin_bit_cast(int, (float)(srcv)), (ctrl), 0xf, 0xf, false))
#define CONV4(AI, BJ, N, E, O) { const f32x4 w_ = *(const LAS f32x4*)(W4 + 4 * ((BJ) * 128 + wc * 32 + 8 * fq + 4 * (N) + (E))); const int slot_ = (BJ) * 32 + 8 * fq + 4 * (N) + (E); \
            const float v0_ = acc[AI][BJ][0][N][E], v1_ = acc[AI][BJ][1][N][E], v2_ = acc[AI][BJ][2][N][E], v3_ = acc[AI][BJ][3][N][E]; \
            const float upo_ = (seg_ > 0 ? edge + ((wc * 4 + seg_ - 1) * 2 + 1) * 64 : halo + wc * 64)[slot_], dno_ = (seg_ < 3 ? edge + ((wc * 4 + seg_ + 1) * 2 + 0) * 64 : halo + 256 + wc * 64)[slot_]; \
            const float up_ = DPPF(upo_, v3_, 0x111), dn_ = DPPF(dno_, v0_, 0x101); \
            O[0] = w_[3] + w_[0] * up_ + w_[1] * v0_ + w_[2] * v1_; O[1] = w_[3] + w_[0] * v0_ + w_[1] * v1_ + w_[2] * v2_; \
            O[2] = w_[3] + w_[0] * v1_ + w_[1] * v2_ + w_[2] * v3_; O[3] = w_[3] + w_[0] * v2_ + w_[1] * v3_ + w_[2] * dn_; }
#define PAIR4(AI, N, E, O) { float a_[4], g_[4]; CONV4(AI, 0, N, E, a_) CONV4(AI, 1, N, E, g_) _Pragma("unroll") for (int m_ = 0; m_ < 4; ++m_) O[m_] = a_[m_] * siluf_(g_[m_]); }
#define HALF_TILE(AI) { const int seg_ = 2 * (AI) + wr; u32x4 pk_[4]; float oa_[4], ob_[4]; \
            PAIR4(AI, 0, 0, oa_) PAIR4(AI, 0, 1, ob_) _Pragma("unroll") for (int m_ = 0; m_ < 4; ++m_) pk_[m_].x = cvtpk(oa_[m_], ob_[m_]); \
            PAIR4(AI, 0, 2, oa_) PAIR4(AI, 0, 3, ob_) _Pragma("unroll") for (int m_ = 0; m_ < 4; ++m_) pk_[m_].y = cvtpk(oa_[m_], ob_[m_]); \
            PAIR4(AI, 1, 0, oa_) PAIR4(AI, 1, 1, ob_) _Pragma("unroll") for (int m_ = 0; m_ < 4; ++m_) pk_[m_].z = cvtpk(oa_[m_], ob_[m_]); \
            PAIR4(AI, 1, 2, oa_) PAIR4(AI, 1, 3, ob_) _Pragma("unroll") for (int m_ = 0; m_ < 4; ++m_) pk_[m_].w = cvtpk(oa_[m_], ob_[m_]); \
            _Pragma("unroll") for (int m_ = 0; m_ < 4; ++m_) __builtin_amdgcn_raw_buffer_store_b128(pk_[m_], rsrcA, (unsigned)(((size_t)(row0 + (AI) * HALF + m_) * DFF + ch0) * 2), 0, 16); asm volatile("" ::: "memory"); }
        HALF_TILE(0) HALF_TILE(1)
        if (u.pn == 21 && u.pm < 16) {
            asm volatile("s_waitcnt vmcnt(0)" ::: "memory"); __builtin_amdgcn_s_barrier(); asm volatile("" ::: "memory");
            if (wr == 0 && wc == 0 && fr == 0 && fq == 0) { __builtin_amdgcn_fence(__ATOMIC_RELEASE, "agent"); asm volatile("s_waitcnt vmcnt(0)" ::: "memory"); __hip_atomic_fetch_add(cnt3 + u.pm, 8u, __ATOMIC_RELAXED, __HIP_MEMORY_SCOPE_AGENT); } }
#undef HALF_TILE
#undef PAIR4
#undef CONV4
#undef DPPF
    }
};

template <class Epi, class Sched>
__device__ __forceinline__ void gemm_phase(LAS unsigned char* lds, const int wid, const int K, const int lda, const int ldb, const Sched& S, const Epi& E) {
    int wr, wc, fr, fq; unsigned voffA[2], voffB[2], ldsw; int aoff, boff;
#define PG8_LANE_SETUP() do { int lane = lane_id(); asm volatile("" : "+v"(lane)); const int tid = wid * 64 + lane; wr = wid >> 2; wc = wid & 3; fr = lane & 15; fq = lane >> 4; \
        _Pragma("unroll") for (int i = 0; i < 2; ++i) { int R, C; stage_rc(tid * 16 + i * 8192, R, C); const int Rb = Epi::PERM ? ((R & ~31) + perm32(R & 31)) : R; \
            const int Ra = Epi::PERM_A ? ((R & ~63) + 4 * (R & 15) + ((R & 63) >> 4)) : R; \
            voffA[i] = (unsigned)(Ra * lda + C) * 2u; voffB[i] = (unsigned)(Rb * ldb + C) * 2u; } \
        ldsw = (unsigned)wid * 1024u; aoff = lds_byte(wr * 64 + fr, fq * 8); boff = lds_byte(wc * 32 + fr, fq * 8); } while (0)
    PG8_LANE_SETUP();
    if (!Sched::VAR_K || wid < 2) { const char* pc_ = (const char*)__builtin_amdgcn_s_getpc() + (size_t)(wid * 64 + lane_id()) * 64;
      __builtin_amdgcn_global_load_lds((const unsigned*)pc_, (LAS unsigned*)(lds + MISC_OFF + 1024), 4, 0, 0); }
    const size_t kstep = (size_t)(BK * 2);
    const size_t hstepA = (size_t)HALF * lda * 2, hstepB = (size_t)HALF * ldb * 2;
#define PG8_SA(b, h) (((b) * 2 + (h)) * HTB)
#define PG8_SB(b, h) ((4 + (b) * 2 + (h)) * HTB)
#define PG8_STAGE(bufoff, gbase, voff) do { _Pragma("unroll") for (int _i = 0; _i < 2; ++_i) \
        __builtin_amdgcn_global_load_lds((const unsigned*)((const char*)(gbase) + (voff)[_i]), (LAS unsigned*)(lds + (bufoff) + ldsw + _i * 8192), 16, 0, 0); } while (0)
#define PG8_LDA(dst, b, h) do { _Pragma("unroll") for (int m = 0; m < 4; ++m) _Pragma("unroll") for (int k = 0; k < 2; ++k) dst[m][k] = *(const LAS bf16x8*)(lds + PG8_SA(b, h) + aoff + m * 2048 + k * 1024); } while (0)
#define PG8_LDB(dst, b, h) do { _Pragma("unroll") for (int n = 0; n < 2; ++n) _Pragma("unroll") for (int k = 0; k < 2; ++k) dst[n][k] = *(const LAS bf16x8*)(lds + PG8_SB(b, h) + boff + n * 2048 + k * 1024); } while (0)
#define PG8_MMA(ai, bj, At, Bt) do { __builtin_amdgcn_s_setprio(1); _Pragma("unroll") for (int m = 0; m < 4; ++m) _Pragma("unroll") for (int n = 0; n < 2; ++n) _Pragma("unroll") for (int k = 0; k < 2; ++k) \
        acc[ai][bj][m][n] = __builtin_amdgcn_mfma_f32_16x16x32_bf16(Bt[n][k], At[m][k], acc[ai][bj][m][n], 0, 0, 0); __builtin_amdgcn_s_setprio(0); } while (0)
#define PG8_WAIT_V(n) asm volatile("s_waitcnt vmcnt(" #n ")" ::: "memory")
#define PG8_WAIT_L(n) asm volatile("s_waitcnt lgkmcnt(" #n ")" ::: "memory")
#define PG8_BAR __builtin_amdgcn_s_barrier()
#define PG8_SCHED __builtin_amdgcn_sched_barrier(0)
    Unit cur, nxt; int ui = 0;
    if (!S.next(0, cur)) return;
    int nt = Sched::VAR_K ? cur.kt : K / BK;
    f32x4 acc[2][2][4][2];
#pragma unroll
    for (int a = 0; a < 2; ++a)
#pragma unroll
        for (int b = 0; b < 2; ++b)
#pragma unroll
            for (int m = 0; m < 4; ++m)
#pragma unroll
                for (int n = 0; n < 2; ++n) acc[a][b][m][n] = (f32x4){0.f, 0.f, 0.f, 0.f};
    bf16x8 At[4][2], B0[2][2], B1[2][2];
    const char* cA = uptr(cur.A); const char* cB = uptr(cur.B);
    PG8_STAGE(PG8_SB(0, 0), cB, voffB); PG8_STAGE(PG8_SB(0, 1), cB + hstepB, voffB); PG8_STAGE(PG8_SA(0, 0), cA, voffA); PG8_STAGE(PG8_SA(0, 1), cA + hstepA, voffA);
    if (wr == 1) PG8_BAR;
    PG8_WAIT_V(2); PG8_BAR;
    PG8_STAGE(PG8_SB(1, 0), cB + kstep, voffB); PG8_STAGE(PG8_SA(1, 0), cA + kstep, voffA); PG8_STAGE(PG8_SB(1, 1), cB + hstepB + kstep, voffB);
    PG8_WAIT_V(6); PG8_BAR;
    for (;;) {
        if (ui > 0) PG8_LANE_SETUP();
        const bool has_next = S.next(ui + 1, nxt);
        const char* nA = uptr(has_next ? nxt.A : cA); const char* nB = uptr(has_next ? nxt.B : cB);
        for (int t = 0; t < nt; t += 2) {
            const bool last = (t == nt - 2);
            if constexpr (Sched::VAR_K) { if (last && cur.wait && wid == 0) {
                unsigned sp_ = 0; while (__hip_atomic_load(cur.wait, __ATOMIC_RELAXED, __HIP_MEMORY_SCOPE_AGENT) < 8u) { __builtin_amdgcn_s_sleep(1); if (++sp_ > (1u << 22)) break; }
                __builtin_amdgcn_fence(__ATOMIC_ACQUIRE, "agent"); asm volatile("s_waitcnt vmcnt(0)" ::: "memory"); } }
            const char* a1 = cA + (size_t)(t + 1) * kstep;
            const char* a2 = last ? nA : cA + (size_t)(t + 2) * kstep; const char* b2 = last ? nB : cB + (size_t)(t + 2) * kstep;
            const char* a3 = a2 + kstep; const char* b3 = b2 + kstep;
            PG8_LDB(B0, 0, 0); PG8_LDB(B1, 0, 1); PG8_SCHED; PG8_LDA(At, 0, 0); PG8_STAGE(PG8_SA(1, 1), a1 + hstepA, voffA);
            PG8_WAIT_V(8); PG8_WAIT_L(0); PG8_BAR; PG8_MMA(0, 0, At, B0); PG8_MMA(0, 1, At, B1); PG8_BAR; PG8_SCHED;
            PG8_LDA(At, 0, 1); PG8_STAGE(PG8_SB(0, 0), b2, voffB); PG8_STAGE(PG8_SB(0, 1), b2 + hstepB, voffB); PG8_STAGE(PG8_SA(0, 0), a2, voffA);
            PG8_WAIT_V(8); PG8_WAIT_L(0); PG8_BAR; PG8_MMA(1, 0, At, B0); PG8_MMA(1, 1, At, B1); PG8_BAR; PG8_SCHED;
            PG8_LDB(B0, 1, 0); PG8_LDB(B1, 1, 1); PG8_SCHED; PG8_LDA(At, 1, 0); PG8_STAGE(PG8_SA(0, 1), a2 + hstepA, voffA);
            PG8_WAIT_V(8); PG8_WAIT_L(0); PG8_BAR; PG8_MMA(0, 0, At, B0); PG8_MMA(0, 1, At, B1); PG8_BAR; PG8_SCHED;
            PG8_LDA(At, 1, 1); PG8_STAGE(PG8_SB(1, 0), b3, voffB); PG8_STAGE(PG8_SB(1, 1), b3 + hstepB, voffB); PG8_STAGE(PG8_SA(1, 0), a3, voffA);
            PG8_WAIT_V(8); PG8_WAIT_L(0); PG8_BAR; PG8_MMA(1, 0, At, B0); PG8_MMA(1, 1, At, B1); PG8_BAR; PG8_SCHED;
        }
        bool chained = false;
        if constexpr (Sched::VAR_K) chained = cur.chain != 0;
        if (!chained) {
        if (wr == 0) PG8_BAR;
        E(acc, cur, wr, wc, fr, fq);
#pragma unroll
        for (int a = 0; a < 2; ++a)
#pragma unroll
            for (int b = 0; b < 2; ++b)
#pragma unroll
                for (int m = 0; m < 4; ++m)
#pragma unroll
                    for (int n = 0; n < 2; ++n) acc[a][b][m][n] = (f32x4){0.f, 0.f, 0.f, 0.f};
        }
        if (!has_next) break;
        cur = nxt; cA = nA; cB = nB; ++ui;
        if constexpr (Sched::VAR_K) nt = cur.kt;
        if constexpr (Sched::HOOK) S.before_unit(ui);
        if (!chained) { if (wr == 1) PG8_BAR; }
    }
    PG8_WAIT_V(0);
    PG8_BAR;
#undef PG8_LANE_SETUP
#undef PG8_SA
#undef PG8_SB
#undef PG8_STAGE
#undef PG8_LDA
#undef PG8_LDB
#undef PG8_MMA
#undef PG8_WAIT_V
#undef PG8_WAIT_L
#undef PG8_BAR
#undef PG8_SCHED
}
}

#define XB_TMO      128
#define XB_XCNT(j)  (256  + 64 * (j))
#define XB_XSUB(j)  (1280 + 64 * (j))
#define XB_XGEN(j)  (2304 + 64 * (j))
#define XB_TOP      3328
#define XB_TOPGEN   3392
#define XCD_BAR_WORDS 3456
#define XB_SPIN_CAP (1u << 22)
__device__ __forceinline__ unsigned xb_ld(unsigned* p)              { return __hip_atomic_load(p, __ATOMIC_RELAXED, __HIP_MEMORY_SCOPE_AGENT); }
__device__ __forceinline__ unsigned xb_add(unsigned* p, unsigned v) { return __hip_atomic_fetch_add(p, v, __ATOMIC_RELAXED, __HIP_MEMORY_SCOPE_AGENT); }
__device__ __forceinline__ unsigned xb_xcc_id() { return (unsigned)__builtin_amdgcn_s_getreg((3 << 11) | 20) & 0xFu; }
#define XB_SPIN(cond, bar) do { unsigned _sp = 0; while (cond) { __builtin_amdgcn_s_sleep(1); \
    if ((++_sp & 255u) == 0u) { if (xb_ld(&(bar)[XB_TMO])) break; if (_sp > XB_SPIN_CAP) { atomicAdd(&(bar)[XB_TMO], 1u); break; } } } } while (0)
__device__ __forceinline__ XcdBarrier xcd_barrier_post(unsigned* bar, volatile LAS unsigned* st) {
    XcdBarrier b; b.bar = bar; b.x = xb_xcc_id(); b.st = st;
    if (threadIdx.x == 0) (void)xb_add(&bar[XB_XCNT(b.x)], 1u);
    return b;
}
__device__ __forceinline__ void xcd_barrier_complete(unsigned* bar, unsigned x, unsigned& nloc, unsigned& nx) {
    const unsigned G = gridDim.x * gridDim.y * gridDim.z;
    unsigned sum, cnt, mine, sp = 0u;
    for (;;) {
        sum = 0u; cnt = 0u; mine = 0u;
#pragma unroll
        for (unsigned j = 0; j < 16; ++j) { const unsigned c = xb_ld(&bar[XB_XCNT(j)]); sum += c; cnt += (c > 0u) ? 1u : 0u; mine = (j == x) ? c : mine; }
        if (sum == G) break;
        __builtin_amdgcn_s_sleep(1);
        if ((++sp & 255u) == 0u) { if (xb_ld(&bar[XB_TMO])) break; if (sp > XB_SPIN_CAP) { atomicAdd(&bar[XB_TMO], 1u); break; } }
    }
    nloc = mine > 0u ? mine : 1u; nx = cnt > 0u ? cnt : 1u;
}
template <int PT_N = 0>
__device__ __forceinline__ void xcd_barrier_pt(const XcdBarrier& b, LAS unsigned* dummy) {
    asm volatile("s_waitcnt vmcnt(0)" ::: "memory");
    __syncthreads();
    if (PT_N > 0) { const int i_ = (int)threadIdx.x - 64;
        if (i_ >= 0 && i_ < PT_N) __builtin_amdgcn_global_load_lds((const unsigned*)((const char*)__builtin_amdgcn_s_getpc() + (size_t)i_ * 128), dummy, 4, 0, 0); }
    if (threadIdx.x == 0) {
        unsigned* bar = b.bar;
        __builtin_amdgcn_s_waitcnt(0);
        unsigned nloc = b.st[0], nx = b.st[1];
        if (nloc == 0u) { xcd_barrier_complete(bar, b.x, nloc, nx); b.st[0] = nloc; b.st[1] = nx; }
        const unsigned old = xb_add(&bar[XB_XSUB(b.x)], 1u);
        const unsigned gen = old / nloc;
        if (old + 1u == (gen + 1u) * nloc) {
            __builtin_amdgcn_fence(__ATOMIC_RELEASE, "agent");
            asm volatile("s_waitcnt vmcnt(0)" ::: "memory");
            const unsigned og = xb_add(&bar[XB_TOP], 1u);
            const unsigned tg = og / nx;
            if (og + 1u != (tg + 1u) * nx) XB_SPIN(xb_ld(&bar[XB_TOP]) < (tg + 1u) * nx, bar);
            __builtin_amdgcn_fence(__ATOMIC_ACQUIRE, "agent");
            xb_add(&bar[XB_XGEN(b.x)], 1u);
            asm volatile("s_waitcnt vmcnt(0)" ::: "memory");
        } else {
            XB_SPIN(xb_ld(&bar[XB_XGEN(b.x)]) == gen, bar);
            __builtin_amdgcn_fence(__ATOMIC_ACQUIRE, "agent");
            asm volatile("s_waitcnt vmcnt(0)" ::: "memory");
        }
    }
    __syncthreads();
}

__device__ __forceinline__ void xcd_barrier(const XcdBarrier& b) { xcd_barrier_pt<0>(b, nullptr); }
__device__ __forceinline__ void xcd_barrier_early(const XcdBarrier& b) {
    asm volatile("s_waitcnt vmcnt(0)" ::: "memory");
    __syncthreads();
    if (threadIdx.x == 0) {
        unsigned* bar = b.bar;
        __builtin_amdgcn_s_waitcnt(0);
        unsigned nloc = b.st[0], nx = b.st[1];
        if (nloc == 0u) { xcd_barrier_complete(bar, b.x, nloc, nx); b.st[0] = nloc; b.st[1] = nx; }
        const unsigned old = xb_add(&bar[XB_XSUB(b.x)], 1u);
        const unsigned gen = old / nloc;
        if (old + 1u == (gen + 1u) * nloc) {
            __builtin_amdgcn_fence(__ATOMIC_RELEASE, "agent");
            asm volatile("s_waitcnt vmcnt(0)" ::: "memory");
            const unsigned og = xb_add(&bar[XB_TOP], 1u);
            const unsigned tg = og / nx;
            if (og + 1u != (tg + 1u) * nx) XB_SPIN(xb_ld(&bar[XB_TOP]) < (tg + 1u) * nx, bar);
            __builtin_amdgcn_fence(__ATOMIC_ACQUIRE, "agent");
            xb_add(&bar[XB_XGEN(b.x)], 1u);
            asm volatile("s_waitcnt vmcnt(0)" ::: "memory");
            b.st[2] = 0u;
        } else b.st[2] = gen + 1u;
    }
    __syncthreads();
}
__device__ __forceinline__ void xcd_barrier_finish(const XcdBarrier& b) {
    if (threadIdx.x == 0) {
        const unsigned pend = b.st[2];
        if (pend) { XB_SPIN(xb_ld(&b.bar[XB_XGEN(b.x)]) == pend - 1u, b.bar); __builtin_amdgcn_fence(__ATOMIC_ACQUIRE, "agent"); asm volatile("s_waitcnt vmcnt(0)" ::: "memory"); b.st[2] = 0u; }
    }
    __syncthreads();
}

struct Frame {
    LAS unsigned char* lds;
    int tid, lane, wave, G, bid;
    const float* in[28];
    float* out; unsigned char* ws;
    __device__ __forceinline__ const float* xrow(int m) const { return m < NCTX ? in[0] + (size_t)m * DM : in[1] + (size_t)(m - NCTX) * DM; }
};
__device__ __forceinline__ int cond_of(int m) { return m < NCTX ? 0 : 1 + ((m - NCTX) >> 10); }

__device__ __forceinline__ void st_wt16(Frame& F, const void* p, u32x4 v) {
    const __amdgpu_buffer_rsrc_t rsrc = __builtin_amdgcn_make_buffer_rsrc((void*)F.ws, (short)0, (int)WS_END, 0x00020000);
    __builtin_amdgcn_raw_buffer_store_b128(v, rsrc, (unsigned)((const unsigned char*)p - F.ws), 0, 16); }
__device__ __forceinline__ void st_wt8(void* p, u32x2 v) { __hip_atomic_store((unsigned long long*)p, (unsigned long long)v.x | ((unsigned long long)v.y << 32), __ATOMIC_RELAXED, __HIP_MEMORY_SCOPE_AGENT); }
__device__ __forceinline__ void st_wt4(float* p, float v) { __hip_atomic_store(p, v, __ATOMIC_RELAXED, __HIP_MEMORY_SCOPE_AGENT); }
__device__ __forceinline__ u32x4 ld_sc1_16(Frame& F, const void* p) { const __amdgpu_buffer_rsrc_t rsrc = __builtin_amdgcn_make_buffer_rsrc((void*)F.ws, (short)0, (int)WS_END, 0x00020000);
    return __builtin_amdgcn_raw_buffer_load_b128(rsrc, (unsigned)((const unsigned char*)p - F.ws), 0, 16); }
__device__ __forceinline__ u32x2 ld_sc1_8(Frame& F, const void* p) { const __amdgpu_buffer_rsrc_t rsrc = __builtin_amdgcn_make_buffer_rsrc((void*)F.ws, (short)0, (int)WS_END, 0x00020000);
    return __builtin_amdgcn_raw_buffer_load_b64(rsrc, (unsigned)((const unsigned char*)p - F.ws), 0, 16); }
__device__ __forceinline__ float ld_sc1_4(Frame& F, const void* p) { const __amdgpu_buffer_rsrc_t rsrc = __builtin_amdgcn_make_buffer_rsrc((void*)F.ws, (short)0, (int)WS_END, 0x00020000);
    return __builtin_bit_cast(float, __builtin_amdgcn_raw_buffer_load_b32(rsrc, (unsigned)((const unsigned char*)p - F.ws), 0, 16)); }
__device__ __forceinline__ void wait_count_na(Frame& F, unsigned* cnt, unsigned want) {
    if (F.tid == 0) { unsigned sp = 0; while (__hip_atomic_load(cnt, __ATOMIC_RELAXED, __HIP_MEMORY_SCOPE_AGENT) < want) { __builtin_amdgcn_s_sleep(1); if (++sp > (1u << 23)) break; } }
    __syncthreads();
}
__device__ __forceinline__ void signal_done(Frame& F, unsigned* cnt) {
    asm volatile("s_waitcnt vmcnt(0)" ::: "memory"); __syncthreads();
    if (F.tid == 0) __hip_atomic_fetch_add(cnt, 1u, __ATOMIC_RELAXED, __HIP_MEMORY_SCOPE_AGENT);
}
__device__ __forceinline__ void wait_count(Frame& F, unsigned* cnt, unsigned want) {
    if (F.tid == 0) { unsigned sp = 0; while (__hip_atomic_load(cnt, __ATOMIC_RELAXED, __HIP_MEMORY_SCOPE_AGENT) < want) { __builtin_amdgcn_s_sleep(1); if (++sp > (1u << 23)) break; }
        __builtin_amdgcn_fence(__ATOMIC_ACQUIRE, "agent"); asm volatile("s_waitcnt vmcnt(0)" ::: "memory"); }
    __syncthreads();
    { const char* pc_ = (const char*)__builtin_amdgcn_s_getpc() + (size_t)(F.wave * 64 + lane_id()) * 64; __builtin_amdgcn_global_load_lds((const unsigned*)pc_, (LAS unsigned*)(F.lds + MISC_OFF + 1024), 4, 0, 0); }
}
__device__ __forceinline__ int chain_ctr(int gc, int h) { const int seq = gc < 64 ? (gc >> 2) : 16 + ((gc - 64) >> 4); return seq * 4 + h; }

__device__ __forceinline__ void p0_transpose_item(const float* W, int N, int K, bf16_t* WT, int k0, int n0, int drow0, LAS float* scr, int lane) {
#pragma unroll 8
    for (int i = 0; i < 32; ++i) { const int kk = 2 * i + (lane >> 5); scr[kk * 33 + (lane & 31)] = W[(size_t)(k0 + kk) * N + n0 + (lane & 31)]; }
    asm volatile("s_waitcnt lgkmcnt(0)" ::: "memory");
    const int c = lane & 7;
#pragma unroll
    for (int j = 0; j < 4; ++j) { const int n = (lane >> 3) + 8 * j; const LAS float* s = scr + (8 * c) * 33 + n;
        u32x4 o; o.x = cvtpk(s[0 * 33], s[1 * 33]); o.y = cvtpk(s[2 * 33], s[3 * 33]); o.z = cvtpk(s[4 * 33], s[5 * 33]); o.w = cvtpk(s[6 * 33], s[7 * 33]);
        *(u32x4*)(WT + (size_t)(drow0 + n) * K + k0 + 8 * c) = o; }
    asm volatile("s_waitcnt lgkmcnt(0)" ::: "memory");
}
constexpr int I_IN = 16 * 161, I_GO = 8 * 32, I_NO = 8 * 32, I_OUT = 16 * 32, I_UP = 16 * 176, I_DN = 44 * 32;
constexpr int I_EARLY = I_IN + I_GO + I_NO + I_OUT, I_LATE = I_UP + I_DN;
__device__ __forceinline__ void p0_transposes(Frame& F, int first, int count, int worker, int nworkers) {
    LAS float* scr = (LAS float*)(F.lds + F.wave * 16384);
    for (int it = first + worker; it < first + count; it += nworkers) {
        int r = it;
        if (r < I_IN) { const int kb = r / 161, nb = r % 161;
            if (nb == 48) p0_transpose_item(F.in[11], DIN, 1024, (bf16_t*)(F.ws + WS_WZT), 64 * kb, 32 * nb, 0, scr, F.lane);
            else { int dr = 32 * nb - (nb > 48 ? 32 : 0);
                if (dr >= UNQ && dr < UNV) { const int t0 = dr & ~255, hh = (dr & 255) >> 6; dr = t0 + ((dr & 32) ? 128 + 32 * hh : 32 * hh); }
                p0_transpose_item(F.in[11], DIN, 1024, (bf16_t*)(F.ws + WS_WIN), 64 * kb, 32 * nb, dr, scr, F.lane); }
            continue; } r -= I_IN;
        if (r < I_GO) { p0_transpose_item(F.in[20], 1024, 512, (bf16_t*)(F.ws + WS_WGO), 64 * (r / 32), 32 * (r % 32), 32 * (r % 32), scr, F.lane); continue; } r -= I_GO;
        if (r < I_NO) { p0_transpose_item(F.in[21], 1024, 512, (bf16_t*)(F.ws + WS_WNO), 64 * (r / 32), 32 * (r % 32), 32 * (r % 32), scr, F.lane); continue; } r -= I_NO;
        if (r < I_OUT) { p0_transpose_item(F.in[22], 1024, 1024, (bf16_t*)(F.ws + WS_WOUT), 64 * (r / 32), 32 * (r % 32), 32 * (r % 32), scr, F.lane); continue; } r -= I_OUT;
        if (r < I_UP) { const int n0 = 32 * (r % 176), c0 = n0 % DFF; p0_transpose_item(F.in[24], NUP, 1024, (bf16_t*)(F.ws + WS_WUP), 64 * (r / 176), n0, 256 * (c0 / 128) + (c0 % 128) + (n0 >= DFF ? 128 : 0), scr, F.lane); continue; } r -= I_UP;
        p0_transpose_item(F.in[27], 1024, DFF, (bf16_t*)(F.ws + WS_WDN), 64 * (r / 32), 32 * (r % 32), 32 * (r % 32), scr, F.lane);
    }
}
__device__ __forceinline__ void p0_prologue(Frame& F) {
    {
        LAS float* sc = (LAS float*)(F.lds);
        LAS float* red = (LAS float*)(F.lds + 12288);
        for (int i = F.tid; i < 3072; i += NTHR) { const int c = i >> 10, k = i & 1023; const float v = c == 0 ? F.in[7][k] : F.in[2][(c - 1) * 1024 + k]; sc[i] = siluf_(v); }
        __syncthreads();
        const float* wada = F.in[8]; const float* bada = F.in[9]; float* ada = (float*)(F.ws + WS_ADA);
        for (int cb = F.bid; cb < 256; cb += F.G) {
            if (F.tid < 384) {
                const int cq = F.tid % 6, kg = F.tid / 6;
                f32x4 a0 = {0.f, 0.f, 0.f, 0.f}, a1 = a0, a2 = a0;
#pragma unroll 4
                for (int kk = 0; kk < 16; ++kk) { const int k = 16 * kg + kk; const f32x4 w = *(const f32x4*)(wada + (size_t)k * 6144 + 24 * cb + 4 * cq);
                    a0 += w * sc[k]; a1 += w * sc[1024 + k]; a2 += w * sc[2048 + k]; }
#pragma unroll
                for (int e = 0; e < 4; ++e) { red[(0 * 64 + kg) * 24 + 4 * cq + e] = a0[e]; red[(1 * 64 + kg) * 24 + 4 * cq + e] = a1[e]; red[(2 * 64 + kg) * 24 + 4 * cq + e] = a2[e]; }
            }
            __syncthreads();
            if (F.tid < 72) { const int c = F.tid / 24, col = F.tid % 24; float s = 0.f;
                for (int kg = 0; kg < 64; ++kg) s += red[(c * 64 + kg) * 24 + col];
                st_wt4(ada + c * 6144 + 24 * cb + col, s + bada[24 * cb + col]); }
            __syncthreads();
        }
    }
    signal_done(F, (unsigned*)(F.ws + WS_CTL) + 8320);
    for (int it = F.bid * NTHR + F.tid; it < 2 * 65536; it += F.G * NTHR) { const int which = it >> 16, i8 = it & 65535; const float* src = (which ? F.in[4] : F.in[3]) + (size_t)i8 * 8;
        const f32x4 a = *(const f32x4*)src, b = *(const f32x4*)(src + 4); u32x4 w; w.x = cvtpk(a[0], a[1]); w.y = cvtpk(a[2], a[3]); w.z = cvtpk(b[0], b[1]); w.w = cvtpk(b[2], b[3]);
        *(u32x4*)((bf16_t*)(F.ws + (which ? WS_CVB : WS_CKB)) + (size_t)i8 * 8) = w; }
    p0_transposes(F, 0, F.G == 256 ? I_EARLY : I_EARLY + I_LATE, F.bid * NWAVES + F.wave, F.G * NWAVES);
}

template <bool FROM_OUT>
__device__ __forceinline__ void norm_rows(Frame& F, const float* g, int off_sh, int off_sc) {
    const int gw = F.bid * NWAVES + F.wave, NGW = F.G * NWAVES;
    const float* ada = (const float*)(F.ws + WS_ADA);
    bf16_t* H = (bf16_t*)(F.ws + WS_H);
    for (int mb = gw; mb < MTOK; mb += 3 * NGW) {
        f32x4 v[3][4];
#pragma unroll
        for (int r = 0; r < 3; ++r) { const int m = mb + r * NGW; if (m < MTOK) { const float* xr = FROM_OUT ? F.out + (size_t)m * DM : F.xrow(m);
#pragma unroll
            for (int j = 0; j < 4; ++j) v[r][j] = *(const f32x4*)(xr + 4 * F.lane + 256 * j); } }
#pragma unroll
        for (int r = 0; r < 3; ++r) { const int m = mb + r * NGW; if (m >= MTOK) break;
            const float* ad = ada + cond_of(m) * 6144;
            f32x4 gg[4], sc[4], sh[4];
#pragma unroll
            for (int j = 0; j < 4; ++j) { const int c = 4 * F.lane + 256 * j; gg[j] = *(const f32x4*)(g + c); sc[j] = *(const f32x4*)(ad + off_sc + c); sh[j] = *(const f32x4*)(ad + off_sh + c); }
            float s = 0.f;
#pragma unroll
            for (int j = 0; j < 4; ++j) s += (v[r][j].x * v[r][j].x + v[r][j].y * v[r][j].y) + (v[r][j].z * v[r][j].z + v[r][j].w * v[r][j].w);
            const float rinv = __builtin_amdgcn_rsqf(wave_sum(s) * (1.f / DM) + EPS);
#pragma unroll
            for (int j = 0; j < 4; ++j) { const int c = 4 * F.lane + 256 * j;
                const f32x4 o = v[r][j] * rinv * gg[j] * (sc[j] + 1.f) + sh[j];
                u32x2 w; w.x = cvtpk(o[0], o[1]); w.y = cvtpk(o[2], o[3]);
                __builtin_amdgcn_raw_buffer_store_b64(w, __builtin_amdgcn_make_buffer_rsrc((void*)F.ws, (short)0, (int)WS_END, 0x00020000), (unsigned)(WS_H + ((size_t)m * DM + c) * 2), 0, 16);     } }
    }
}

__device__ __forceinline__ float logsigf_(float x) { return fminf(x, 0.f) - 0.6931471805599453f * __builtin_amdgcn_logf(1.f + __builtin_amdgcn_exp2f(-LOG2E * fabsf(x))); }
constexpr int VLS = 160;
constexpr int STS = 72;

__device__ __forceinline__ void gla_stage_v(Frame& F, const bf16_t* U, int m0, int h, LAS bf16_t* VL) {
#pragma unroll
    for (int i = 0; i < 2; ++i) { const int p = F.tid + i * NTHR, row = p >> 4, c16 = p & 15;
        const u32x4 v = *(const u32x4*)(U + (size_t)(m0 + row) * NU + UV + 128 * h + 8 * c16);
        *(LAS u32x4*)(VL + row * VLS + 8 * c16) = v; }
}

__device__ __forceinline__ void gla_pass1_item(Frame& F, int item) {
    const bf16_t* U = (const bf16_t*)(F.ws + WS_U); const float* Z = (const float*)(F.ws + WS_Z);
    bf16_t* QK = (bf16_t*)(F.ws + WS_QK) + (size_t)item * 4 * 4096; bf16_t* KV = (bf16_t*)(F.ws + WS_KV) + (size_t)item * 2 * 8192; float* DEC = (float*)(F.ws + WS_DEC) + (size_t)item * 128;
    const int gc = item >> 2, h = item & 3, m0 = gc * 64, tid = F.tid, d = tid & 63, w = F.wave, t0 = 8 * w;
    LAS float* ZL = (LAS float*)(F.lds);
    LAS float* SEG = (LAS float*)(F.lds + 8192);
    LAS bf16_t* KP = (LAS bf16_t*)(F.lds + 12288);
    LAS bf16_t* VL = (LAS bf16_t*)(F.lds + 28672);
    LAS bf16_t* QS = (LAS bf16_t*)(F.lds + 49152);
    LAS bf16_t* KVL = (LAS bf16_t*)(F.lds + 81920);
    { const int t = tid >> 3, c4 = tid & 7; *(LAS f32x4*)(ZL + t * 32 + 4 * c4) = *(const f32x4*)(Z + (size_t)(m0 + t) * 32 + 4 * c4);
      const bf16_t* up = U + (size_t)(m0 + t) * NU + 64 * h + 8 * c4;
      *(LAS u32x4*)(QS + t * 64 + 8 * c4) = *(const u32x4*)(up + UQ); *(LAS u32x4*)(QS + 4096 + t * 64 + 8 * c4) = *(const u32x4*)(up + UK); }
    gla_stage_v(F, U, m0, h, VL);
    float wf[16], wb[16];
#pragma unroll
    for (int j = 0; j < 16; ++j) { wf[j] = F.in[12][j * 256 + 64 * h + d]; wb[j] = F.in[14][j * 256 + 64 * h + d]; }
    const float bfv = F.in[13][64 * h + d], bbv = F.in[15][64 * h + d];
    __syncthreads();
    float q[8], k[8];
#pragma unroll
    for (int i = 0; i < 8; ++i) { q[i] = __uint_as_float((unsigned)QS[(t0 + i) * 64 + d] << 16) * 0.125f; k[i] = __uint_as_float((unsigned)QS[4096 + (t0 + i) * 64 + d] << 16); }
    float cf[8], cb[8];
#pragma unroll
    for (int i = 0; i < 8; ++i) { float af = bfv, ab = bbv;
#pragma unroll
        for (int j = 0; j < 16; ++j) { af += ZL[(t0 + i) * 32 + j] * wf[j]; ab += ZL[(t0 + i) * 32 + 16 + j] * wb[j]; }
        cf[i] = logsigf_(af) * (1.f / 16.f); cb[i] = logsigf_(ab) * (1.f / 16.f); }
#pragma unroll
    for (int i = 1; i < 8; ++i) cf[i] += cf[i - 1];
#pragma unroll
    for (int i = 6; i >= 0; --i) cb[i] += cb[i + 1];
    SEG[w * 64 + d] = cf[7]; SEG[(8 + w) * 64 + d] = cb[0];
    __syncthreads();
    float offf = 0.f, totf = 0.f, offb = 0.f, totb = 0.f;
#pragma unroll
    for (int sg = 0; sg < 8; ++sg) { const float a = SEG[sg * 64 + d], b2 = SEG[(8 + sg) * 64 + d]; totf += a; totb += b2; offf += sg < w ? a : 0.f; offb += sg > w ? b2 : 0.f; }
#pragma unroll
    for (int i = 0; i < 8; ++i) { const int t = t0 + i;
        { const float c = LOG2E * (offf + cf[i]), e = __builtin_amdgcn_exp2f(c), ei = __builtin_amdgcn_exp2f(-c), el = __builtin_amdgcn_exp2f(LOG2E * totf - c);
          QS[0 * 4096 + t * 64 + d] = (bf16_t)(cvtpk(q[i] * e, 0.f) & 0xffffu); QS[1 * 4096 + t * 64 + d] = (bf16_t)(cvtpk(k[i] * ei, 0.f) & 0xffffu); KP[t * 64 + d] = (bf16_t)(cvtpk(k[i] * el, 0.f) & 0xffffu); }
        { const float c = LOG2E * (offb + cb[i]), e = __builtin_amdgcn_exp2f(c), ei = __builtin_amdgcn_exp2f(-c), el = __builtin_amdgcn_exp2f(LOG2E * totb - c);
          QS[2 * 4096 + t * 64 + d] = (bf16_t)(cvtpk(q[i] * e, 0.f) & 0xffffu); QS[3 * 4096 + t * 64 + d] = (bf16_t)(cvtpk(k[i] * ei, 0.f) & 0xffffu); KP[(64 + t) * 64 + d] = (bf16_t)(cvtpk(k[i] * el, 0.f) & 0xffffu); } }
    if (w == 0) { st_wt4(DEC + d, __builtin_amdgcn_exp2f(LOG2E * totf)); st_wt4(DEC + 64 + d, __builtin_amdgcn_exp2f(LOG2E * totb)); }
    __syncthreads();
#pragma unroll
    for (int i = 0; i < 4; ++i) st_wt16(F, QK + (size_t)(tid + i * NTHR) * 8, *(const LAS u32x4*)(QS + (tid + i * NTHR) * 8));
    { const int l = F.lane, hh = l >> 5, g1 = (l >> 4) & 1, qq = (l & 15) >> 2, pp = l & 3, dvt = w & 3, dt = w >> 2;
#pragma unroll
      for (int dir = 0; dir < 2; ++dir) { f32x16 acc = {};
#pragma unroll
        for (int ks = 0; ks < 4; ++ks) { const int r0 = 16 * ks + 8 * hh + qq;
            const LAS bf16_t* va = VL + r0 * VLS + 32 * dvt + 16 * g1 + 4 * pp; const LAS bf16_t* kb = KP + (dir * 64 + r0) * 64 + 32 * dt + 16 * g1 + 4 * pp;
            const bf16x8 a = cat8(vtr(va), vtr(va + 4 * VLS)), b = cat8(vtr(kb), vtr(kb + 4 * 64));
            acc = __builtin_amdgcn_mfma_f32_32x32x16_bf16(a, b, acc, 0, 0, 0); }
        LAS bf16_t* kvl = KVL + dir * 8192 + (32 * dt + (l & 31)) * 128 + 32 * dvt + 4 * hh;
#pragma unroll
        for (int rg = 0; rg < 4; ++rg) { u32x2 wv; wv.x = cvtpk(acc[4 * rg], acc[4 * rg + 1]); wv.y = cvtpk(acc[4 * rg + 2], acc[4 * rg + 3]); *(LAS u32x2*)(kvl + 8 * rg) = wv; } } }
    __syncthreads();
#pragma unroll
    for (int i = 0; i < 4; ++i) st_wt16(F, KV + (size_t)(tid + i * NTHR) * 8, *(const LAS u32x4*)(KVL + (tid + i * NTHR) * 8));
    signal_done(F, (unsigned*)(F.ws + WS_CTL) + 9216 + chain_ctr(gc, h));
}

__device__ __forceinline__ void gla_scan_chain(Frame& F, int chain) {
    const bf16_t* KVb = (const bf16_t*)(F.ws + WS_KV); const float* DECb = (const float*)(F.ws + WS_DEC); bf16_t* SSb = (bf16_t*)(F.ws + WS_SS);
    int seq, h, dir;
    if (chain < 16) { seq = 16 + (chain >> 3); h = (chain >> 1) & 3; dir = chain & 1; } else { const int c = chain - 16; seq = c >> 3; h = (c >> 1) & 3; dir = c & 1; }
    const bool ctx = seq < 16; const int N = ctx ? 4 : 16, gc0 = ctx ? seq * 4 : 64 + (seq - 16) * 16;
    wait_count_na(F, (unsigned*)(F.ws + WS_CTL) + 9216 + seq * 4 + h, (unsigned)N);
    const int d = 8 * F.wave + (F.lane >> 3), dv0 = 16 * (F.lane & 7);
    float S[16];
    if (ctx) {
#pragma unroll
        for (int e = 0; e < 16; ++e) S[e] = 0.f; }
    else { const float* s0 = (dir ? F.in[6] : F.in[5]) + (size_t)((seq - 16) * 4 + h) * 8192 + d * 128 + dv0;
#pragma unroll
        for (int e4 = 0; e4 < 4; ++e4) { const f32x4 v = *(const f32x4*)(s0 + 4 * e4); S[4 * e4] = v[0]; S[4 * e4 + 1] = v[1]; S[4 * e4 + 2] = v[2]; S[4 * e4 + 3] = v[3]; } }
    u32x4 kv[16][2]; float dc[16];
#pragma unroll
    for (int n = 0; n < 16; ++n) if (n < N) { const int gc = gc0 + (dir ? N - 1 - n : n), it = gc * 4 + h;
        const bf16_t* kp = KVb + ((size_t)it * 2 + dir) * 8192 + d * 128 + dv0; kv[n][0] = ld_sc1_16(F, kp); kv[n][1] = ld_sc1_16(F, kp + 8); dc[n] = ld_sc1_4(F, DECb + (size_t)it * 128 + dir * 64 + d); }
#pragma unroll
    for (int n = 0; n < 16; ++n) if (n < N) { const int gc = gc0 + (dir ? N - 1 - n : n), it = gc * 4 + h;
        bf16_t* sp = SSb + ((size_t)it * 2 + dir) * 8192 + d * 128 + dv0;
        u32x4 w0, w1; w0.x = cvtpk(S[0], S[1]); w0.y = cvtpk(S[2], S[3]); w0.z = cvtpk(S[4], S[5]); w0.w = cvtpk(S[6], S[7]); w1.x = cvtpk(S[8], S[9]); w1.y = cvtpk(S[10], S[11]); w1.z = cvtpk(S[12], S[13]); w1.w = cvtpk(S[14], S[15]);
        st_wt16(F, sp, w0); st_wt16(F, sp + 8, w1);
        float kf[16]; { float t8[8]; unpack8(kv[n][0], t8);
#pragma unroll
            for (int e = 0; e < 8; ++e) kf[e] = t8[e];
            unpack8(kv[n][1], t8);
#pragma unroll
            for (int e = 0; e < 8; ++e) kf[8 + e] = t8[e]; }
#pragma unroll
        for (int e = 0; e < 16; ++e) S[e] = dc[n] * S[e] + kf[e]; }
    if (ctx) { float* so = F.out + (dir ? O_SB : O_SF) + (size_t)(seq * 4 + h) * 8192 + d * 128 + dv0;
#pragma unroll
        for (int e4 = 0; e4 < 4; ++e4) *(f32x4*)(so + 4 * e4) = (f32x4){S[4 * e4], S[4 * e4 + 1], S[4 * e4 + 2], S[4 * e4 + 3]}; }
    signal_done(F, (unsigned*)(F.ws + WS_CTL) + 9472 + seq * 4 + h);
}

__device__ __forceinline__ void gla_scan_latq(Frame& F, int chain, int part) {
    const bf16_t* KVb = (const bf16_t*)(F.ws + WS_KV); const float* DECb = (const float*)(F.ws + WS_DEC); bf16_t* SSb = (bf16_t*)(F.ws + WS_SS);
    const int seq = 16 + (chain >> 3), h = (chain >> 1) & 3, dir = chain & 1, gc0 = 64 + (seq - 16) * 16;
    wait_count_na(F, (unsigned*)(F.ws + WS_CTL) + 9216 + seq * 4 + h, 16u);
    const int d = 16 * part + (F.tid >> 5), dv0 = 4 * (F.tid & 31);
    f32x4 S = *(const f32x4*)((dir ? F.in[6] : F.in[5]) + (size_t)((seq - 16) * 4 + h) * 8192 + d * 128 + dv0);
    u32x2 kv[16]; float dc[16];
#pragma unroll
    for (int n = 0; n < 16; ++n) { const int it = (gc0 + (dir ? 15 - n : n)) * 4 + h;
        kv[n] = ld_sc1_8(F, KVb + ((size_t)it * 2 + dir) * 8192 + d * 128 + dv0); dc[n] = ld_sc1_4(F, DECb + (size_t)it * 128 + dir * 64 + d); }
#pragma unroll
    for (int n = 0; n < 16; ++n) { const int it = (gc0 + (dir ? 15 - n : n)) * 4 + h;
        u32x2 w; w.x = cvtpk(S[0], S[1]); w.y = cvtpk(S[2], S[3]);
        st_wt8(SSb + ((size_t)it * 2 + dir) * 8192 + d * 128 + dv0, w);
        const f32x4 kf = {bflo(kv[n].x), bfhi(kv[n].x), bflo(kv[n].y), bfhi(kv[n].y)};
        S = S * dc[n] + kf; }
    signal_done(F, (unsigned*)(F.ws + WS_CTL) + 9472 + seq * 4 + h);
}

__device__ __forceinline__ void gla_pass2_item(Frame& F, int item) {
    const bf16_t* U = (const bf16_t*)(F.ws + WS_U); bf16_t* OG = (bf16_t*)(F.ws + WS_OG);
    const bf16_t* QKb = (const bf16_t*)(F.ws + WS_QK); const bf16_t* SSb = (const bf16_t*)(F.ws + WS_SS) + (size_t)item * 2 * 8192;
    const int gc = item >> 2, h = item & 3, m0 = gc * 64, tid = F.tid;
    wait_count_na(F, (unsigned*)(F.ws + WS_CTL) + 9472 + chain_ctr(gc, h), gc < 64 ? 2u : 8u);
    LAS bf16_t* ST = (LAS bf16_t*)(F.lds);
    LAS bf16_t* VL = (LAS bf16_t*)(F.lds + 40960);
    LAS float* SS = (LAS float*)(F.lds + 61440);
#pragma unroll
    for (int i = 0; i < 4; ++i) { const int p = tid + i * NTHR, dir = p >> 10, row = (p & 1023) >> 4, c16 = p & 15;
        *(LAS u32x4*)(ST + (dir * 64 + row) * VLS + 8 * c16) = ld_sc1_16(F, SSb + (size_t)dir * 8192 + row * 128 + 8 * c16); }
    gla_stage_v(F, U, m0, h, VL);
    __syncthreads();
    const int l = F.lane, hh = l >> 5, c31 = l & 31, g1 = (l >> 4) & 1, qq = (l & 15) >> 2, pp = l & 3, dvt = F.wave & 3, tt = F.wave >> 2;
    f32x16 o = {};
#pragma unroll
    for (int dir = 0; dir < 2; ++dir) {
        const bf16_t* Qg = QKb + ((size_t)item * 4 + 2 * dir) * 4096; const bf16_t* Kg = Qg + 4096;
        bf16x8 qf[4];
#pragma unroll
        for (int ks = 0; ks < 4; ++ks) qf[ks] = *(const bf16x8*)(Qg + (32 * tt + c31) * 64 + 16 * ks + 8 * hh);
#pragma unroll
        for (int st = 0; st < 2; ++st) {
            if (dir == 0 ? st > tt : st < tt) continue;
            f32x16 p = {};
#pragma unroll
            for (int ks = 0; ks < 4; ++ks) { const bf16x8 kf = *(const bf16x8*)(Kg + (32 * st + c31) * 64 + 16 * ks + 8 * hh); p = __builtin_amdgcn_mfma_f32_32x32x16_bf16(kf, qf[ks], p, 0, 0, 0); }
            if (st == tt) {
#pragma unroll
                for (int r = 0; r < 16; ++r) { const int sx = crow(r, hh); const bool keep = dir == 0 ? sx <= c31 : sx >= c31; p[r] = keep ? p[r] : 0.f; } }
#pragma unroll
            for (int s2 = 0; s2 < 2; ++s2) {
                u32x4 pw; pw.x = cvtpk(p[8 * s2 + 0], p[8 * s2 + 1]); pw.y = cvtpk(p[8 * s2 + 2], p[8 * s2 + 3]); pw.z = cvtpk(p[8 * s2 + 4], p[8 * s2 + 5]); pw.w = cvtpk(p[8 * s2 + 6], p[8 * s2 + 7]);
                const LAS bf16_t* va = VL + (32 * st + 16 * s2 + 4 * hh + qq) * VLS + 32 * dvt + 16 * g1 + 4 * pp;
                o = __builtin_amdgcn_mfma_f32_32x32x16_bf16(cat8(vtr(va), vtr(va + 8 * VLS)), __builtin_bit_cast(bf16x8, pw), o, 0, 0, 0); }
        }
#pragma unroll
        for (int ks = 0; ks < 4; ++ks) { const LAS bf16_t* sa = ST + (dir * 64 + 16 * ks + 8 * hh + qq) * VLS + 32 * dvt + 16 * g1 + 4 * pp;
            o = __builtin_amdgcn_mfma_f32_32x32x16_bf16(cat8(vtr(sa), vtr(sa + 4 * VLS)), qf[ks], o, 0, 0, 0); }
    }
    { float ss = 0.f;
#pragma unroll
      for (int r = 0; r < 16; ++r) ss += o[r] * o[r];
      ss += __shfl_xor(ss, 32);
      if (hh == 0) SS[dvt * 64 + 32 * tt + c31] = ss; }
    __syncthreads();
    { const int t = 32 * tt + c31; const float tot = SS[t] + SS[64 + t] + SS[128 + t] + SS[192 + t]; const float rinv = __builtin_amdgcn_rsqf(tot * (1.f / 128.f) + EPS);
      const float* gg = F.in[16]; const size_t m = (size_t)(m0 + t);
#pragma unroll
      for (int rg = 0; rg < 4; ++rg) { const int dv0 = 32 * dvt + 8 * rg + 4 * hh; const f32x4 g4 = *(const f32x4*)(gg + dv0);
          const u32x2 gr = *(const u32x2*)(U + m * NU + UR + 128 * h + dv0); const float r0 = bflo(gr.x), r1 = bfhi(gr.x), r2 = bflo(gr.y), r3 = bfhi(gr.y);
          u32x2 wv; wv.x = cvtpk(o[4 * rg + 0] * rinv * g4[0] * siluf_(r0), o[4 * rg + 1] * rinv * g4[1] * siluf_(r1)); wv.y = cvtpk(o[4 * rg + 2] * rinv * g4[2] * siluf_(r2), o[4 * rg + 3] * rinv * g4[3] * siluf_(r3));
          *(u32x2*)(OG + m * 512 + 128 * h + dv0) = wv; } }
    __syncthreads();
}

constexpr float QSC = 0.125f * LOG2E;
struct AttnLocal { const LAS float* rpb; int dr0; int qc0; };

template <bool LOCAL>
__device__ __forceinline__ void attn_wave(Frame& F, const bf16_t* U, int qtok0, int h, const bf16_t* krow0, int kstride, const LAS bf16_t* VLw, const AttnLocal& L, f32x16 (&o)[2], float& m_out, float& l_out) {
    const int l = F.lane, hh = l >> 5, c31 = l & 31, g1 = (l >> 4) & 1, qq = (l & 15) >> 2, pp = l & 3;
    bf16x8 qf[4];
    { const bf16_t* qp = U + (size_t)(qtok0 + c31) * NU + UNQ + 64 * h + 8 * hh;
#pragma unroll
      for (int ks = 0; ks < 4; ++ks) qf[ks] = *(const bf16x8*)(qp + 16 * ks); }
    float m_run = -1e30f, l_run = 0.f;
    o[0] = f32x16{}; o[1] = f32x16{};
    const bf16_t* kpu = krow0 + (size_t)c31 * kstride + 8 * hh;
    u32x4 rawu[4];
#pragma unroll
    for (int ks = 0; ks < 4; ++ks) rawu[ks] = *(const u32x4*)(kpu + 16 * ks);
#pragma unroll 1
    for (int T = 0; T < 8; ++T) {
        bf16x8 kf[4];
#pragma unroll
        for (int ks = 0; ks < 4; ++ks) kf[ks] = __builtin_bit_cast(bf16x8, rawu[ks]);
        if (T < 7) { const bf16_t* kn = kpu + (size_t)(32 * (T + 1)) * kstride;
#pragma unroll
            for (int ks = 0; ks < 4; ++ks) rawu[ks] = *(const u32x4*)(kn + 16 * ks); }
        f32x16 acc = {};
#pragma unroll
        for (int ks = 0; ks < 4; ++ks) acc = __builtin_amdgcn_mfma_f32_32x32x16_bf16(kf[ks], qf[ks], acc, 0, 0, 0);
        if (LOCAL) {
            const int c = L.qc0 + c31, cs = min(max(c - 8, 0), 48); const LAS float* rp = L.rpb + (L.dr0 + (T >> 1)) * 32 + (cs - c + 15);
            const int rel0 = 32 * (T & 1) + 4 * hh - cs;
#pragma unroll
            for (int r = 0; r < 16; ++r) { const int rel = rel0 + (r & 3) + 8 * (r >> 2); const bool inw = (unsigned)rel < 16u;
                acc[r] = inw ? acc[r] + rp[inw ? rel : 0] : -INFINITY; } }
        float mx = acc[0];
#pragma unroll
        for (int r = 1; r < 16; ++r) mx = fmaxf(mx, acc[r]);
        { auto r32 = __builtin_amdgcn_permlane32_swap(__float_as_uint(mx), __float_as_uint(mx), false, false); mx = fmaxf(__uint_as_float(r32[0]), __uint_as_float(r32[1])); }
        const float mnew = fmaxf(m_run, mx), fsc = __builtin_amdgcn_exp2f(m_run - mnew);
        m_run = mnew; l_run *= fsc;
#pragma unroll
        for (int r = 0; r < 16; ++r) { o[0][r] *= fsc; o[1][r] *= fsc; }
#pragma unroll
        for (int r = 0; r < 16; ++r) { const float p = __builtin_amdgcn_exp2f(acc[r] - mnew); acc[r] = p; l_run += p; }
#pragma unroll
        for (int s2 = 0; s2 < 2; ++s2) {
            u32x4 pw; pw.x = cvtpk(acc[8 * s2 + 0], acc[8 * s2 + 1]); pw.y = cvtpk(acc[8 * s2 + 2], acc[8 * s2 + 3]); pw.z = cvtpk(acc[8 * s2 + 4], acc[8 * s2 + 5]); pw.w = cvtpk(acc[8 * s2 + 6], acc[8 * s2 + 7]);
            const bf16x8 pb = __builtin_bit_cast(bf16x8, pw);
#pragma unroll
            for (int dt = 0; dt < 2; ++dt) { const LAS bf16_t* va = VLw + (32 * T + 16 * s2 + 4 * hh + qq) * 64 + 32 * dt + 16 * g1 + 4 * pp;
                o[dt] = __builtin_amdgcn_mfma_f32_32x32x16_bf16(cat8(vtr(va), vtr(va + 8 * 64)), pb, o[dt], 0, 0, 0); } }
    }
    l_run += __shfl_xor(l_run, 32);
    const float mx = m_run, ls = l_run;
    m_out = mx; l_out = ls;
}

__device__ __forceinline__ void attn_ctx_unit(Frame& F, int unit) {
    const bf16_t* U = (const bf16_t*)(F.ws + WS_U); bf16_t* ON = (bf16_t*)(F.ws + WS_ON);
    const int b = unit >> 3, h = unit & 7, tok0 = b * 256;
    LAS bf16_t* VL = (LAS bf16_t*)(F.lds);
#pragma unroll
    for (int i = 0; i < 4; ++i) { const int p = F.tid + i * NTHR, row = p >> 3, c8 = p & 7;
        *(LAS u32x4*)(VL + row * 64 + 8 * c8) = *(const u32x4*)(U + (size_t)(tok0 + row) * NU + UNV + 64 * h + 8 * c8); }
    __syncthreads();
    f32x16 o[2]; float mx, ls; AttnLocal L{nullptr, 0, 0};
    attn_wave<false>(F, U, tok0 + 32 * F.wave, h, U + (size_t)tok0 * NU + UNK + 64 * h, NU, VL, L, o, mx, ls);
    { const int hh = F.lane >> 5, c31 = F.lane & 31; const float inv = __builtin_amdgcn_rcpf(ls); bf16_t* op = ON + (size_t)(tok0 + 32 * F.wave + c31) * 512 + 64 * h;
#pragma unroll
      for (int dt = 0; dt < 2; ++dt)
#pragma unroll
          for (int rg = 0; rg < 4; ++rg) { u32x2 w; w.x = cvtpk(o[dt][4 * rg] * inv, o[dt][4 * rg + 1] * inv); w.y = cvtpk(o[dt][4 * rg + 2] * inv, o[dt][4 * rg + 3] * inv);
              *(u32x2*)(op + 32 * dt + 8 * rg + 4 * hh) = w; } }
    __syncthreads();
}

__device__ __forceinline__ void attn_lat_unit(Frame& F, int unit) {
    const bf16_t* U = (const bf16_t*)(F.ws + WS_U); bf16_t* ON = (bf16_t*)(F.ws + WS_ON);
    const int r = unit & 15, h = (unit >> 4) & 7, bl = unit >> 7;
    const int rs = min(max(r - 4, 0), 8), ltok0 = NCTX + bl * 1024 + rs * 64, qrow0 = NCTX + bl * 1024 + r * 64;
    LAS bf16_t* VL = (LAS bf16_t*)(F.lds);
    LAS float* RPB = (LAS float*)(F.lds + 131072);
    LAS float* ML = (LAS float*)(F.lds + 133120);
    LAS float* PO = (LAS float*)(F.lds);
    const bf16_t* cvb = (const bf16_t*)(F.ws + WS_CVB) + (size_t)bl * 512 * 512;
#pragma unroll
    for (int i = 0; i < 8; ++i) { const int p = F.tid + i * NTHR, row = p >> 3, c8 = p & 7;
        *(LAS u32x4*)(VL + row * 64 + 8 * c8) = *(const u32x4*)(U + (size_t)(ltok0 + row) * NU + UNV + 64 * h + 8 * c8); }
#pragma unroll
    for (int i = 0; i < 8; ++i) { const int p = F.tid + i * NTHR, row = p >> 3, c8 = p & 7;
        *(LAS u32x4*)(VL + (512 + row) * 64 + 8 * c8) = *(const u32x4*)(cvb + ((size_t)row * 8 + h) * 64 + 8 * c8); }
    if (F.tid < 480) { const int dr = F.tid >> 5, dc = F.tid & 31; RPB[F.tid] = dc < 31 ? F.in[19][(h * 15 + dr) * 31 + dc] * LOG2E : 0.f; }
    __syncthreads();
    const int qg = F.wave >> 2, kb = F.wave & 3;
    f32x16 o[2]; float mx, ls;
    if (kb < 2) { AttnLocal L{RPB, rs + 4 * kb - r + 7, 32 * qg}; attn_wave<true>(F, U, qrow0 + 32 * qg, h, U + (size_t)(ltok0 + 256 * kb) * NU + UNK + 64 * h, NU, VL + 256 * kb * 64, L, o, mx, ls); }
    else { AttnLocal L{nullptr, 0, 0}; attn_wave<false>(F, U, qrow0 + 32 * qg, h, (const bf16_t*)(F.ws + WS_CKB) + ((size_t)(bl * 512 + 256 * (kb - 2)) * 8 + h) * 64, 512, VL + (512 + 256 * (kb - 2)) * 64, L, o, mx, ls); }
    __syncthreads();
    { const int hh = F.lane >> 5, c31 = F.lane & 31;
#pragma unroll
      for (int dt = 0; dt < 2; ++dt)
#pragma unroll
          for (int rr = 0; rr < 16; ++rr) PO[(F.wave * 64 + 32 * dt + crow(rr, hh)) * 32 + c31] = o[dt][rr];
      if (hh == 0) { ML[F.wave * 64 + c31] = mx; ML[F.wave * 64 + 32 + c31] = ls; } }
    __syncthreads();
    { const int q = F.tid & 31, dv8 = (F.tid >> 5) & 7, qg2 = F.tid >> 8;
      float M = -INFINITY;
#pragma unroll
      for (int w = 0; w < 4; ++w) M = fmaxf(M, ML[(4 * qg2 + w) * 64 + q]);
      float Ls = 0.f, acc[8];
#pragma unroll
      for (int e = 0; e < 8; ++e) acc[e] = 0.f;
#pragma unroll
      for (int w = 0; w < 4; ++w) { const int ww = 4 * qg2 + w; const float wt = __builtin_amdgcn_exp2f(ML[ww * 64 + q] - M); Ls += wt * ML[ww * 64 + 32 + q];
#pragma unroll
          for (int e = 0; e < 8; ++e) acc[e] += wt * PO[(ww * 64 + 8 * dv8 + e) * 32 + q]; }
      const float inv = __builtin_amdgcn_rcpf(Ls);
#pragma unroll
      for (int e = 0; e < 8; ++e) acc[e] *= inv;
      *(u32x4*)(ON + (size_t)(qrow0 + 32 * qg2 + q) * 512 + 64 * h + 8 * dv8) = pack8(acc); }
    __syncthreads();
}

__device__ __forceinline__ void resid_norm_rows(Frame& F) {
    const int gw = F.bid * NWAVES + F.wave, NGW = F.G * NWAVES;
    const float* ada = (const float*)(F.ws + WS_ADA); const float* g = F.in[23];
    const bf16_t* P0 = (const bf16_t*)(F.ws + WS_PART0); const bf16_t* P1 = (const bf16_t*)(F.ws + WS_PART1);
    bf16_t* H = (bf16_t*)(F.ws + WS_H);
    for (int mb = gw; mb < MTOK; mb += 3 * NGW) {
        f32x4 v[3][4]; u32x2 p0[3][4], p1[3][4];
#pragma unroll
        for (int r = 0; r < 3; ++r) { const int m = mb + r * NGW; if (m < MTOK) { const float* xr = F.xrow(m);
#pragma unroll
            for (int j = 0; j < 4; ++j) { const int c = 4 * F.lane + 256 * j; v[r][j] = *(const f32x4*)(xr + c); p0[r][j] = *(const u32x2*)(P0 + (size_t)m * DM + c); p1[r][j] = *(const u32x2*)(P1 + (size_t)m * DM + c); } } }
#pragma unroll
        for (int r = 0; r < 3; ++r) { const int m = mb + r * NGW; if (m >= MTOK) break;
            const float* ad = ada + cond_of(m) * 6144;
            f32x4 gg[4], sc[4], sh[4]; float s = 0.f;
#pragma unroll
            for (int j = 0; j < 4; ++j) { const int c = 4 * F.lane + 256 * j; const f32x4 gt = *(const f32x4*)(ad + 2048 + c); gg[j] = *(const f32x4*)(g + c); sc[j] = *(const f32x4*)(ad + 4096 + c); sh[j] = *(const f32x4*)(ad + 3072 + c);
                { const f32x4 ps = {bflo(p0[r][j].x) + bflo(p1[r][j].x), bfhi(p0[r][j].x) + bfhi(p1[r][j].x), bflo(p0[r][j].y) + bflo(p1[r][j].y), bfhi(p0[r][j].y) + bfhi(p1[r][j].y)}; v[r][j] = v[r][j] + gt * ps; }
                __builtin_amdgcn_raw_buffer_store_b128(__builtin_bit_cast(u32x4, v[r][j]), __builtin_amdgcn_make_buffer_rsrc((void*)F.out, (short)0, (int)(1u << 30), 0x00020000), (unsigned)(((size_t)m * DM + c) * 4), 0, 16);
                s += (v[r][j].x * v[r][j].x + v[r][j].y * v[r][j].y) + (v[r][j].z * v[r][j].z + v[r][j].w * v[r][j].w); }
            const float rinv = __builtin_amdgcn_rsqf(wave_sum(s) * (1.f / DM) + EPS);
#pragma unroll
            for (int j = 0; j < 4; ++j) { const int c = 4 * F.lane + 256 * j;
                const f32x4 o = v[r][j] * rinv * gg[j] * (sc[j] + 1.f) + sh[j];
                u32x2 w; w.x = cvtpk(o[0], o[1]); w.y = cvtpk(o[2], o[3]);
                __builtin_amdgcn_raw_buffer_store_b64(w, __builtin_amdgcn_make_buffer_rsrc((void*)F.ws, (short)0, (int)WS_END, 0x00020000), (unsigned)(WS_H + ((size_t)m * DM + c) * 2), 0, 16);     } }
    }
}
__device__ __forceinline__ void final_rows(Frame& F) {
    const float* ada = (const float*)(F.ws + WS_ADA);
    const bf16_t* P0 = (const bf16_t*)(F.ws + WS_PART0); const bf16_t* P1 = (const bf16_t*)(F.ws + WS_PART1);
    constexpr int NV4 = MTOK * DM / 4;
    for (int base = F.bid * NTHR + F.tid; base < NV4; base += 4 * F.G * NTHR) {
        f32x4 x1[4]; u32x2 a[4], b[4];
#pragma unroll
        for (int k = 0; k < 4; ++k) { const int i4 = base + k * F.G * NTHR; if (i4 < NV4) { x1[k] = *(const f32x4*)(F.out + (size_t)i4 * 4); a[k] = *(const u32x2*)(P0 + (size_t)i4 * 4); b[k] = *(const u32x2*)(P1 + (size_t)i4 * 4); } }
#pragma unroll
        for (int k = 0; k < 4; ++k) { const int i4 = base + k * F.G * NTHR; if (i4 < NV4) { const int m = i4 >> 8, c = (i4 & 255) * 4;
            const f32x4 gt = *(const f32x4*)(ada + cond_of(m) * 6144 + 5120 + c);
            const f32x4 ps = {bflo(a[k].x) + bflo(b[k].x), bfhi(a[k].x) + bfhi(b[k].x), bflo(a[k].y) + bflo(b[k].y), bfhi(a[k].y) + bfhi(b[k].y)};
            *(f32x4*)(F.out + (size_t)i4 * 4) = x1[k] + gt * ps; } }
    }
}

struct Args { const float* in[28]; float* out; unsigned char* ws; int ph_lo, ph_hi; };

__device__ unsigned char code_tail_guard[65536];

__global__ void __launch_bounds__(NTHR, 2) fwd_kernel(Args args) {
    extern __shared__ __attribute__((aligned(16))) unsigned char lds_raw[];
    Frame F;
    F.lds = (LAS unsigned char*)lds_raw;
    F.tid = threadIdx.x; F.lane = F.tid & 63; F.wave = __builtin_amdgcn_readfirstlane(F.tid >> 6);
    F.G = gridDim.x; F.bid = blockIdx.x;
#pragma unroll
    for (int i = 0; i < 28; ++i) F.in[i] = args.in[i];
    F.out = args.out; F.ws = args.ws;
    const int lo = args.ph_lo, hi = args.ph_hi;
    const bool multi = (hi - lo) > 1;
    volatile LAS unsigned* MISC = (volatile LAS unsigned*)(F.lds + MISC_OFF);
    if (F.tid < 128) MISC[F.tid] = 0u;
    __syncthreads();
    XcdBarrier bar; bar.bar = (unsigned*)(F.ws + WS_CTL) + 4096; bar.x = 0; bar.st = MISC + 8;
    if (multi) bar = xcd_barrier_post((unsigned*)(F.ws + WS_CTL) + 4096, MISC + 8);
    if (multi && F.tid == 0 && xb_xcc_id() != (unsigned)(F.bid & 7)) __hip_atomic_fetch_add((unsigned*)(F.ws + WS_CTL) + 8900, 1u, __ATOMIC_RELAXED, __HIP_MEMORY_SCOPE_AGENT);
#define IN(k) (lo <= (k) && (k) < hi)
#define REP(k) for (int rep_ = 0; rep_ < (((REP_MASK) >> (k)) & 1u ? 2 : 1); ++rep_)
    int bar_idx = 0;
#define PRETOUCH() do { const char* pc_ = (const char*)__builtin_amdgcn_s_getpc() + (size_t)(F.wave * 64 + lane_id()) * 64; __builtin_amdgcn_global_load_lds((const unsigned*)pc_, (LAS unsigned*)(F.lds + MISC_OFF + 1024), 4, 0, 0); } while (0)
    if (PROBE_IDX && F.tid == 0) MISC[16] = (unsigned)__builtin_amdgcn_s_memrealtime();
#define LAP(id) do { if (PROBE_IDX < 0 && F.tid == 0) MISC[16 + (id)] = (unsigned)__builtin_amdgcn_s_memrealtime(); } while (0)
#define GRID_BAR() GRID_BAR_N(512)
#define GRID_BAR_N(NT) do { if (multi) xcd_barrier_pt<((NT) > 448 ? 448 : (NT))>(bar, (LAS unsigned*)(F.lds + MISC_OFF + 1024)); if (PROBE_IDX) { ++bar_idx; if (F.tid == 0 && bar_idx < 40) MISC[16 + bar_idx] = (unsigned)__builtin_amdgcn_s_memrealtime(); } } while (0)

    if (IN(0)) { PRETOUCH(); p0_prologue(F); if (F.G == 256) { wait_count(F, (unsigned*)(F.ws + WS_CTL) + 8320, 256u); norm_rows<false>(F, F.in[10], 0, 1024); } GRID_BAR(); }
    if (IN(1) && F.G != 256) { norm_rows<false>(F, F.in[10], 0, 1024); GRID_BAR(); }
    if (IN(2)) {
        pg8::InOrder S; S.init(F.ws + WS_H, F.ws + WS_WIN, DM, DM, F.bid);
        pg8::EpiBf16 E{(bf16_t*)(F.ws + WS_U), NU, nullptr, (bf16_t*)(F.ws + WS_GATE), 12, (float*)(F.ws + WS_Z), 20, 6, F.in[17], F.in[18], F.out + O_NK, F.out + O_NV};
        LAP(30); pg8::gemm_phase(F.lds, F.wave, DM, DM, DM, S, E);
        LAP(31);
        LAP(32); GRID_BAR(); LAP(33);
    }
    if (IN(3)) {
        if (F.G == 256) {
            PRETOUCH();
#pragma unroll 1
            for (int k = 0; k < 2; ++k) { const int it = k == 0 ? (F.bid < 128 ? 256 + F.bid : F.bid) : (F.bid < 128 ? F.bid : -1); if (it >= 0) gla_pass1_item(F, it); }
            PRETOUCH();
            if (F.bid >= 128) attn_ctx_unit(F, F.bid - 128);
            PRETOUCH();
            if (F.bid >= 128) {
                if (F.bid < 192) gla_scan_latq(F, (F.bid - 128) >> 2, (F.bid - 128) & 3);
                gla_scan_chain(F, 16 + (F.bid - 128)); }
            PRETOUCH();
            { const int x_ = F.bid & 7, j_ = F.bid >> 3, g_ = 2 * x_ + (j_ >> 4);
              attn_lat_unit(F, (g_ << 4) | (j_ & 15)); }
            PRETOUCH();
#pragma unroll 1
            for (int k = 0; k < 2; ++k) { const int it = k == 0 ? F.bid : (F.bid < 128 ? 256 + F.bid : -1); if (it >= 0) gla_pass2_item(F, it); }
        } else {
            for (int it = F.bid; it < 384; it += F.G) gla_pass1_item(F, it);
            for (int u = F.bid; u < 128; u += F.G) attn_ctx_unit(F, u);
            for (int u = F.bid; u < 256; u += F.G) attn_lat_unit(F, u);
        }
        GRID_BAR(); LAP(55);
    }
    if (IN(4) && F.G != 256) { for (int c = F.bid; c < 144; c += F.G) gla_scan_chain(F, c); GRID_BAR(); }
    if (IN(5) && F.G != 256) { for (int it = F.bid; it < 384; it += F.G) gla_pass2_item(F, it); GRID_BAR(); }
    bool rr_ok = false;
    if (IN(6)) {
        rr_ok = multi && __hip_atomic_load((unsigned*)(F.ws + WS_CTL) + 8900, __ATOMIC_RELAXED, __HIP_MEMORY_SCOPE_AGENT) == 0u;
        pg8::DualOrder S; S.init(F.ws + WS_OG, F.ws + WS_WGO, F.ws + WS_ON, F.ws + WS_WNO, MTOK, DM, 512, 512, F.G, F.bid);
        pg8::EpiGate E{(const bf16_t*)(F.ws + WS_GATE), (bf16_t*)(F.ws + WS_MIX), (bf16_t*)(F.ws + WS_MIXN), (multi && F.G == 256) ? (unsigned*)(F.ws + WS_CTL) + 8832 : nullptr, !rr_ok};
        pg8::gemm_phase(F.lds, F.wave, 512, 512, 512, S, E);
        if (F.G == 256 && F.bid >= 192) p0_transposes(F, I_EARLY, I_UP, (F.bid - 192) * NWAVES + F.wave, 64 * NWAVES);
        if (!(multi && F.G == 256)) GRID_BAR();
    }
    if (IN(7)) {
        pg8::DualOrder S; S.init(F.ws + WS_MIX, F.ws + WS_WOUT, F.ws + WS_MIXN, F.ws + WS_WOUT, MTOK, DM, DM, DM, F.G, F.bid);
        pg8::EpiBf16 E{(bf16_t*)(F.ws + WS_PART0), DM, (bf16_t*)(F.ws + WS_PART1), nullptr, 1 << 30, nullptr, -1, -1, nullptr, nullptr, nullptr, nullptr};
        if (multi && F.G == 256 && F.bid < 192) { const int x_ = F.bid & 7, j_ = F.bid >> 3; unsigned* fl_ = (unsigned*)(F.ws + WS_CTL) + 8832 + (3 * x_ + (j_ >> 3)) * 2 + (j_ & 1);
            if (rr_ok) { if (F.tid == 0) { unsigned sp = 0; while (__hip_atomic_load(fl_, __ATOMIC_RELAXED, __HIP_MEMORY_SCOPE_AGENT) < 4u) { __builtin_amdgcn_s_sleep(1); if (++sp > (1u << 23)) break; } } __syncthreads(); }
            else wait_count(F, fl_, 4u); }
        pg8::gemm_phase(F.lds, F.wave, DM, DM, DM, S, E);
        if (F.G == 256 && F.bid >= 192) p0_transposes(F, I_EARLY + I_UP, I_DN, (F.bid - 192) * NWAVES + F.wave, 64 * NWAVES);
        GRID_BAR_N(320);
    }
    if (IN(8)) { PRETOUCH(); resid_norm_rows(F); GRID_BAR_N(256); }
    if (IN(9)) {
        unsigned* cnt = (unsigned*)(F.ws + WS_CTL) + 8192;
        pg8::UpOrder S; S.init(F.ws + WS_H, F.ws + WS_WUP, DM, DM, F.bid, bar, multi);
        pg8::EpiConv E{(bf16_t*)(F.ws + WS_ACT), F.in[25], F.in[26], (LAS float*)(F.lds + RING_BYTES), (float*)(F.ws + WS_EDGE), cnt + 256, cnt + 32};
        { int l_ = lane_id(); asm volatile("" : "+v"(l_)); F.lane = l_; F.tid = F.wave * 64 + l_; }
        pg8::gemm_phase(F.lds, F.wave, DM, DM, DM, S, E);
        { int l_ = lane_id(); asm volatile("" : "+v"(l_)); F.lane = l_; F.tid = F.wave * 64 + l_; }
        if (F.bid >= 16) GRID_BAR_N(128); else if (multi) xcd_barrier_finish(bar);
    }
    if (IN(11)) {
        pg8::DownOrder S; S.init(F.ws + WS_ACT, F.ws + WS_WDN, DFF, DFF, F.bid, (unsigned*)(F.ws + WS_CTL) + 8192 + 32);
        pg8::EpiBf16 E{(bf16_t*)(F.ws + WS_PART0), DM, (bf16_t*)(F.ws + WS_PART1), nullptr, 1 << 30, nullptr, -1, -1, nullptr, nullptr, nullptr, nullptr};
        pg8::gemm_phase(F.lds, F.wave, 1408, DFF, DFF, S, E);
        GRID_BAR_N(64);
    }
    if (IN(12)) { if (F.tid < 128) PRETOUCH(); final_rows(F); }
    if (PROBE_IDX > 0) { GRID_BAR(); if (F.bid == 0 && F.tid == 0) { const unsigned dt = MISC[16 + PROBE_IDX] - MISC[16 + PROBE_IDX - 1]; F.out[0] += (float)dt * 0.001f; } }
    if (PROBE_IDX < 0) { GRID_BAR(); if (F.bid == PROBE_BLOCK && F.tid == 0) { const unsigned dt = MISC[16 + PROBE_B] - MISC[16 + PROBE_A]; F.out[0] += (float)dt * 0.001f; } }
#undef IN
}

#ifndef FUSED_MASK
#define FUSED_MASK 0xFFFu
#endif
constexpr unsigned FUSED = FUSED_MASK;
constexpr size_t WS_ADEC = 168 * MiB, WS_OT = 181 * MiB, WS_BN = 72 * MiB;

extern "C" void kernel_launch(void* const* d_in, const int* in_sizes, int n_in, void* d_out, int out_size, void* d_ws, size_t ws_size, hipStream_t stream) {
    static int grid = 0;
    if (grid == 0) {
        if (n_in != 28 || ws_size < WS_END) { fprintf(stderr, "kernel_launch: unexpected n_in %d / ws %zu\n", n_in, ws_size); grid = -1; return; }
        int dev = 0, cus = 0, per_cu = 0;
        (void)hipGetDevice(&dev);
        (void)hipDeviceGetAttribute(&cus, hipDeviceAttributeMultiprocessorCount, dev);
        (void)hipFuncSetAttribute((const void*)fwd_kernel, hipFuncAttributeMaxDynamicSharedMemorySize, LDS_BYTES);
        (void)hipOccupancyMaxActiveBlocksPerMultiprocessor(&per_cu, (const void*)fwd_kernel, NTHR, LDS_BYTES);
        (void)hipGetLastError();
        if (per_cu < 1) { fprintf(stderr, "kernel_launch: occupancy query reports 0 workgroups per CU\n"); grid = -1; return; }
        if (cus < 256) { fprintf(stderr, "kernel_launch: the phase program is laid out for 256 CUs (found %d)\n", cus); grid = -1; return; }
        grid = 256;
    }
    if (grid < 0) return;
    (void)hipMemsetAsync((char*)d_ws + WS_CTL, 0, CTL_BYTES, stream);
    Args a{};
    for (int i = 0; i < 28; ++i) a.in[i] = (const float*)d_in[i];
    a.out = (float*)d_out; a.ws = (unsigned char*)d_ws;
    if (ONE_LAUNCH) {
        a.ph_lo = 0; a.ph_hi = 13;
        void* kargs[] = {&a};
        hipError_t e = hipLaunchCooperativeKernel((const void*)fwd_kernel, dim3(grid), dim3(NTHR), kargs, LDS_BYTES, stream);
        if (e != hipSuccess) fprintf(stderr, "kernel_launch: cooperative launch failed: %s (grid %d)\n", hipGetErrorString(e), grid);
        return;
    }
    for (int p = 0; p < 13; ++p) { a.ph_lo = p; a.ph_hi = p + 1; hipLaunchKernelGGL(fwd_kernel, dim3(grid), dim3(NTHR), LDS_BYTES, stream, a); }
}
```
